# Optimizing an MI355X kernel written in HIP

```python
import math
import jax, jax.numpy as jnp
from jax import lax
import numpy as np

D_MODEL = 2048
BATCH = 8
SEQ = 2048
DEPTH = 2
DEC_BATCH = 128
DEC_SEQ = 8
PAST_LEN = 2048
PAGE_SIZE = 128

N_MIXERS = 2
N_A_LAYERS = (DEPTH + N_MIXERS - 1) // N_MIXERS
N_B_LAYERS = DEPTH // N_MIXERS
CHUNK = 128
A_WIDTH = D_MODEL
A_GROUPS = 16
A_GROUP_DIM = A_WIDTH // A_GROUPS
N_HEADS = 16
HEAD_DIM = D_MODEL // N_HEADS
N_KV_HEADS = 4
Q_PER_KV = N_HEADS // N_KV_HEADS
IDX_HEADS = 16
IDX_DIM = 64
TOPK_MAX = 256
Q_BLOCK = 128
ROPE_THETA = 10000.0
IDX_W_SCALE = (IDX_HEADS * IDX_DIM) ** -0.5
B_Q = N_HEADS * HEAD_DIM
B_KV = N_KV_HEADS * HEAD_DIM
B_IQ = IDX_HEADS * IDX_DIM
B_PROJ = B_Q + 2 * B_KV + B_IQ + IDX_DIM + IDX_HEADS
B_SPLITS = [B_Q, B_Q + B_KV, B_Q + 2 * B_KV, B_Q + 2 * B_KV + B_IQ, B_Q + 2 * B_KV + B_IQ + IDX_DIM]
D_FF = 5632
CONV_WIDTH = 3
EPS = 1e-6

kernel_name = "hybrid_chunkgmlp_dsa_convffn_step"


def _rmsnorm(x, g):
    xf = x.astype(jnp.float32)
    y = xf * lax.rsqrt(jnp.mean(xf * xf, axis=-1, keepdims=True) + EPS)
    return (y * g.astype(jnp.float32)).astype(x.dtype)


def _rope(x, pos):
    d = x.shape[-1]
    half = d // 2
    inv = ROPE_THETA ** (-jnp.arange(half, dtype=jnp.float32) * (2.0 / d))
    ang = pos.astype(jnp.float32)[:, None] * inv[None, :]
    cos = jnp.cos(ang)[:, None, :]
    sin = jnp.sin(ang)[:, None, :]
    xf = x.astype(jnp.float32)
    x1, x2 = xf[..., :half], xf[..., half:]
    return jnp.concatenate([x1 * cos - x2 * sin, x2 * cos + x1 * sin], axis=-1).astype(x.dtype)


def _chunk_mlp(h, w_in, v_gain, w_s, b_s, w_out):
    bsz, t, _ = h.shape
    c = min(t, CHUNK)
    n = t // c
    z = jax.nn.gelu(h @ w_in)
    u, v = z[..., :A_WIDTH], z[..., A_WIDTH:]
    v = _rmsnorm(v, v_gain)
    causal = jnp.tril(jnp.ones((c, c), dtype=bool))
    ws = jnp.where(causal[None], w_s[:, :c, :c], 0).astype(v.dtype)
    vg = v.reshape(bsz, n, c, A_GROUPS, A_GROUP_DIM)
    s = jnp.einsum('gts,bnsgd->bntgd', ws, vg) + b_s[:, :c].T[:, :, None]
    s = s.reshape(bsz, t, A_WIDTH)
    return (u * s) @ w_out, v


def _dsa_project(h, pos, w_in, q_gain, k_gain):
    bsz, t, _ = h.shape
    p = h @ w_in
    q, k, v, iq, ik, iw = jnp.split(p, B_SPLITS, axis=-1)
    q = _rope(_rmsnorm(q.reshape(bsz, t, N_HEADS, HEAD_DIM), q_gain), pos)
    k = _rope(_rmsnorm(k.reshape(bsz, t, N_KV_HEADS, HEAD_DIM), k_gain), pos)
    v = v.reshape(bsz, t, N_KV_HEADS, HEAD_DIM)
    iq = _rope(iq.reshape(bsz, t, IDX_HEADS, IDX_DIM), pos)
    ik = _rope(ik[:, :, None, :], pos)[:, :, 0, :]
    iw = iw * IDX_W_SCALE
    return q, k, v, iq, ik, iw


def _index_select(iq, iw, ik, qpos, kpos, topk):
    logits = jnp.einsum('bqhd,bsd->bqsh', iq, ik, preferred_element_type=jnp.float32)
    score = jnp.einsum('bqsh,bqh->bqs', jax.nn.relu(logits), iw.astype(jnp.float32))
    admissible = kpos[None, :] <= qpos[:, None]
    score = jnp.where(admissible[None], score, -jnp.inf)
    _, sel = lax.top_k(score, topk)
    valid = sel <= qpos[None, :, None]
    return sel, valid


def _sparse_attend(q, k_sel, v_sel, valid):
    bsz, t = q.shape[:2]
    qg = q.reshape(bsz, t, N_KV_HEADS, Q_PER_KV, HEAD_DIM)
    s = jnp.einsum('btkgd,btskd->btkgs', qg, k_sel, preferred_element_type=jnp.float32) * (HEAD_DIM ** -0.5)
    s = jnp.where(valid[:, :, None, None, :], s, -jnp.inf)
    p = jax.nn.softmax(s, axis=-1).astype(v_sel.dtype)
    o = jnp.einsum('btkgs,btskd->btkgd', p, v_sel)
    return o.reshape(bsz, t, N_HEADS * HEAD_DIM)


def _dsa_prompt(h, w_in, q_gain, k_gain, w_o):
    bsz, s_len, _ = h.shape
    pos = jnp.arange(s_len, dtype=jnp.int32)
    q, k, v, iq, ik, iw = _dsa_project(h, pos, w_in, q_gain, k_gain)
    topk = min(TOPK_MAX, s_len // 4)
    bidx = jnp.arange(bsz)[:, None, None]

    def block(start):
        qpos = start + jnp.arange(Q_BLOCK, dtype=jnp.int32)
        q_b = lax.dynamic_slice_in_dim(q, start, Q_BLOCK, axis=1)
        iq_b = lax.dynamic_slice_in_dim(iq, start, Q_BLOCK, axis=1)
        iw_b = lax.dynamic_slice_in_dim(iw, start, Q_BLOCK, axis=1)
        sel, valid = _index_select(iq_b, iw_b, ik, qpos, pos, topk)
        return _sparse_attend(q_b, k[bidx, sel], v[bidx, sel], valid)

    starts = jnp.arange(0, s_len, Q_BLOCK, dtype=jnp.int32)
    o = lax.map(block, starts)
    o = jnp.moveaxis(o, 0, 1).reshape(bsz, s_len, N_HEADS * HEAD_DIM)
    return o @ w_o, k, v, ik


def _gather_rows(pool, layer, page_table, new, sel, past):
    bidx = jnp.arange(sel.shape[0])[:, None, None]
    ps = jnp.minimum(sel, past - 1)
    old = pool[layer, page_table[bidx, ps // PAGE_SIZE], ps % PAGE_SIZE]
    cur = new[bidx, jnp.clip(sel - past, 0, new.shape[1] - 1)]
    return jnp.where((sel < past)[..., None, None], old, cur)


def _dsa_sample(h, layer, cache_k, cache_v, cache_idx_k, page_table, w_in, q_gain, k_gain, w_o):
    bsz, t, _ = h.shape
    past = page_table.shape[1] * PAGE_SIZE
    pos = past + jnp.arange(t, dtype=jnp.int32)
    q, k, v, iq, ik, iw = _dsa_project(h, pos, w_in, q_gain, k_gain)
    ik_past = cache_idx_k[layer, page_table].reshape(bsz, past, IDX_DIM)
    ik_all = jnp.concatenate([ik_past, ik.astype(ik_past.dtype)], axis=1)
    kpos = jnp.arange(past + t, dtype=jnp.int32)
    topk = min(TOPK_MAX, (past + t) // 4)
    sel, valid = _index_select(iq, iw, ik_all, pos, kpos, topk)
    k_sel = _gather_rows(cache_k, layer, page_table, k, sel, past)
    v_sel = _gather_rows(cache_v, layer, page_table, v, sel, past)
    o = _sparse_attend(q, k_sel, v_sel, valid)
    return o @ w_o, k, v, ik


def _conv_ffn(h, conv_buf, w_in, conv_w, conv_b, w_out):
    t = h.shape[1]
    a = h @ w_in
    ap = jnp.concatenate([conv_buf.astype(a.dtype), a], axis=1)
    c = conv_b
    for j in range(CONV_WIDTH):
        c = c + conv_w[j] * ap[:, j:j + t]
    g, up = c[..., :D_FF], c[..., D_FF:]
    return (jax.nn.silu(g) * up) @ w_out, ap[:, t:]


def setup_inputs(seed: int = 0) -> dict:
    key = jax.random.key(seed)
    ks = jax.random.split(key, 32)
    n_pages = PAST_LEN // PAGE_SIZE
    n_used = DEC_BATCH * n_pages
    n_pool = n_used + (n_used + 3) // 4

    def nrm(k, shape, scale=1.0):
        return jax.random.normal(k, shape, jnp.float32) * scale

    def gain(k, shape):
        return 1.0 + 0.02 * jax.random.normal(k, shape, jnp.float32)

    page_table = jax.random.permutation(ks[7], n_pool)[:n_used].reshape(DEC_BATCH, n_pages).astype(jnp.int32)
    return {
        'x_prompt': nrm(ks[0], (BATCH, SEQ, D_MODEL)),
        'x_sample': nrm(ks[1], (DEC_BATCH, DEC_SEQ, D_MODEL)),
        'cache_k': nrm(ks[2], (N_B_LAYERS, n_pool, PAGE_SIZE, N_KV_HEADS, HEAD_DIM)),
        'cache_v': nrm(ks[3], (N_B_LAYERS, n_pool, PAGE_SIZE, N_KV_HEADS, HEAD_DIM)),
        'cache_idx_k': nrm(ks[4], (N_B_LAYERS, n_pool, PAGE_SIZE, IDX_DIM)),
        'state_ffn_conv': nrm(ks[5], (DEPTH, DEC_BATCH, CONV_WIDTH - 1, 2 * D_FF)),
        'page_table': page_table,
        'a_norm': gain(ks[8], (N_A_LAYERS, D_MODEL)),
        'a_w_in': nrm(ks[9], (N_A_LAYERS, D_MODEL, 2 * A_WIDTH), D_MODEL ** -0.5),
        'a_v_norm': gain(ks[10], (N_A_LAYERS, A_WIDTH)),
        'a_w_s': nrm(ks[11], (N_A_LAYERS, A_GROUPS, CHUNK, CHUNK), CHUNK ** -0.5),
        'a_b_s': gain(ks[12], (N_A_LAYERS, A_GROUPS, CHUNK)),
        'a_w_out': nrm(ks[13], (N_A_LAYERS, A_WIDTH, D_MODEL), A_WIDTH ** -0.5),
        'b_norm': gain(ks[14], (N_B_LAYERS, D_MODEL)),
        'b_w_in': nrm(ks[15], (N_B_LAYERS, D_MODEL, B_PROJ), D_MODEL ** -0.5),
        'b_q_norm': gain(ks[16], (N_B_LAYERS, HEAD_DIM)),
        'b_k_norm': gain(ks[17], (N_B_LAYERS, HEAD_DIM)),
        'b_w_o': nrm(ks[18], (N_B_LAYERS, N_HEADS * HEAD_DIM, D_MODEL), (N_HEADS * HEAD_DIM) ** -0.5),
        'f_norm': gain(ks[19], (DEPTH, D_MODEL)),
        'f_w_in': nrm(ks[20], (DEPTH, D_MODEL, 2 * D_FF), D_MODEL ** -0.5),
        'f_conv_w': nrm(ks[21], (DEPTH, CONV_WIDTH, 2 * D_FF), CONV_WIDTH ** -0.5),
        'f_conv_b': nrm(ks[22], (DEPTH, 2 * D_FF), 0.01),
        'f_w_out': nrm(ks[23], (DEPTH, D_FF, D_MODEL), D_FF ** -0.5),
    }


def reference(x_prompt, x_sample, cache_k, cache_v, cache_idx_k, state_ffn_conv, page_table,
              a_norm, a_w_in, a_v_norm, a_w_s, a_b_s, a_w_out,
              b_norm, b_w_in, b_q_norm, b_k_norm, b_w_o,
              f_norm, f_w_in, f_conv_w, f_conv_b, f_w_out):
    xp, xs = x_prompt, x_sample
    bsz, seq = xp.shape[:2]
    n_seq_pages = seq // PAGE_SIZE
    k_p, v_p, ik_p, k_s, v_s, ik_s, chunk_v_s, conv_p, conv_s = [], [], [], [], [], [], [], [], []
    for layer in range(DEPTH):
        j = layer // N_MIXERS
        if layer % N_MIXERS == 0:
            op, _ = _chunk_mlp(_rmsnorm(xp, a_norm[j]), a_w_in[j], a_v_norm[j], a_w_s[j], a_b_s[j], a_w_out[j])
            os_, vrows = _chunk_mlp(_rmsnorm(xs, a_norm[j]), a_w_in[j], a_v_norm[j], a_w_s[j], a_b_s[j], a_w_out[j])
            chunk_v_s.append(vrows)
        else:
            op, kp, vp, ikp = _dsa_prompt(_rmsnorm(xp, b_norm[j]), b_w_in[j], b_q_norm[j], b_k_norm[j], b_w_o[j])
            os_, ksn, vsn, iks = _dsa_sample(_rmsnorm(xs, b_norm[j]), j, cache_k, cache_v, cache_idx_k, page_table,
                                             b_w_in[j], b_q_norm[j], b_k_norm[j], b_w_o[j])
            k_p.append(kp.reshape(bsz, n_seq_pages, PAGE_SIZE, N_KV_HEADS, HEAD_DIM))
            v_p.append(vp.reshape(bsz, n_seq_pages, PAGE_SIZE, N_KV_HEADS, HEAD_DIM))
            ik_p.append(ikp.reshape(bsz, n_seq_pages, PAGE_SIZE, IDX_DIM))
            k_s.append(ksn)
            v_s.append(vsn)
            ik_s.append(iks)
        xp = xp + op
        xs = xs + os_
        zeros_buf = jnp.zeros((bsz, CONV_WIDTH - 1, 2 * D_FF), xp.dtype)
        fp, cp = _conv_ffn(_rmsnorm(xp, f_norm[layer]), zeros_buf, f_w_in[layer], f_conv_w[layer], f_conv_b[layer], f_w_out[layer])
        fs, cs = _conv_ffn(_rmsnorm(xs, f_norm[layer]), state_ffn_conv[layer], f_w_in[layer], f_conv_w[layer], f_conv_b[layer], f_w_out[layer])
        xp = xp + fp
        xs = xs + fs
        conv_p.append(cp)
        conv_s.append(cs)
    return (xp, xs, jnp.stack(k_p), jnp.stack(v_p), jnp.stack(ik_p), jnp.stack(k_s), jnp.stack(v_s), jnp.stack(ik_s), jnp.stack(chunk_v_s), jnp.stack(conv_p), jnp.stack(conv_s))
```

```cpp
#include <hip/hip_runtime.h>
#include <cstdio>
#include <cstdint>
namespace pg8 {
#define PG8_LAS __attribute__((address_space(3)))
typedef unsigned short bf16_t;
typedef short bf16x8 __attribute__((ext_vector_type(8)));
typedef float f32x4 __attribute__((ext_vector_type(4)));
typedef unsigned u32x4 __attribute__((ext_vector_type(4)));
constexpr int BM = 256, BK = 64, HALF = 128, HTB = HALF * BK * 2  , STAGE_BYTES = 8 * HTB, NXCD = 8, WGM = 8;

__host__ __device__ __forceinline__ int lds_byte(int r, int c) { const int st = (r >> 4) * 2 + (c >> 5), rr = r & 15, cc = c & 31, ob = rr * 64 + cc * 2; return st * 1024 + (ob ^ (((ob >> 9) & 1) << 5)); }
__host__ __device__ __forceinline__ void stage_rc(int b, int& R, int& C) { const int st = b / 1024, sb = b % 1024, swz = sb ^ (((sb >> 9) & 1) << 5); R = (st >> 1) * 16 + swz / 64; C = (st & 1) * 32 + (swz % 64) / 2; }
__host__ __device__ __forceinline__ int perm32(int rho) { const int n = rho >> 4, i = rho & 15; return 8 * (i >> 2) + 4 * n + (i & 3); }

struct Unit { int pm, pn; };
struct Gemm { const bf16_t* A; const bf16_t* Bt; int M, N, K; };

struct StaticOrder {
    int nM, nN, nwg, G, c;
    __host__ __device__ void init(int M, int N, int G_, int c_) { nM = M / BM; nN = N / BM; nwg = nM * nN; G = G_; c = c_; }
    __host__ __device__ bool next(int i, Unit& u) const {
        const long L = (long)i * G + c; if (L >= nwg) return false;
        int wgid = (int)L; { const int q = nwg / NXCD, r = nwg % NXCD, xcd = wgid % NXCD, off = wgid / NXCD; wgid = (xcd < r ? xcd * (q + 1) : r * (q + 1) + (xcd - r) * q) + off; }
        const int nig = WGM * nN, gid = wgid / nig, fm = gid * WGM, gsz = (nM - fm) < WGM ? (nM - fm) : WGM;
        u.pm = fm + ((wgid % nig) % gsz); u.pn = (wgid % nig) / gsz; return true;
    }
    __device__ __forceinline__ void a_ready(const Unit&) const {}
    __device__ __forceinline__ void done(const Unit&) const {}
};
constexpr int RPROMPT = 16384;
typedef __bf16 bf2_t __attribute__((ext_vector_type(2)));
typedef float f32x2 __attribute__((ext_vector_type(2)));
__device__ __forceinline__ unsigned cvt_pk_bf16(float lo, float hi) { f32x2 v = {lo, hi}; return __builtin_bit_cast(unsigned, __builtin_convertvector(v, bf2_t)); }
__device__ __forceinline__ u32x4 pack8(const f32x4& a, const f32x4& b) { u32x4 w; w.x = cvt_pk_bf16(a[0], a[1]); w.y = cvt_pk_bf16(a[2], a[3]); w.z = cvt_pk_bf16(b[0], b[1]); w.w = cvt_pk_bf16(b[2], b[3]); return w; }
__device__ __forceinline__ float rstd_of(const float* ss, int row) {
    const f32x4* p = (const f32x4*)(ss + (size_t)row * 32);
    f32x4 a = p[0];
#pragma unroll
    for (int i = 1; i < 8; ++i) a += p[i];
    const float s = (a[0] + a[1]) + (a[2] + a[3]);
    return 1.0f / sqrtf(s * (1.0f / 2048.0f) + 1e-6f);
}
__device__ __forceinline__ float gelu_tanh(float x) {
    const float u = x * (0.7978845608f + 0.0356774081f * x * x);
    const float e = __builtin_amdgcn_exp2f(-2.885390082f * u);
    return x * __builtin_amdgcn_rcpf(1.0f + e);
}
__device__ __forceinline__ float sumsq4(const f32x4& a) { return (a[0] * a[0] + a[1] * a[1]) + (a[2] * a[2] + a[3] * a[3]); }

struct EpiA1 {
    static constexpr bool PERM = true, AFTER_DRAIN = false;
    bf16_t* U; bf16_t* V; float* vss; const float* ss;
    __device__ __forceinline__ void operator()(const f32x4 (&acc)[2][2][4][2], const Unit& u, int wr, int wc, int fr, int fq) const {
        const bool isv = u.pn >= 8; bf16_t* dst = isv ? V : U; const int pt = isv ? u.pn - 8 : u.pn;
        const int col0 = pt * BM + wc * 32 + 8 * fq, row0 = u.pm * BM + wr * 64 + fr;
#pragma unroll
        for (int ai = 0; ai < 2; ++ai)
#pragma unroll
            for (int m = 0; m < 4; ++m) { const int row = row0 + ai * HALF + m * 16; const float rs = rstd_of(ss, row); float q = 0.f;
#pragma unroll
                for (int bj = 0; bj < 2; ++bj) { f32x4 v0 = acc[ai][bj][m][0] * rs, v1 = acc[ai][bj][m][1] * rs;
#pragma unroll
                    for (int j = 0; j < 4; ++j) { v0[j] = gelu_tanh(v0[j]); v1[j] = gelu_tanh(v1[j]); }
                    q += sumsq4(v0) + sumsq4(v1);
                    *(u32x4*)(dst + (size_t)row * 2048 + col0 + bj * HALF) = pack8(v0, v1); }
                if (isv) { q += __shfl_xor(q, 16); q += __shfl_xor(q, 32); if (fq == 0) vss[(size_t)row * 32 + pt * 4 + wc] = q; } }
    }
};
struct EpiResid {
    static constexpr bool PERM = true, AFTER_DRAIN = false;
    const float* base0; const float* base1; float* out; bf16_t* xb; float* ss;
    __device__ __forceinline__ void operator()(const f32x4 (&acc)[2][2][4][2], const Unit& u, int wr, int wc, int fr, int fq) const {
        const int col0 = u.pn * BM + wc * 32 + 8 * fq, row0 = u.pm * BM + wr * 64 + fr;
#pragma unroll
        for (int ai = 0; ai < 2; ++ai)
#pragma unroll
            for (int m = 0; m < 4; ++m) { const int row = row0 + ai * HALF + m * 16; float q = 0.f;
                const float* bp = (row < RPROMPT ? base0 + (size_t)row * 2048 : base1 + (size_t)(row - RPROMPT) * 2048) + col0;
                float* op = out + (size_t)row * 2048 + col0;
#pragma unroll
                for (int bj = 0; bj < 2; ++bj) { const f32x4 o0 = *(const f32x4*)(bp + bj * HALF) + acc[ai][bj][m][0], o1 = *(const f32x4*)(bp + bj * HALF + 4) + acc[ai][bj][m][1];
                    *(f32x4*)(op + bj * HALF) = o0; *(f32x4*)(op + bj * HALF + 4) = o1; q += sumsq4(o0) + sumsq4(o1);
                    *(u32x4*)(xb + (size_t)row * 2048 + col0 + bj * HALF) = pack8(o0, o1); }
                q += __shfl_xor(q, 16); q += __shfl_xor(q, 32); if (fq == 0) ss[(size_t)row * 32 + u.pn * 4 + wc] = q; }
    }
};
struct EpiScale {
    static constexpr bool PERM = true, AFTER_DRAIN = false;
    bf16_t* O; int ldc; const float* ss; float* convp; float* convs;
    __device__ __forceinline__ void operator()(const f32x4 (&acc)[2][2][4][2], const Unit& u, int wr, int wc, int fr, int fq) const {
        const int col0 = u.pn * BM + wc * 32 + 8 * fq, row0 = u.pm * BM + wr * 64 + fr;
#pragma unroll
        for (int ai = 0; ai < 2; ++ai)
#pragma unroll
            for (int m = 0; m < 4; ++m) { const int row = row0 + ai * HALF + m * 16; const float rs = rstd_of(ss, row);
                float* cd = nullptr;
                if (convp) { if (row < RPROMPT) { const int t = row & 2047; if (t >= 2046) cd = convp + (size_t)((row >> 11) * 2 + (t - 2046)) * ldc; }
                             else { const int rr = row - RPROMPT, t = rr & 7; if (t >= 6) cd = convs + (size_t)((rr >> 3) * 2 + (t - 6)) * ldc; } }
#pragma unroll
                for (int bj = 0; bj < 2; ++bj) { const f32x4 v0 = acc[ai][bj][m][0] * rs, v1 = acc[ai][bj][m][1] * rs;
                    *(u32x4*)(O + (size_t)row * ldc + col0 + bj * HALF) = pack8(v0, v1);
                    if (cd) { *(f32x4*)(cd + col0 + bj * HALF) = v0; *(f32x4*)(cd + col0 + bj * HALF + 4) = v1; } } }
    }
};

template <class Epi, class Sched, bool ALIGN_EPI = false, bool SP2 = false>
__device__ __forceinline__ void gemm_phase(PG8_LAS unsigned char* lds, const Gemm g, const Sched& S, const Epi& E) {
    const int tid = threadIdx.x, wid = __builtin_amdgcn_readfirstlane(tid >> 6), lane = tid & 63, wr = wid >> 2, wc = wid & 3, fr = lane & 15, fq = lane >> 4;
    const int K = g.K, nt = K / BK;
    unsigned voffA[2], voffB[2];
#pragma unroll
    for (int i = 0; i < 2; ++i) { int R, C; stage_rc(tid * 16 + i * 8192, R, C); const int Rb = Epi::PERM ? ((R & ~31) + perm32(R & 31)) : R;
        voffA[i] = (unsigned)(R * K + C) * 2u; voffB[i] = (unsigned)(Rb * K + C) * 2u; }
    const size_t kstep = (size_t)(BK * 2);
    const size_t hstep = (size_t)HALF * K * 2;
    const size_t tstep = 2 * hstep;
    const unsigned ldsw = (unsigned)wid * 1024u;
    const int aoff = lds_byte(wr * 64 + fr, fq * 8), boff = lds_byte(wc * 32 + fr, fq * 8);
#define PG8_SA(b, h) (((b) * 2 + (h)) * HTB)
#define PG8_SB(b, h) ((4 + (b) * 2 + (h)) * HTB)
#define PG8_STAGE(bufoff, gbase, voff) do { _Pragma("unroll") for (int _i = 0; _i < 2; ++_i) \
        __builtin_amdgcn_global_load_lds((const unsigned*)((const char*)(gbase) + (voff)[_i]), (PG8_LAS unsigned*)(lds + (bufoff) + ldsw + _i * 8192), 16, 0, 0); } while (0)
#define PG8_LDA(dst, b, h) do { _Pragma("unroll") for (int m = 0; m < 4; ++m) _Pragma("unroll") for (int k = 0; k < 2; ++k) dst[m][k] = *(const PG8_LAS bf16x8*)(lds + PG8_SA(b, h) + aoff + m * 2048 + k * 1024); } while (0)
#define PG8_LDB(dst, b, h) do { _Pragma("unroll") for (int n = 0; n < 2; ++n) _Pragma("unroll") for (int k = 0; k < 2; ++k) dst[n][k] = *(const PG8_LAS bf16x8*)(lds + PG8_SB(b, h) + boff + n * 2048 + k * 1024); } while (0)
#define PG8_MMA(ai, bj, At, Bt) do { __builtin_amdgcn_s_setprio(1); _Pragma("unroll") for (int m = 0; m < 4; ++m) _Pragma("unroll") for (int n = 0; n < 2; ++n) _Pragma("unroll") for (int k = 0; k < 2; ++k) \
        acc[ai][bj][m][n] = __builtin_amdgcn_mfma_f32_16x16x32_bf16(Bt[n][k], At[m][k], acc[ai][bj][m][n], 0, 0, 0); __builtin_amdgcn_s_setprio(0); } while (0)
#define PG8_WAIT_V(n) asm volatile("s_waitcnt vmcnt(" #n ")" ::: "memory")
#define PG8_WAIT_L(n) asm volatile("s_waitcnt lgkmcnt(" #n ")" ::: "memory")
#define PG8_BAR __builtin_amdgcn_s_barrier()
#define PG8_SCHED __builtin_amdgcn_sched_barrier(0)
    Unit cur, nxt; int ui = 0;
    if (!S.next(0, cur)) return;
    f32x4 acc[2][2][4][2];
#pragma unroll
    for (int a = 0; a < 2; ++a)
#pragma unroll
        for (int b = 0; b < 2; ++b)
#pragma unroll
            for (int m = 0; m < 4; ++m)
#pragma unroll
                for (int n = 0; n < 2; ++n) acc[a][b][m][n] = (f32x4){0.f, 0.f, 0.f, 0.f};
    bf16x8 At[4][2], B0[2][2], B1[2][2];
    const char* cA = (const char*)g.A + (size_t)cur.pm * tstep; const char* cB = (const char*)g.Bt + (size_t)cur.pn * tstep;
    S.a_ready(cur);
    if constexpr (SP2) {
        PG8_STAGE(PG8_SB(0, 0), cB, voffB); PG8_STAGE(PG8_SB(0, 1), cB + hstep, voffB); PG8_STAGE(PG8_SA(0, 0), cA, voffA); PG8_STAGE(PG8_SA(0, 1), cA + hstep, voffA);
        if (wr == 1) PG8_BAR;
        PG8_WAIT_V(2); PG8_BAR;
        PG8_STAGE(PG8_SB(1, 0), cB + kstep, voffB); PG8_STAGE(PG8_SA(1, 0), cA + kstep, voffA); PG8_STAGE(PG8_SB(1, 1), cB + hstep + kstep, voffB);
        PG8_WAIT_V(6); PG8_BAR;
    } else {
        PG8_STAGE(PG8_SB(0, 0), cB, voffB); PG8_STAGE(PG8_SA(0, 0), cA, voffA); PG8_STAGE(PG8_SB(0, 1), cB + hstep, voffB); PG8_STAGE(PG8_SA(0, 1), cA + hstep, voffA);
        if (wr == 1) PG8_BAR;
        PG8_WAIT_V(4); PG8_BAR;
        PG8_STAGE(PG8_SB(1, 0), cB + kstep, voffB); PG8_STAGE(PG8_SA(1, 0), cA + kstep, voffA); PG8_STAGE(PG8_SB(1, 1), cB + hstep + kstep, voffB);
        PG8_WAIT_V(6); PG8_BAR;
    }
    for (;;) {
        const bool has_next = S.next(ui + 1, nxt);
        const char* nA = has_next ? (const char*)g.A + (size_t)nxt.pm * tstep : cA; const char* nB = has_next ? (const char*)g.Bt + (size_t)nxt.pn * tstep : cB;
        for (int t = 0; t < nt; t += 2) {
            const bool last = (t == nt - 2);
            const char* a1 = cA + (size_t)(t + 1) * kstep;
            const char* a2 = last ? nA : cA + (size_t)(t + 2) * kstep; const char* b2 = last ? nB : cB + (size_t)(t + 2) * kstep;
            const char* a3 = a2 + kstep; const char* b3 = b2 + kstep;
            if (last && has_next) S.a_ready(nxt);
            if constexpr (SP2) {
            PG8_LDB(B0, 0, 0); PG8_LDB(B1, 0, 1); PG8_SCHED; PG8_LDA(At, 0, 0); PG8_STAGE(PG8_SA(1, 1), a1 + hstep, voffA);
            PG8_WAIT_V(8); PG8_WAIT_L(0); PG8_BAR; PG8_MMA(0, 0, At, B0); PG8_MMA(0, 1, At, B1); PG8_BAR; PG8_SCHED;
            PG8_LDA(At, 0, 1); PG8_STAGE(PG8_SB(0, 0), b2, voffB); PG8_STAGE(PG8_SB(0, 1), b2 + hstep, voffB); PG8_STAGE(PG8_SA(0, 0), a2, voffA);
            PG8_WAIT_V(8); PG8_WAIT_L(0); PG8_BAR; PG8_MMA(1, 0, At, B0); PG8_MMA(1, 1, At, B1); PG8_BAR; PG8_SCHED;
            PG8_LDB(B0, 1, 0); PG8_LDB(B1, 1, 1); PG8_SCHED; PG8_LDA(At, 1, 0); PG8_STAGE(PG8_SA(0, 1), a2 + hstep, voffA);
            PG8_WAIT_V(8); PG8_WAIT_L(0); PG8_BAR; PG8_MMA(0, 0, At, B0); PG8_MMA(0, 1, At, B1); PG8_BAR; PG8_SCHED;
            PG8_LDA(At, 1, 1); PG8_STAGE(PG8_SB(1, 0), b3, voffB); PG8_STAGE(PG8_SB(1, 1), b3 + hstep, voffB); PG8_STAGE(PG8_SA(1, 0), a3, voffA);
            PG8_WAIT_V(8); PG8_WAIT_L(0); PG8_BAR; PG8_MMA(1, 0, At, B0); PG8_MMA(1, 1, At, B1); PG8_BAR; PG8_SCHED;
            } else {
            PG8_LDB(B0, 0, 0); PG8_SCHED; PG8_LDA(At, 0, 0); PG8_STAGE(PG8_SA(1, 1), a1 + hstep, voffA);
            PG8_WAIT_L(8); PG8_BAR; PG8_WAIT_L(0); PG8_MMA(0, 0, At, B0); PG8_BAR; PG8_SCHED;
            PG8_LDB(B1, 0, 1); PG8_STAGE(PG8_SB(0, 0), b2, voffB);
            PG8_BAR; PG8_WAIT_L(0); PG8_MMA(0, 1, At, B1); PG8_BAR;
            PG8_LDA(At, 0, 1); PG8_STAGE(PG8_SA(0, 0), a2, voffA);
            PG8_BAR; PG8_WAIT_L(0); PG8_MMA(1, 0, At, B0); PG8_BAR; PG8_SCHED;
            PG8_STAGE(PG8_SB(0, 1), b2 + hstep, voffB);
            PG8_WAIT_V(6); PG8_BAR; PG8_MMA(1, 1, At, B1); PG8_BAR;
            PG8_LDB(B0, 1, 0); PG8_SCHED; PG8_LDA(At, 1, 0); PG8_STAGE(PG8_SA(0, 1), a2 + hstep, voffA);
            PG8_WAIT_L(8); PG8_BAR; PG8_WAIT_L(0); PG8_MMA(0, 0, At, B0); PG8_BAR; PG8_SCHED;
            PG8_LDB(B1, 1, 1); PG8_STAGE(PG8_SB(1, 0), b3, voffB);
            PG8_BAR; PG8_WAIT_L(0); PG8_MMA(0, 1, At, B1); PG8_BAR;
            PG8_LDA(At, 1, 1); PG8_STAGE(PG8_SA(1, 0), a3, voffA);
            PG8_BAR; PG8_WAIT_L(0); PG8_MMA(1, 0, At, B0); PG8_BAR; PG8_SCHED;
            PG8_STAGE(PG8_SB(1, 1), b3 + hstep, voffB);
            PG8_WAIT_V(6); PG8_BAR; PG8_MMA(1, 1, At, B1); PG8_BAR;
            }
        }
        if constexpr (ALIGN_EPI) { if (wr == 0) PG8_BAR; }
        if constexpr (!Epi::AFTER_DRAIN) { E(acc, cur, wr, wc, fr, fq); S.done(cur); }
        if (!has_next) break;
#pragma unroll
        for (int a = 0; a < 2; ++a)
#pragma unroll
            for (int b = 0; b < 2; ++b)
#pragma unroll
                for (int m = 0; m < 4; ++m)
#pragma unroll
                    for (int n = 0; n < 2; ++n) acc[a][b][m][n] = (f32x4){0.f, 0.f, 0.f, 0.f};
        cur = nxt; cA = nA; cB = nB; ++ui;
        if constexpr (ALIGN_EPI) { if (wr == 1) PG8_BAR; }
    }
    PG8_WAIT_V(0);
    if constexpr (!ALIGN_EPI) { if (wr == 0) PG8_BAR; }
    PG8_BAR;
    if constexpr (Epi::AFTER_DRAIN) { E.fused(acc, cur, wr, wc, fr, fq, lds, wid, lane); S.done(cur); }
#undef PG8_SA
#undef PG8_SB
#undef PG8_STAGE
#undef PG8_LDA
#undef PG8_LDB
#undef PG8_MMA
#undef PG8_WAIT_V
#undef PG8_WAIT_L
#undef PG8_BAR
#undef PG8_SCHED
}
}
constexpr int NWAVES = 8;
constexpr int RP = 16384, RS = 1024, R = RP + RS;
constexpr int DM = 2048, DFF = 5632, DFF2 = 11264, BPROJ = 4176, NBP = 4352;
constexpr float EPS = 1e-6f;
constexpr float QSCALE = 0.08838834764831845f * 1.4426950408889634f;
constexpr size_t OFF_Y = 0, OFF_KP = 35651584, OFF_VP = 44040192, OFF_IKP = 52428800, OFF_KS = 53477376, OFF_VS = 54001664, OFF_IKS = 54525952,
                 OFF_CV = 54591488, OFF_CP = 56688640, OFF_CS = 57049088, OUT_TOTAL = 62816256;
constexpr size_t CTL_BYTES = 1u << 20;
constexpr size_t WS_WAIN = CTL_BYTES;
constexpr size_t WS_WAOUT = WS_WAIN + (size_t)4096 * 2048 * 2;
constexpr size_t WS_WBIN = WS_WAOUT + (size_t)2048 * 2048 * 2;
constexpr size_t WS_WBO = WS_WBIN + (size_t)NBP * 2048 * 2;
constexpr size_t WS_WFIN = WS_WBO + (size_t)2048 * 2048 * 2;
constexpr size_t WS_WFOUT = WS_WFIN + (size_t)2 * DFF2 * 2048 * 2;
constexpr size_t WS_XB = WS_WFOUT + (size_t)2 * 2048 * DFF * 2;
constexpr size_t WS_SS = WS_XB + (size_t)R * 2048 * 2;
constexpr size_t WS_XA = WS_SS + (size_t)R * 32 * 4;
constexpr size_t WS_U = WS_XA + (size_t)R * 2048 * 4;
constexpr size_t WS_V = WS_U + (size_t)R * 2048 * 2;
constexpr size_t WS_VSS = WS_V + (size_t)R * 2048 * 2;
constexpr size_t WS_GT = WS_VSS + (size_t)R * 32 * 4;
constexpr size_t WS_AB = WS_GT + (size_t)R * 2048 * 2;
constexpr size_t WS_HID = WS_AB + (size_t)R * DFF2 * 2;
constexpr size_t WS_P = WS_HID + (size_t)R * DFF * 2;
constexpr size_t WS_Q = WS_P + (size_t)R * NBP * 2;
constexpr size_t WS_KB = WS_Q + (size_t)R * 2048 * 2;
constexpr size_t WS_VB = WS_KB + (size_t)R * 512 * 2;
constexpr size_t WS_IQ = WS_VB + (size_t)R * 512 * 2;
constexpr size_t WS_IK = WS_IQ + (size_t)R * 1024 * 2;
constexpr size_t WS_IW = WS_IK + (size_t)R * 64 * 2;
constexpr size_t WS_ROPE = WS_IW + (size_t)R * 16 * 4;
constexpr size_t WS_SC = WS_ROPE + (size_t)2056 * 96 * 2 * 4;
constexpr size_t WS_SCS = WS_SC + (size_t)RP * 2048 * 4;
constexpr size_t WS_MASK = WS_SCS + (size_t)RS * 2112 * 4;
constexpr size_t WS_O = WS_MASK + (size_t)R * 34 * 8;
constexpr size_t WS_END = WS_O + (size_t)R * 2048 * 2;
constexpr int CW_BAR = 4096;
constexpr int CW_WQ = 8192;
constexpr int CW_CHK = 16384;
constexpr int LDS_BYTES = 147456;
constexpr int MISC_OFF = 147456 - 256;

#define GAS __attribute__((address_space(1)))
#define LAS __attribute__((address_space(3)))
#define DI __device__ __forceinline__
typedef unsigned short bf16;
typedef unsigned v4u __attribute__((ext_vector_type(4)));
typedef unsigned v2u __attribute__((ext_vector_type(2)));
typedef float f32x4 __attribute__((ext_vector_type(4)));
typedef float f32x16 __attribute__((ext_vector_type(16)));
typedef short bf16x8 __attribute__((ext_vector_type(8)));
typedef GAS unsigned gu32;
#define RLX_AGENT __ATOMIC_RELAXED, __HIP_MEMORY_SCOPE_AGENT
#define LDS_WAIT() asm volatile("s_waitcnt lgkmcnt(0)" ::: "memory")
#define MFMA32(a, b, c) __builtin_amdgcn_mfma_f32_32x32x16_bf16((a), (b), (c), 0, 0, 0)
#define MFMA16(a, b, c) __builtin_amdgcn_mfma_f32_16x16x32_bf16((a), (b), (c), 0, 0, 0)
DI float bf2f(unsigned short h) { return __uint_as_float(((unsigned)h) << 16); }
DI float bflo(unsigned w) { return __uint_as_float(w << 16); }
DI float bfhi(unsigned w) { return __uint_as_float(w & 0xffff0000u); }
DI unsigned pk2(float lo, float hi) { return pg8::cvt_pk_bf16(lo, hi); }
DI unsigned short f2bf(float f) { return (unsigned short)(pk2(f, 0.f) & 0xffffu); }
DI float wave_sum(float v) {
#pragma unroll
    for (int o = 1; o < 64; o <<= 1) v += __shfl_xor(v, o);
    return v;
}
DI float fexp2(float x) { return __builtin_amdgcn_exp2f(x); }
#define XB_TMO      128
#define XB_XCNT(j)  (256  + 64 * (j))
#define XB_XSUB(j)  (1280 + 64 * (j))
#define XB_XGEN(j)  (2304 + 64 * (j))
#define XB_TOP      3328
#define XB_TOPGEN   3392
#define XCD_BAR_WORDS 3456
#define XB_SPIN_CAP (1u << 18)

__device__ __forceinline__ unsigned xb_ld(unsigned* p)              { return __hip_atomic_load(p, __ATOMIC_RELAXED, __HIP_MEMORY_SCOPE_AGENT); }
__device__ __forceinline__ unsigned xb_add(unsigned* p, unsigned v) { return __hip_atomic_fetch_add(p, v, __ATOMIC_RELAXED, __HIP_MEMORY_SCOPE_AGENT); }
__device__ __forceinline__ unsigned xb_xcc_id() { return (unsigned)__builtin_amdgcn_s_getreg((3 << 11) | 20) & 0xFu; }
#define XB_SPIN(cond, bar) do { unsigned _sp = 0; while (cond) { __builtin_amdgcn_s_sleep(1); \
    if ((++_sp & 255u) == 0u) { if (xb_ld(&(bar)[XB_TMO])) break; if (_sp > XB_SPIN_CAP) { atomicAdd(&(bar)[XB_TMO], 1u); break; } } } } while (0)

struct XcdBarrier {
    unsigned* bar; unsigned x;
    volatile LAS unsigned* st;
};

__device__ __forceinline__ XcdBarrier xcd_barrier_post(unsigned* bar, volatile LAS unsigned* st) {
    XcdBarrier b; b.bar = bar; b.x = xb_xcc_id(); b.st = st;
    if (threadIdx.x == 0) (void)xb_add(&bar[XB_XCNT(b.x)], 1u);
    return b;
}
__device__ __forceinline__ void xcd_barrier_complete(unsigned* bar, unsigned x, unsigned& nloc, unsigned& nx) {
    const unsigned G = gridDim.x * gridDim.y * gridDim.z;
    unsigned sum, cnt, mine, sp = 0u;
    for (;;) {
        sum = 0u; cnt = 0u; mine = 0u;
#pragma unroll
        for (unsigned j = 0; j < 16; ++j) { const unsigned c = xb_ld(&bar[XB_XCNT(j)]); sum += c; cnt += (c > 0u) ? 1u : 0u; mine = (j == x) ? c : mine; }
        if (sum == G) break;
        __builtin_amdgcn_s_sleep(1);
        if ((++sp & 255u) == 0u) { if (xb_ld(&bar[XB_TMO])) break; if (sp > XB_SPIN_CAP) { atomicAdd(&bar[XB_TMO], 1u); break; } }
    }
    nloc = mine > 0u ? mine : 1u; nx = cnt > 0u ? cnt : 1u;
}

__device__ __forceinline__ void xcd_barrier(const XcdBarrier& b) {
    asm volatile("s_waitcnt vmcnt(0)" ::: "memory");
    __syncthreads();
    if (threadIdx.x == 0) {
        unsigned* bar = b.bar;
        __builtin_amdgcn_s_waitcnt(0);
        unsigned nloc = b.st[0], nx = b.st[1];
        if (nloc == 0u) { xcd_barrier_complete(bar, b.x, nloc, nx); b.st[0] = nloc; b.st[1] = nx; }
        const unsigned old = xb_add(&bar[XB_XSUB(b.x)], 1u);
        const unsigned gen = old / nloc;
        if (old + 1u == (gen + 1u) * nloc) {
            __builtin_amdgcn_fence(__ATOMIC_RELEASE, "agent");
            asm volatile("s_waitcnt vmcnt(0)" ::: "memory");
            const unsigned og = xb_add(&bar[XB_TOP], 1u);
            const unsigned tg = og / nx;
            if (og + 1u == (tg + 1u) * nx) xb_add(&bar[XB_TOPGEN], 1u);
            else XB_SPIN(xb_ld(&bar[XB_TOPGEN]) == tg, bar);
            __builtin_amdgcn_fence(__ATOMIC_ACQUIRE, "agent");
            xb_add(&bar[XB_XGEN(b.x)], 1u);
            asm volatile("s_waitcnt vmcnt(0)" ::: "memory");
        } else {
            XB_SPIN(xb_ld(&bar[XB_XGEN(b.x)]) == gen, bar);
            __builtin_amdgcn_fence(__ATOMIC_ACQUIRE, "agent");
            asm volatile("s_waitcnt vmcnt(0)" ::: "memory");
        }
    }
    __syncthreads();
}
struct Args { const float* in[23]; float* out; unsigned char* ws; int ph_lo, ph_hi; };
struct Ctx { LAS unsigned char* lds; int tid, lane, wave, G, bx; };

DI void p0_transpose_item(const float* W, const float* gain, int K, int N, int Npad, bf16* WT, LAS float* scr, int item, int lane) {
    const int nblk = Npad / 32, kb = item / nblk, nb = item % nblk, k0 = 64 * kb, n0 = 32 * nb;
    const int n = n0 + (lane & 31);
#pragma unroll 8
    for (int i = 0; i < 32; ++i) { const int kk = 2 * i + (lane >> 5);
        float v = 0.f; if (n < N) { v = W[(size_t)(k0 + kk) * N + n]; if (gain) v *= gain[k0 + kk]; }
        scr[kk * 33 + (lane & 31)] = v; }
    LDS_WAIT(); asm volatile("" ::: "memory");
    const int c = lane & 7;
#pragma unroll
    for (int j = 0; j < 4; ++j) { const int nn = (lane >> 3) + 8 * j; const LAS float* s = scr + (8 * c) * 33 + nn;
        v4u o; o.x = pk2(s[0 * 33], s[1 * 33]); o.y = pk2(s[2 * 33], s[3 * 33]); o.z = pk2(s[4 * 33], s[5 * 33]); o.w = pk2(s[6 * 33], s[7 * 33]);
        *(GAS v4u*)(WT + (size_t)(n0 + nn) * K + k0 + 8 * c) = o; }
    LDS_WAIT(); asm volatile("" ::: "memory");
}
DI void sincos_small(double r, double& s, double& c) {
    const double r2 = r * r;
    double ts = 1.0 / 51090942171709440000.0;
    ts = ts * r2 * (-1.0) + 1.0 / 121645100408832000.0;
    ts = ts * (-r2) + 1.0 / 355687428096000.0;
    ts = ts * (-r2) + 1.0 / 1307674368000.0;
    ts = ts * (-r2) + 1.0 / 6227020800.0;
    ts = ts * (-r2) + 1.0 / 39916800.0;
    ts = ts * (-r2) + 1.0 / 362880.0;
    ts = ts * (-r2) + 1.0 / 5040.0;
    ts = ts * (-r2) + 1.0 / 120.0;
    ts = ts * (-r2) + 1.0 / 6.0;
    ts = ts * (-r2) + 1.0;
    s = ts * r;
    double tc = 1.0 / 2432902008176640000.0;
    tc = tc * (-r2) + 1.0 / 6402373705728000.0;
    tc = tc * (-r2) + 1.0 / 20922789888000.0;
    tc = tc * (-r2) + 1.0 / 87178291200.0;
    tc = tc * (-r2) + 1.0 / 479001600.0;
    tc = tc * (-r2) + 1.0 / 3628800.0;
    tc = tc * (-r2) + 1.0 / 40320.0;
    tc = tc * (-r2) + 1.0 / 720.0;
    tc = tc * (-r2) + 1.0 / 24.0;
    tc = tc * (-r2) + 1.0 / 2.0;
    tc = tc * (-r2) + 1.0;
    c = tc;
}
DI void ph_prologue(const Args& a, const Ctx& C) {
    unsigned char* ws = a.ws;
    LAS float* scr = (LAS float*)(C.lds + C.wave * 16384);
    const int gw = C.bx * NWAVES + C.wave, NGW = C.G * NWAVES;
    constexpr int I_AIN = 32 * 128, I_AOUT = 32 * 64, I_BIN = 32 * (NBP / 32), I_BO = 32 * 64, I_FIN = 32 * (DFF2 / 32), I_FOUT = (DFF / 64) * 64;
    constexpr int NITEMS = I_AIN + I_AOUT + I_BIN + I_BO + 2 * I_FIN + 2 * I_FOUT;
    for (int it = gw; it < NITEMS; it += NGW) {
        int r = it;
        if (r < I_AIN) { p0_transpose_item(a.in[8], a.in[7], 2048, 4096, 4096, (bf16*)(ws + WS_WAIN), scr, r, C.lane); continue; } r -= I_AIN;
        if (r < I_AOUT) { p0_transpose_item(a.in[12], nullptr, 2048, 2048, 2048, (bf16*)(ws + WS_WAOUT), scr, r, C.lane); continue; } r -= I_AOUT;
        if (r < I_BIN) { p0_transpose_item(a.in[14], a.in[13], 2048, BPROJ, NBP, (bf16*)(ws + WS_WBIN), scr, r, C.lane); continue; } r -= I_BIN;
        if (r < I_BO) { p0_transpose_item(a.in[17], nullptr, 2048, 2048, 2048, (bf16*)(ws + WS_WBO), scr, r, C.lane); continue; } r -= I_BO;
        if (r < 2 * I_FIN) { const int l = r / I_FIN; p0_transpose_item(a.in[19] + (size_t)l * 2048 * DFF2, a.in[18] + l * 2048, 2048, DFF2, DFF2, (bf16*)(ws + WS_WFIN) + (size_t)l * DFF2 * 2048, scr, r % I_FIN, C.lane); continue; } r -= 2 * I_FIN;
        { const int l = r / I_FOUT; p0_transpose_item(a.in[22] + (size_t)l * DFF * 2048, nullptr, DFF, 2048, 2048, (bf16*)(ws + WS_WFOUT) + (size_t)l * 2048 * DFF, scr, r % I_FOUT, C.lane); }
    }
    bf16* XB = (bf16*)(ws + WS_XB); float* SS = (float*)(ws + WS_SS);
    for (int row = gw; row < R; row += NGW) {
        const float* src = row < RP ? a.in[0] + (size_t)row * 2048 : a.in[1] + (size_t)(row - RP) * 2048;
        const GAS f32x4* xr = (const GAS f32x4*)src + C.lane; float s = 0.f;
        GAS v2u* o8 = (GAS v2u*)(XB + (size_t)row * 2048) + C.lane;
#pragma unroll
        for (int j = 0; j < 8; ++j) { const f32x4 v = xr[64 * j]; s += (v[0] * v[0] + v[1] * v[1]) + (v[2] * v[2] + v[3] * v[3]); v2u w; w.x = pk2(v[0], v[1]); w.y = pk2(v[2], v[3]); o8[64 * j] = w; }
        s = wave_sum(s);
        if (C.lane < 32) SS[(size_t)row * 32 + C.lane] = C.lane == 0 ? s : 0.f;
    }
    float* rope = (float*)(ws + WS_ROPE);
    for (int idx = C.bx * 512 + C.tid; idx < 2056 * 96; idx += C.G * 512) {
        const int pos = idx / 96, i = idx % 96;
        const float ex = i < 64 ? (float)i * (2.0f / 128.0f) : (float)(i - 64) * (2.0f / 64.0f);
        const float inv = exp2f(-ex * 13.287712379549449f);
        const double ang = (double)pos * (double)inv;
        const double k = __builtin_rint(ang * 0.15915494309189535);
        const double rr = ang - k * 6.283185307179586;
        double sn, cs; sincos_small(rr, sn, cs);
        rope[2 * idx] = (float)cs; rope[2 * idx + 1] = (float)sn;
    }
}
DI float rstd32(const float* p) { const f32x4* q = (const f32x4*)p; f32x4 a = q[0];
#pragma unroll
    for (int i = 1; i < 8; ++i) a += q[i];
    return 1.0f / sqrtf(((a[0] + a[1]) + (a[2] + a[3])) * (1.0f / 2048.0f) + EPS); }
DI void ph_gate(const Args& a, const Ctx& C) {
    unsigned char* ws = a.ws;
    const bf16* V = (const bf16*)(ws + WS_V); const bf16* U = (const bf16*)(ws + WS_U); bf16* GT = (bf16*)(ws + WS_GT); const float* vss = (const float*)(ws + WS_VSS);
    const float* vgain = a.in[9]; const float* Ws = a.in[10]; const float* bs = a.in[11];
    LAS unsigned char* vt = C.lds;
    LAS float* rsv = (LAS float*)(C.lds + 36864);
    const int l15 = C.lane & 15, kq = C.lane >> 4;
    int gcur = -1; bf16x8 wf[4];
#pragma unroll
    for (int kk = 0; kk < 4; ++kk) wf[kk] = (bf16x8){0, 0, 0, 0, 0, 0, 0, 0};
    for (int u = C.bx; u < 2048; u += C.G) {
        const int g = u & 15, chunk = u >> 4, r0 = chunk * 128;
        if (g != gcur) { gcur = g; const int t = 16 * C.wave + l15;
#pragma unroll
            for (int kk = 0; kk < 4; ++kk) { const int s0 = 32 * kk + 8 * kq; const float* wp = Ws + ((size_t)g * 128 + t) * 128 + s0;
                const f32x4 w0 = *(const f32x4*)wp, w1 = *(const f32x4*)(wp + 4); v4u o;
                o.x = pk2(s0 + 0 <= t ? w0[0] : 0.f, s0 + 1 <= t ? w0[1] : 0.f); o.y = pk2(s0 + 2 <= t ? w0[2] : 0.f, s0 + 3 <= t ? w0[3] : 0.f);
                o.z = pk2(s0 + 4 <= t ? w1[0] : 0.f, s0 + 5 <= t ? w1[1] : 0.f); o.w = pk2(s0 + 6 <= t ? w1[2] : 0.f, s0 + 7 <= t ? w1[3] : 0.f);
                wf[kk] = __builtin_bit_cast(bf16x8, o); } }
        if (C.tid < 128) rsv[C.tid] = rstd32(vss + (size_t)(r0 + C.tid) * 32);
        __syncthreads();
#pragma unroll
        for (int it = 0; it < 4; ++it) { const int id = C.tid + 512 * it, s = id >> 4, c = id & 15;
            const v4u raw = *(const v4u*)(V + (size_t)(r0 + s) * 2048 + g * 128 + c * 8); const float rs = rsv[s];
            const f32x4 g0 = *(const f32x4*)(vgain + g * 128 + c * 8), g1 = *(const f32x4*)(vgain + g * 128 + c * 8 + 4);
            float x[8] = {bflo(raw.x) * g0[0], bfhi(raw.x) * g0[1], bflo(raw.y) * g0[2], bfhi(raw.y) * g0[3], bflo(raw.z) * g1[0], bfhi(raw.z) * g1[1], bflo(raw.w) * g1[2], bfhi(raw.w) * g1[3]};
#pragma unroll
            for (int i = 0; i < 8; ++i) *(LAS bf16*)(vt + (c * 8 + i) * 272 + s * 2) = f2bf(x[i] * rs); }
        __syncthreads();
        const int t = 16 * C.wave + l15, row = r0 + t; const float bias = bs[g * 128 + t];
#pragma unroll
        for (int db = 0; db < 8; ++db) { f32x4 acc = {0.f, 0.f, 0.f, 0.f};
#pragma unroll
            for (int kk = 0; kk < 4; ++kk) if (kk <= (C.wave >> 1)) { const bf16x8 av = *(const LAS bf16x8*)(vt + (db * 16 + l15) * 272 + (kk * 32 + kq * 8) * 2); acc = MFMA16(av, wf[kk], acc); }
            const size_t off = (size_t)row * 2048 + g * 128 + db * 16 + 4 * kq;
            const v2u uu = *(const v2u*)(U + off); v2u o;
            o.x = pk2(bflo(uu.x) * (acc[0] + bias), bfhi(uu.x) * (acc[1] + bias)); o.y = pk2(bflo(uu.y) * (acc[2] + bias), bfhi(uu.y) * (acc[3] + bias));
            *(v2u*)(GT + off) = o; }
        __syncthreads();
    }
    float* cvout = a.out + OFF_CV;
    for (int us = C.bx; us < 32; us += C.G) {
        const int r0 = RP + 32 * us;
        if (C.tid < 32) rsv[C.tid] = rstd32(vss + (size_t)(r0 + C.tid) * 32);
        __syncthreads();
#pragma unroll 1
        for (int it = 0; it < 2; ++it) { const int id = C.tid + 512 * it, bl = id >> 8, c = id & 255, col = c * 8, g = col >> 7;
            const f32x4 g0 = *(const f32x4*)(vgain + col), g1 = *(const f32x4*)(vgain + col + 4);
            float vn[8][8];
#pragma unroll
            for (int t = 0; t < 8; ++t) { const size_t off = (size_t)(r0 + 8 * bl + t) * 2048 + col; const v4u raw = *(const v4u*)(V + off); const float rs = rsv[8 * bl + t];
                vn[t][0] = bflo(raw.x) * rs * g0[0]; vn[t][1] = bfhi(raw.x) * rs * g0[1]; vn[t][2] = bflo(raw.y) * rs * g0[2]; vn[t][3] = bfhi(raw.y) * rs * g0[3];
                vn[t][4] = bflo(raw.z) * rs * g1[0]; vn[t][5] = bfhi(raw.z) * rs * g1[1]; vn[t][6] = bflo(raw.w) * rs * g1[2]; vn[t][7] = bfhi(raw.w) * rs * g1[3];
                float* co = cvout + (size_t)(32 * us + 8 * bl + t) * 2048 + col;
                *(f32x4*)co = (f32x4){vn[t][0], vn[t][1], vn[t][2], vn[t][3]}; *(f32x4*)(co + 4) = (f32x4){vn[t][4], vn[t][5], vn[t][6], vn[t][7]}; }
#pragma unroll
            for (int t = 0; t < 8; ++t) { float s[8]; const float bias = bs[g * 128 + t];
#pragma unroll
                for (int i = 0; i < 8; ++i) s[i] = bias;
#pragma unroll
                for (int sp = 0; sp <= t; ++sp) { const float wv = Ws[((size_t)g * 128 + t) * 128 + sp];
#pragma unroll
                    for (int i = 0; i < 8; ++i) s[i] += wv * vn[sp][i]; }
                const size_t off = (size_t)(r0 + 8 * bl + t) * 2048 + col; const v4u uu = *(const v4u*)(U + off); v4u o;
                o.x = pk2(bflo(uu.x) * s[0], bfhi(uu.x) * s[1]); o.y = pk2(bflo(uu.y) * s[2], bfhi(uu.y) * s[3]); o.z = pk2(bflo(uu.z) * s[4], bfhi(uu.z) * s[5]); o.w = pk2(bflo(uu.w) * s[6], bfhi(uu.w) * s[7]);
                *(v4u*)(GT + off) = o; } }
        __syncthreads();
    }
}
DI void up8(const v4u& r, float (&x)[8]) { x[0] = bflo(r.x); x[1] = bfhi(r.x); x[2] = bflo(r.y); x[3] = bfhi(r.y); x[4] = bflo(r.z); x[5] = bfhi(r.z); x[6] = bflo(r.w); x[7] = bfhi(r.w); }
DI void ld8(const float* p, float (&x)[8]) { const f32x4 a = *(const f32x4*)p, b = *(const f32x4*)(p + 4); x[0] = a[0]; x[1] = a[1]; x[2] = a[2]; x[3] = a[3]; x[4] = b[0]; x[5] = b[1]; x[6] = b[2]; x[7] = b[3]; }
DI void ph_conv(const Args& a, const Ctx& C, int layer) {
    unsigned char* ws = a.ws;
    const bf16* AB = (const bf16*)(ws + WS_AB); bf16* HID = (bf16*)(ws + WS_HID);
    const float* cw = a.in[20] + (size_t)layer * 3 * DFF2; const float* cb = a.in[21] + (size_t)layer * DFF2; const float* st = a.in[5] + (size_t)layer * 128 * 2 * DFF2;
    constexpr int NCC = DFF / 8, NRB = R / 32;
    for (int item = C.bx * 512 + C.tid; item < NRB * NCC; item += C.G * 512) {
        const int rb = item / NCC, cc = item % NCC, col = cc * 8, r0 = rb * 32;
        float w0g[8], w1g[8], w2g[8], bg[8], w0u[8], w1u[8], w2u[8], bu[8];
        ld8(cw + col, w0g); ld8(cw + DFF2 + col, w1g); ld8(cw + 2 * DFF2 + col, w2g); ld8(cb + col, bg);
        ld8(cw + DFF + col, w0u); ld8(cw + DFF2 + DFF + col, w1u); ld8(cw + 2 * DFF2 + DFF + col, w2u); ld8(cb + DFF + col, bu);
        float g1[8], g2[8], u1[8], u2[8];
#pragma unroll
        for (int i = 0; i < 8; ++i) { g1[i] = 0.f; g2[i] = 0.f; u1[i] = 0.f; u2[i] = 0.f; }
        if (r0 < RP && (r0 & 2047) != 0) {
            up8(*(const v4u*)(AB + (size_t)(r0 - 1) * DFF2 + col), g1); up8(*(const v4u*)(AB + (size_t)(r0 - 2) * DFF2 + col), g2);
            up8(*(const v4u*)(AB + (size_t)(r0 - 1) * DFF2 + DFF + col), u1); up8(*(const v4u*)(AB + (size_t)(r0 - 2) * DFF2 + DFF + col), u2); }
#pragma unroll 1
        for (int rr = 0; rr < 32; ++rr) { const int row = r0 + rr;
            if (r0 >= RP && (rr & 7) == 0) { const int b = (row - RP) >> 3;
                ld8(st + (size_t)(b * 2 + 0) * DFF2 + col, g2); ld8(st + (size_t)(b * 2 + 1) * DFF2 + col, g1);
                ld8(st + (size_t)(b * 2 + 0) * DFF2 + DFF + col, u2); ld8(st + (size_t)(b * 2 + 1) * DFF2 + DFF + col, u1); }
            float g0[8], u0[8]; up8(*(const v4u*)(AB + (size_t)row * DFF2 + col), g0); up8(*(const v4u*)(AB + (size_t)row * DFF2 + DFF + col), u0);
            float h[8];
#pragma unroll
            for (int i = 0; i < 8; ++i) { const float cg = bg[i] + w0g[i] * g2[i] + w1g[i] * g1[i] + w2g[i] * g0[i], cu = bu[i] + w0u[i] * u2[i] + w1u[i] * u1[i] + w2u[i] * u0[i];
                h[i] = cg * __builtin_amdgcn_rcpf(1.0f + fexp2(-1.4426950408889634f * cg)) * cu; g2[i] = g1[i]; g1[i] = g0[i]; u2[i] = u1[i]; u1[i] = u0[i]; }
            v4u o; o.x = pk2(h[0], h[1]); o.y = pk2(h[2], h[3]); o.z = pk2(h[4], h[5]); o.w = pk2(h[6], h[7]);
            *(v4u*)(HID + (size_t)row * DFF + col) = o; }
    }
}
DI void ph_qkrope(const Args& a, const Ctx& C) {
    unsigned char* ws = a.ws;
    const bf16* P = (const bf16*)(ws + WS_P); const float* rope = (const float*)(ws + WS_ROPE);
    bf16* Q = (bf16*)(ws + WS_Q); bf16* KB = (bf16*)(ws + WS_KB); bf16* VB = (bf16*)(ws + WS_VB); bf16* IQ = (bf16*)(ws + WS_IQ); bf16* IK = (bf16*)(ws + WS_IK); float* IW = (float*)(ws + WS_IW);
    const float* qgain = a.in[15]; const float* kgain = a.in[16];
    const int gw = C.bx * NWAVES + C.wave, NGW = C.G * NWAVES, lane = C.lane;
    const float qg1 = qgain[lane], qg2 = qgain[64 + lane], kg1 = kgain[lane], kg2 = kgain[64 + lane];
    for (int row = gw; row < R; row += NGW) {
        const bf16* p = P + (size_t)row * NBP;
        const int pos = row < RP ? (row & 2047) : 2048 + ((row - RP) & 7);
        const float* rt = rope + (size_t)pos * 192;
        const float c1 = rt[2 * lane], s1 = rt[2 * lane + 1];
        float* kout = row < RP ? a.out + OFF_KP + (size_t)row * 512 : a.out + OFF_KS + (size_t)(row - RP) * 512;
        float* vout = row < RP ? a.out + OFF_VP + (size_t)row * 512 : a.out + OFF_VS + (size_t)(row - RP) * 512;
        float* ikout = row < RP ? a.out + OFF_IKP + (size_t)row * 64 : a.out + OFF_IKS + (size_t)(row - RP) * 64;
#pragma unroll 4
        for (int h = 0; h < 16; ++h) { const float x1 = bf2f(p[h * 128 + lane]), x2 = bf2f(p[h * 128 + 64 + lane]);
            const float rs = 1.0f / sqrtf(wave_sum(x1 * x1 + x2 * x2) * (1.0f / 128.0f) + EPS);
            const float y1 = x1 * rs * qg1, y2 = x2 * rs * qg2;
            Q[(size_t)row * 2048 + h * 128 + lane] = f2bf((y1 * c1 - y2 * s1) * QSCALE); Q[(size_t)row * 2048 + h * 128 + 64 + lane] = f2bf((y2 * c1 + y1 * s1) * QSCALE); }
#pragma unroll
        for (int h = 0; h < 4; ++h) { const float x1 = bf2f(p[2048 + h * 128 + lane]), x2 = bf2f(p[2048 + h * 128 + 64 + lane]);
            const float rs = 1.0f / sqrtf(wave_sum(x1 * x1 + x2 * x2) * (1.0f / 128.0f) + EPS);
            const float y1 = x1 * rs * kg1, y2 = x2 * rs * kg2, o1 = y1 * c1 - y2 * s1, o2 = y2 * c1 + y1 * s1;
            KB[(size_t)row * 512 + h * 128 + lane] = f2bf(o1); KB[(size_t)row * 512 + h * 128 + 64 + lane] = f2bf(o2);
            kout[h * 128 + lane] = o1; kout[h * 128 + 64 + lane] = o2; }
        { const v4u raw = *(const v4u*)(p + 2560 + lane * 8); *(v4u*)(VB + (size_t)row * 512 + lane * 8) = raw; float x[8]; up8(raw, x);
          *(f32x4*)(vout + lane * 8) = (f32x4){x[0], x[1], x[2], x[3]}; *(f32x4*)(vout + lane * 8 + 4) = (f32x4){x[4], x[5], x[6], x[7]}; }
        const int i = lane & 31, hs = lane >> 5; const float c2 = rt[2 * (64 + i)], s2 = rt[2 * (64 + i) + 1];
#pragma unroll 4
        for (int hp = 0; hp < 8; ++hp) { const int hd = 2 * hp + hs; const float x1 = bf2f(p[3072 + hd * 64 + i]), x2 = bf2f(p[3072 + hd * 64 + 32 + i]);
            IQ[(size_t)row * 1024 + hd * 64 + i] = f2bf(x1 * c2 - x2 * s2); IQ[(size_t)row * 1024 + hd * 64 + 32 + i] = f2bf(x2 * c2 + x1 * s2); }
        if (lane < 32) { const float x1 = bf2f(p[4096 + i]), x2 = bf2f(p[4096 + 32 + i]), o1 = x1 * c2 - x2 * s2, o2 = x2 * c2 + x1 * s2;
            IK[(size_t)row * 64 + i] = f2bf(o1); IK[(size_t)row * 64 + 32 + i] = f2bf(o2); ikout[i] = o1; ikout[32 + i] = o2; }
        if (lane < 16) IW[(size_t)row * 16 + lane] = bf2f(p[4160 + lane]) * 0.03125f;
    }
}
DI int wq_next(gu32* head, volatile LAS int* slot, int tid) {
    __syncthreads();
    if (tid == 0) *slot = (int)__hip_atomic_fetch_add(head, 1u, RLX_AGENT);
    __syncthreads();
    return *slot;
}
DI void idx_prompt_unit(const Args& a, const Ctx& C, int b, int qb) {
    unsigned char* ws = a.ws;
    const bf16* IQ = (const bf16*)(ws + WS_IQ); const bf16* IK = (const bf16*)(ws + WS_IK); const float* IW = (const float*)(ws + WS_IW); float* SC = (float*)(ws + WS_SC);
    LAS unsigned char* iql = C.lds;
    { const bf16* src = IQ + (size_t)(b * 2048 + qb * 64) * 1024;
#pragma unroll 4
      for (int i = 0; i < 16; ++i) { const int id = C.tid + 512 * i, row = id >> 7, ch = id & 127; *(LAS v4u*)(iql + row * 2064 + ch * 16) = *(const v4u*)(src + (size_t)row * 1024 + ch * 8); } }
    __syncthreads();
    const int qg = C.wave & 1, kg = C.wave >> 1, r = C.lane & 31, hh = C.lane >> 5;
    const int qrow = b * 2048 + qb * 64 + qg * 32 + r;
    const float* wrow = IW + (size_t)qrow * 16;
    const int nsteps = (qb * 64 + 64 + 255) >> 8;
    for (int st = 0; st < nsteps; ++st) {
        const int s0 = st * 256 + kg * 64;
        if (s0 <= qb * 64 + 63) {
            bf16x8 ka[2][4];
#pragma unroll
            for (int sb = 0; sb < 2; ++sb)
#pragma unroll
                for (int kk = 0; kk < 4; ++kk) ka[sb][kk] = *(const bf16x8*)(IK + (size_t)(b * 2048 + s0 + sb * 32 + r) * 64 + kk * 16 + hh * 8);
            f32x16 acc0, acc1;
#pragma unroll
            for (int e = 0; e < 16; ++e) { acc0[e] = 0.f; acc1[e] = 0.f; }
#pragma unroll 1
            for (int h = 0; h < 16; ++h) {
                const float wh = wrow[h];
                bf16x8 qf[4];
#pragma unroll
                for (int kk = 0; kk < 4; ++kk) qf[kk] = *(const LAS bf16x8*)(iql + (qg * 32 + r) * 2064 + h * 128 + kk * 32 + hh * 16);
                f32x16 c0, c1;
#pragma unroll
                for (int e = 0; e < 16; ++e) { c0[e] = 0.f; c1[e] = 0.f; }
#pragma unroll
                for (int kk = 0; kk < 4; ++kk) { c0 = MFMA32(ka[0][kk], qf[kk], c0); c1 = MFMA32(ka[1][kk], qf[kk], c1); }
#pragma unroll
                for (int e = 0; e < 16; ++e) { acc0[e] += wh * fmaxf(c0[e], 0.f); acc1[e] += wh * fmaxf(c1[e], 0.f); }
            }
            float* dst = SC + (size_t)qrow * 2048 + s0 + 4 * hh;
#pragma unroll
            for (int rg = 0; rg < 4; ++rg) { *(f32x4*)(dst + 8 * rg) = (f32x4){acc0[4 * rg], acc0[4 * rg + 1], acc0[4 * rg + 2], acc0[4 * rg + 3]};
                                             *(f32x4*)(dst + 32 + 8 * rg) = (f32x4){acc1[4 * rg], acc1[4 * rg + 1], acc1[4 * rg + 2], acc1[4 * rg + 3]}; }
        }
    }
}
DI void idx_sample_unit(const Args& a, const Ctx& C, int b) {
    unsigned char* ws = a.ws;
    const bf16* IQ = (const bf16*)(ws + WS_IQ); const bf16* IK = (const bf16*)(ws + WS_IK); const float* IW = (const float*)(ws + WS_IW); float* SCS = (float*)(ws + WS_SCS);
    const float* cik = a.in[4]; const int* pt = (const int*)a.in[6] + b * 16;
    const int r = C.lane & 31, hh = C.lane >> 5;
    bf16x8 qa[4][4];
#pragma unroll
    for (int blk = 0; blk < 4; ++blk)
#pragma unroll
        for (int kk = 0; kk < 4; ++kk) qa[blk][kk] = *(const bf16x8*)(IQ + (size_t)(RP + 8 * b + 2 * blk + (r >> 4)) * 1024 + (r & 15) * 64 + kk * 16 + hh * 8);
    for (int kb = C.wave; kb < 65; kb += 8) {
        bf16x8 kf[4];
        if (kb < 64) { const int s = 32 * kb + r; const float* kp = cik + ((size_t)pt[s >> 7] * 128 + (s & 127)) * 64 + hh * 8;
#pragma unroll
            for (int kk = 0; kk < 4; ++kk) { const f32x4 x0 = *(const f32x4*)(kp + kk * 16), x1 = *(const f32x4*)(kp + kk * 16 + 4); v4u o; o.x = pk2(x0[0], x0[1]); o.y = pk2(x0[2], x0[3]); o.z = pk2(x1[0], x1[1]); o.w = pk2(x1[2], x1[3]); kf[kk] = __builtin_bit_cast(bf16x8, o); } }
        else {
#pragma unroll
            for (int kk = 0; kk < 4; ++kk) { v4u o = {0u, 0u, 0u, 0u}; if (r < 8) o = *(const v4u*)(IK + (size_t)(RP + 8 * b + r) * 64 + kk * 16 + hh * 8); kf[kk] = __builtin_bit_cast(bf16x8, o); } }
#pragma unroll
        for (int blk = 0; blk < 4; ++blk) {
            f32x16 c;
#pragma unroll
            for (int e = 0; e < 16; ++e) c[e] = 0.f;
#pragma unroll
            for (int kk = 0; kk < 4; ++kk) c = MFMA32(qa[blk][kk], kf[kk], c);
            float p0 = 0.f, p1 = 0.f;
            const float* w0p = IW + (size_t)(RP + 8 * b + 2 * blk) * 16 + 4 * hh; const float* w1p = w0p + 16;
            const f32x4 w00 = *(const f32x4*)w0p, w01 = *(const f32x4*)(w0p + 8), w10 = *(const f32x4*)w1p, w11 = *(const f32x4*)(w1p + 8);
#pragma unroll
            for (int j = 0; j < 4; ++j) { p0 += w00[j] * fmaxf(c[j], 0.f) + w01[j] * fmaxf(c[4 + j], 0.f); p1 += w10[j] * fmaxf(c[8 + j], 0.f) + w11[j] * fmaxf(c[12 + j], 0.f); }
            p0 += __shfl_xor(p0, 32); p1 += __shfl_xor(p1, 32);
            SCS[(size_t)(8 * b + 2 * blk + hh) * 2112 + 32 * kb + r] = hh ? p1 : p0;
        }
    }
}
DI void ph_index(const Args& a, const Ctx& C) {
    gu32* head = (gu32*)a.ws + CW_WQ; volatile LAS int* slot = (volatile LAS int*)(C.lds + MISC_OFF + 64);
    for (;;) {
        const int u = wq_next(head, slot, C.tid);
        if (u >= 128 + 256) break;
        if (u < 128) idx_sample_unit(a, C, u);
        else { const int v = u - 128; idx_prompt_unit(a, C, v & 7, 31 - (v >> 3)); }
    }
}
DI unsigned ordkey(float f) { const unsigned b = __float_as_uint(f); return (b & 0x80000000u) ? ~b : (b | 0x80000000u); }
template <int NS> DI void select_row(const float* sc, int n_adm, unsigned long long* mrow, int lane) {
    unsigned u[NS];
#pragma unroll
    for (int j = 0; j < NS; ++j) { const int key = 64 * j + lane; u[j] = 0u; if (64 * j < n_adm) { const float f = sc[key]; u[j] = key < n_adm ? ordkey(f) : 0u; } }
    unsigned T = 1u;
    if (n_adm > 256) {
        T = 0u;
#pragma unroll 1
        for (int bit = 31; bit >= 0; --bit) { const unsigned cand = T | (1u << bit); int cnt = 0;
#pragma unroll
            for (int j = 0; j < NS; ++j) cnt += __popcll(__ballot(u[j] >= cand));
            if (cnt >= 256) T = cand; }
    }
    unsigned long long mine = 0ull;
#pragma unroll
    for (int j = 0; j < NS; ++j) { const unsigned long long bm = __ballot(u[j] >= T); if (lane == j) mine = bm; }
    if (lane < 34) mrow[lane] = lane < NS ? mine : 0ull;
}
DI void ph_select(const Args& a, const Ctx& C) {
    unsigned char* ws = a.ws;
    const float* SC = (const float*)(ws + WS_SC); const float* SCS = (const float*)(ws + WS_SCS); unsigned long long* MASK = (unsigned long long*)(ws + WS_MASK);
    const int gw = C.bx * NWAVES + C.wave, NGW = C.G * NWAVES;
    for (int row = gw; row < R; row += NGW) {
        if (row < RP) select_row<32>(SC + (size_t)row * 2048, (row & 2047) + 1, MASK + (size_t)row * 34, C.lane);
        else select_row<33>(SCS + (size_t)(row - RP) * 2112, 2049 + ((row - RP) & 7), MASK + (size_t)row * 34, C.lane);
    }
}
constexpr float NEG_BIG = -1.0e30f;
DI bf16x8 pack_p(const f32x16& x, int sp) {
    v4u o; o.x = pk2(x[8 * sp + 0], x[8 * sp + 1]); o.y = pk2(x[8 * sp + 2], x[8 * sp + 3]); o.z = pk2(x[8 * sp + 4], x[8 * sp + 5]); o.w = pk2(x[8 * sp + 6], x[8 * sp + 7]);
    return __builtin_bit_cast(bf16x8, o);
}
DI void softmax_tile(f32x16& s0, f32x16& s1, unsigned long long wq, float& m, float& l, f32x16 (&o)[4]) {
    const unsigned wlo = (unsigned)wq, whi = (unsigned)(wq >> 32);
    float mx = NEG_BIG;
#pragma unroll
    for (int e = 0; e < 16; ++e) { const int sh = (e & 3) + 8 * (e >> 2);
        s0[e] = ((wlo >> sh) & 1u) ? s0[e] : NEG_BIG; s1[e] = ((whi >> sh) & 1u) ? s1[e] : NEG_BIG; mx = fmaxf(mx, fmaxf(s0[e], s1[e])); }
    mx = fmaxf(mx, __shfl_xor(mx, 32));
    const float mn = fmaxf(m, mx), alpha = fexp2(m - mn); m = mn;
    float ls = 0.f;
#pragma unroll
    for (int e = 0; e < 16; ++e) { const int sh = (e & 3) + 8 * (e >> 2);
        s0[e] = ((wlo >> sh) & 1u) ? fexp2(s0[e] - mn) : 0.f; s1[e] = ((whi >> sh) & 1u) ? fexp2(s1[e] - mn) : 0.f; ls += s0[e] + s1[e]; }
    l = l * alpha + ls;
#pragma unroll
    for (int db = 0; db < 4; ++db)
#pragma unroll
        for (int e = 0; e < 16; ++e) o[db][e] *= alpha;
}
constexpr int KT_BYTES = 64 * 272, VT_BYTES = 128 * 144;
DI void attn_prompt_unit(const Args& a, const Ctx& C, int b, int kvh, int qb) {
    unsigned char* ws = a.ws;
    const bf16* Q = (const bf16*)(ws + WS_Q); const bf16* KB = (const bf16*)(ws + WS_KB); const bf16* VB = (const bf16*)(ws + WS_VB);
    const unsigned long long* MASK = (const unsigned long long*)(ws + WS_MASK); bf16* O = (bf16*)(ws + WS_O);
    const int hg = C.wave & 3, qh = C.wave >> 2, r = C.lane & 31, hh = C.lane >> 5, head = 4 * kvh + hg;
    const int qrow = b * 2048 + qb * 64 + qh * 32 + r;
    bf16x8 qf[8];
#pragma unroll
    for (int kk = 0; kk < 8; ++kk) qf[kk] = *(const bf16x8*)(Q + (size_t)qrow * 2048 + head * 128 + kk * 16 + hh * 8);
    f32x16 o[4];
#pragma unroll
    for (int db = 0; db < 4; ++db)
#pragma unroll
        for (int e = 0; e < 16; ++e) o[db][e] = 0.f;
    float m = NEG_BIG, l = 0.f;
    const unsigned long long* mrow = MASK + (size_t)qrow * 34;
    LAS unsigned char* kbuf = C.lds; LAS unsigned char* vbuf = C.lds + 2 * KT_BYTES;
    const int krow0 = C.tid >> 4, kch = C.tid & 15;
    const size_t gbase = (size_t)(b * 2048) * 512 + kvh * 128 + kch * 8;
    v4u kr[2], vr[2];
#define LOADT(kt) do { kr[0] = *(const v4u*)(KB + gbase + (size_t)((kt) * 64 + krow0) * 512); kr[1] = *(const v4u*)(KB + gbase + (size_t)((kt) * 64 + 32 + krow0) * 512); \
                       vr[0] = *(const v4u*)(VB + gbase + (size_t)((kt) * 64 + 2 * krow0) * 512); vr[1] = *(const v4u*)(VB + gbase + (size_t)((kt) * 64 + 2 * krow0 + 1) * 512); } while (0)
#define WRITET(buf) do { *(LAS v4u*)(kbuf + (buf) * KT_BYTES + krow0 * 272 + kch * 16) = kr[0]; *(LAS v4u*)(kbuf + (buf) * KT_BYTES + (32 + krow0) * 272 + kch * 16) = kr[1]; \
        LAS unsigned char* vb_ = vbuf + (buf) * VT_BYTES + ((((krow0 >> 1) ^ kch) & 15) << 3) + ((krow0 & 1) << 2); \
        const unsigned a_[4] = {vr[0].x, vr[0].y, vr[0].z, vr[0].w}, b_[4] = {vr[1].x, vr[1].y, vr[1].z, vr[1].w}; \
        _Pragma("unroll") for (int i_ = 0; i_ < 4; ++i_) { *(LAS unsigned*)(vb_ + (kch * 8 + 2 * i_) * 144) = (a_[i_] & 0xffffu) | (b_[i_] << 16); *(LAS unsigned*)(vb_ + (kch * 8 + 2 * i_ + 1) * 144) = (a_[i_] >> 16) | (b_[i_] & 0xffff0000u); } } while (0)
    LOADT(0); WRITET(0);
    __syncthreads();
    for (int kt = 0; kt <= qb; ++kt) {
        const int cur = kt & 1;
        if (kt < qb) LOADT(kt + 1);
        const unsigned long long wq = mrow[kt] >> (4 * hh);
        f32x16 s0, s1;
#pragma unroll
        for (int e = 0; e < 16; ++e) { s0[e] = 0.f; s1[e] = 0.f; }
        const LAS unsigned char* kb_ = kbuf + cur * KT_BYTES + r * 272 + hh * 16;
#pragma unroll
        for (int kk = 0; kk < 8; ++kk) { const bf16x8 a0 = *(const LAS bf16x8*)(kb_ + kk * 32), a1 = *(const LAS bf16x8*)(kb_ + 32 * 272 + kk * 32); s0 = MFMA32(a0, qf[kk], s0); s1 = MFMA32(a1, qf[kk], s1); }
        softmax_tile(s0, s1, wq, m, l, o);
        const LAS unsigned char* vb_ = vbuf + cur * VT_BYTES;
#pragma unroll
        for (int sb = 0; sb < 2; ++sb)
#pragma unroll
            for (int sp = 0; sp < 2; ++sp) { const bf16x8 pf = pack_p(sb ? s1 : s0, sp); const int pi = 8 * sb + 4 * sp + hh;
#pragma unroll
                for (int db = 0; db < 4; ++db) { const int d = 32 * db + r, sw = (d >> 3) & 15;
                    const v2u x0 = *(const LAS v2u*)(vb_ + d * 144 + ((pi ^ sw) << 3)), x1 = *(const LAS v2u*)(vb_ + d * 144 + (((pi + 2) ^ sw) << 3));
                    const v4u av = {x0.x, x0.y, x1.x, x1.y}; o[db] = MFMA32(__builtin_bit_cast(bf16x8, av), pf, o[db]); } }
        if (kt < qb) WRITET(cur ^ 1);
        __syncthreads();
    }
#undef LOADT
#undef WRITET
    l += __shfl_xor(l, 32); const float inv = 1.0f / l;
#pragma unroll
    for (int db = 0; db < 4; ++db)
#pragma unroll
        for (int rg = 0; rg < 4; ++rg) { v2u w; w.x = pk2(o[db][4 * rg] * inv, o[db][4 * rg + 1] * inv); w.y = pk2(o[db][4 * rg + 2] * inv, o[db][4 * rg + 3] * inv);
            *(v2u*)(O + (size_t)qrow * 2048 + head * 128 + 32 * db + 8 * rg + 4 * hh) = w; }
}
DI bf16x8 cvt8(const f32x4& x0, const f32x4& x1) { v4u o; o.x = pk2(x0[0], x0[1]); o.y = pk2(x0[2], x0[3]); o.z = pk2(x1[0], x1[1]); o.w = pk2(x1[2], x1[3]); return __builtin_bit_cast(bf16x8, o); }
DI void attn_sample_unit(const Args& a, const Ctx& C, int b, int kvh) {
    unsigned char* ws = a.ws;
    const bf16* Q = (const bf16*)(ws + WS_Q); const bf16* KB = (const bf16*)(ws + WS_KB); const bf16* VB = (const bf16*)(ws + WS_VB);
    const unsigned long long* MASK = (const unsigned long long*)(ws + WS_MASK); bf16* O = (bf16*)(ws + WS_O);
    const float* ck = a.in[2]; const float* cv = a.in[3]; const int* pt = (const int*)a.in[6] + b * 16;
    const int r = C.lane & 31, hh = C.lane >> 5, t = r & 7, head = 4 * kvh + (r >> 3), qrow = RP + 8 * b + t;
    const bf16* qp = Q + (size_t)qrow * 2048 + head * 128 + hh * 8;
    f32x16 o[4];
#pragma unroll
    for (int db = 0; db < 4; ++db)
#pragma unroll
        for (int e = 0; e < 16; ++e) o[db][e] = 0.f;
    float m = NEG_BIG, l = 0.f;
    const unsigned long long* mrow = MASK + (size_t)qrow * 34;
    for (int tile = C.wave; tile < 33; tile += 8) {
        const unsigned long long wq = mrow[tile] >> (4 * hh);
        f32x16 s0, s1;
#pragma unroll
        for (int e = 0; e < 16; ++e) { s0[e] = 0.f; s1[e] = 0.f; }
        if (tile < 32) {
            const unsigned rowbase = (unsigned)__builtin_amdgcn_readfirstlane(pt[tile >> 1] * 128 + (tile & 1) * 64);
            const float* kt0 = ck + (size_t)rowbase * 512; const float* kt1 = kt0 + 32 * 512;
            const unsigned kvo = (unsigned)((r * 4 + kvh) * 128 + hh * 8);
#pragma unroll
            for (int kk = 0; kk < 8; ++kk) { const bf16x8 qfk = *(const bf16x8*)(qp + kk * 16);
                const bf16x8 a0 = cvt8(*(const f32x4*)(kt0 + kvo + kk * 16), *(const f32x4*)(kt0 + kvo + kk * 16 + 4)), a1 = cvt8(*(const f32x4*)(kt1 + kvo + kk * 16), *(const f32x4*)(kt1 + kvo + kk * 16 + 4));
                s0 = MFMA32(a0, qfk, s0); s1 = MFMA32(a1, qfk, s1); if (kk & 1) __builtin_amdgcn_sched_barrier(0); }
            softmax_tile(s0, s1, wq, m, l, o);
            const unsigned vvo = (unsigned)((4 * hh * 4 + kvh) * 128 + r);
#pragma unroll
            for (int sb = 0; sb < 2; ++sb)
#pragma unroll
                for (int sp = 0; sp < 2; ++sp) { const bf16x8 pf = pack_p(sb ? s1 : s0, sp);
                    const float* vt0 = cv + (size_t)(rowbase + 32 * sb + 16 * sp) * 512;
#pragma unroll
                    for (int db = 0; db < 4; ++db) { float x[8];
#pragma unroll
                        for (int j = 0; j < 8; ++j) x[j] = (vt0 + (8 * (j >> 2) + (j & 3)) * 512)[vvo + 32 * db];
                        v4u av; av.x = pk2(x[0], x[1]); av.y = pk2(x[2], x[3]); av.z = pk2(x[4], x[5]); av.w = pk2(x[6], x[7]);
                        o[db] = MFMA32(__builtin_bit_cast(bf16x8, av), pf, o[db]); __builtin_amdgcn_sched_barrier(0); } }
        } else {
#pragma unroll
            for (int kk = 0; kk < 8; ++kk) { v4u kv = {0u, 0u, 0u, 0u}; if (r < 8) kv = *(const v4u*)(KB + (size_t)(RP + 8 * b + r) * 512 + kvh * 128 + kk * 16 + hh * 8);
                s0 = MFMA32(__builtin_bit_cast(bf16x8, kv), *(const bf16x8*)(qp + kk * 16), s0); }
            softmax_tile(s0, s1, wq, m, l, o);
            const bf16x8 pf = pack_p(s0, 0);
#pragma unroll
            for (int db = 0; db < 4; ++db) { const bf16* vp = VB + (size_t)(RP + 8 * b + 4 * hh) * 512 + kvh * 128 + 32 * db + r;
                v4u av; av.x = (unsigned)vp[0] | ((unsigned)vp[512] << 16); av.y = (unsigned)vp[1024] | ((unsigned)vp[1536] << 16); av.z = 0u; av.w = 0u;
                o[db] = MFMA32(__builtin_bit_cast(bf16x8, av), pf, o[db]); }
        }
    }
    l += __shfl_xor(l, 32);
    LAS float* ml = (LAS float*)C.lds;
    LAS float* ob = (LAS float*)(C.lds + 4096);
    if (hh == 0) { ml[(C.wave * 32 + r) * 2] = m; ml[(C.wave * 32 + r) * 2 + 1] = l; }
    __syncthreads();
    float M = NEG_BIG;
#pragma unroll
    for (int w = 0; w < 8; ++w) M = fmaxf(M, ml[(w * 32 + r) * 2]);
    float L = 0.f;
#pragma unroll
    for (int w = 0; w < 8; ++w) L += ml[(w * 32 + r) * 2 + 1] * fexp2(ml[(w * 32 + r) * 2] - M);
    { const float sc = fexp2(m - M);
#pragma unroll
      for (int db = 0; db < 4; ++db)
#pragma unroll
          for (int e = 0; e < 16; ++e) o[db][e] *= sc; }
#define OB_WRITE(slot) do { _Pragma("unroll") for (int db = 0; db < 4; ++db) _Pragma("unroll") for (int e = 0; e < 16; ++e) ob[(((slot) * 64 + db * 16 + e) << 6) + C.lane] = o[db][e]; } while (0)
#define OB_ADD(slot) do { _Pragma("unroll") for (int db = 0; db < 4; ++db) _Pragma("unroll") for (int e = 0; e < 16; ++e) o[db][e] += ob[(((slot) * 64 + db * 16 + e) << 6) + C.lane]; } while (0)
    if (C.wave >= 4) OB_WRITE(C.wave - 4);
    __syncthreads();
    if (C.wave < 4) OB_ADD(C.wave);
    __syncthreads();
    if (C.wave == 2 || C.wave == 3) OB_WRITE(C.wave - 2);
    __syncthreads();
    if (C.wave < 2) OB_ADD(C.wave);
    __syncthreads();
    if (C.wave == 1) OB_WRITE(0);
    __syncthreads();
    if (C.wave == 0) { OB_ADD(0); const float inv = 1.0f / L;
#pragma unroll
        for (int db = 0; db < 4; ++db)
#pragma unroll
            for (int rg = 0; rg < 4; ++rg) { v2u w; w.x = pk2(o[db][4 * rg] * inv, o[db][4 * rg + 1] * inv); w.y = pk2(o[db][4 * rg + 2] * inv, o[db][4 * rg + 3] * inv);
                *(v2u*)(O + (size_t)qrow * 2048 + head * 128 + 32 * db + 8 * rg + 4 * hh) = w; } }
#undef OB_WRITE
#undef OB_ADD
}
DI void ph_attn(const Args& a, const Ctx& C) {
    volatile LAS int* slot = (volatile LAS int*)(C.lds + MISC_OFF + 64);
    { gu32* head = (gu32*)a.ws + CW_WQ + 64;
      for (;;) { const int u = wq_next(head, slot, C.tid); if (u >= 512) break; attn_sample_unit(a, C, u >> 2, u & 3); } }
    { gu32* head = (gu32*)a.ws + CW_WQ + 128;
      for (;;) { const int v = wq_next(head, slot, C.tid); if (v >= 1024) break; attn_prompt_unit(a, C, (v & 31) >> 2, v & 3, 31 - (v >> 5)); } }
}
#define SELFCHK_HOOK(a,b,c,d) do {} while (0)
#ifndef MK_ONE_LAUNCH
#define MK_ONE_LAUNCH 1
#endif
constexpr int N_PHASES = 16;
#ifndef DBG_NPH
#define DBG_NPH 16
#endif
__global__ void __launch_bounds__(NWAVES * 64, 2) fwd_kernel(Args args) {
    extern __shared__ __attribute__((aligned(16))) unsigned char lds_raw[];
    Ctx C; C.lds = (LAS unsigned char*)lds_raw; C.tid = threadIdx.x; C.lane = C.tid & 63; C.wave = __builtin_amdgcn_readfirstlane(C.tid >> 6); C.G = gridDim.x; C.bx = blockIdx.x;
    unsigned char* ws = args.ws;
    for (int u = C.tid; u < 64; u += NWAVES * 64) ((LAS unsigned*)(C.lds + MISC_OFF))[u] = 0u;
    __syncthreads();
#if MK_ONE_LAUNCH
    XcdBarrier bar = xcd_barrier_post((unsigned*)ws + CW_BAR, (volatile LAS unsigned*)(C.lds + MISC_OFF) + 8);
#define GRID_BAR() xcd_barrier(bar)
#else
#define GRID_BAR() do {} while (0)
#endif
    const int lo = args.ph_lo, hi = args.ph_hi;
#ifndef PH_MASK
#define PH_MASK 0xFFFF
#endif
#define IN(k) (((PH_MASK >> (k)) & 1) && lo <= (k) && (k) < hi)
#define SEAM(k) do { if (IN(k) && IN((k) + 1)) GRID_BAR(); } while (0)
    bf16* XB = (bf16*)(ws + WS_XB); float* SS = (float*)(ws + WS_SS); float* XA = (float*)(ws + WS_XA); float* Y = args.out + OFF_Y;
    using pg8::Gemm; using pg8::StaticOrder;
    if (IN(0)) { ph_prologue(args, C); } SEAM(0);
    if (IN(1)) { Gemm g{XB, (const bf16*)(ws + WS_WAIN), R, 4096, 2048}; StaticOrder S; S.init(R, 4096, C.G, C.bx);
        pg8::EpiA1 E{(bf16*)(ws + WS_U), (bf16*)(ws + WS_V), (float*)(ws + WS_VSS), SS};
        pg8::gemm_phase<pg8::EpiA1, StaticOrder, true, true>(C.lds, g, S, E); } SEAM(1);
    if (IN(2)) { ph_gate(args, C); } SEAM(2);
    if (IN(3)) { Gemm g{(const bf16*)(ws + WS_GT), (const bf16*)(ws + WS_WAOUT), R, 2048, 2048}; StaticOrder S; S.init(R, 2048, C.G, C.bx);
        pg8::EpiResid E{args.in[0], args.in[1], XA, XB, SS};
        pg8::gemm_phase<pg8::EpiResid, StaticOrder, true, true>(C.lds, g, S, E); } SEAM(3);
    if (IN(4)) { Gemm g{XB, (const bf16*)(ws + WS_WFIN), R, DFF2, 2048}; StaticOrder S; S.init(R, DFF2, C.G, C.bx);
        pg8::EpiScale E{(bf16*)(ws + WS_AB), DFF2, SS, args.out + OFF_CP, args.out + OFF_CS};
        pg8::gemm_phase<pg8::EpiScale, StaticOrder, true, true>(C.lds, g, S, E); } SEAM(4);
    if (IN(5)) { ph_conv(args, C, 0); } SEAM(5);
    if (IN(6)) { Gemm g{(const bf16*)(ws + WS_HID), (const bf16*)(ws + WS_WFOUT), R, 2048, DFF}; StaticOrder S; S.init(R, 2048, C.G, C.bx);
        pg8::EpiResid E{XA, XA + (size_t)RP * 2048, Y, XB, SS};
        pg8::gemm_phase<pg8::EpiResid, StaticOrder, true, true>(C.lds, g, S, E); } SEAM(6);
    if (IN(7)) { Gemm g{XB, (const bf16*)(ws + WS_WBIN), R, NBP, 2048}; StaticOrder S; S.init(R, NBP, C.G, C.bx);
        pg8::EpiScale E{(bf16*)(ws + WS_P), NBP, SS, nullptr, nullptr};
        pg8::gemm_phase<pg8::EpiScale, StaticOrder, true, true>(C.lds, g, S, E); } SEAM(7);
    if (IN(8)) { ph_qkrope(args, C); } SEAM(8);
    if (IN(9)) { ph_index(args, C); } SEAM(9);
    if (IN(10)) { ph_select(args, C); } SEAM(10);
    if (IN(11)) { ph_attn(args, C); } SEAM(11);
    if (IN(12)) { Gemm g{(const bf16*)(ws + WS_O), (const bf16*)(ws + WS_WBO), R, 2048, 2048}; StaticOrder S; S.init(R, 2048, C.G, C.bx);
        pg8::EpiResid E{Y, Y + (size_t)RP * 2048, XA, XB, SS};
        pg8::gemm_phase<pg8::EpiResid, StaticOrder, true, true>(C.lds, g, S, E); } SEAM(12);
    if (IN(13)) { Gemm g{XB, (const bf16*)(ws + WS_WFIN) + (size_t)DFF2 * 2048, R, DFF2, 2048}; StaticOrder S; S.init(R, DFF2, C.G, C.bx);
        pg8::EpiScale E{(bf16*)(ws + WS_AB), DFF2, SS, args.out + OFF_CP + (size_t)8 * 2 * DFF2, args.out + OFF_CS + (size_t)128 * 2 * DFF2};
        pg8::gemm_phase<pg8::EpiScale, StaticOrder, true, true>(C.lds, g, S, E); } SEAM(13);
    if (IN(14)) { ph_conv(args, C, 1); } SEAM(14);
    if (IN(15)) { Gemm g{(const bf16*)(ws + WS_HID), (const bf16*)(ws + WS_WFOUT) + (size_t)2048 * DFF, R, 2048, DFF}; StaticOrder S; S.init(R, 2048, C.G, C.bx);
        pg8::EpiResid E{XA, XA + (size_t)RP * 2048, Y, XB, SS};
        pg8::gemm_phase<pg8::EpiResid, StaticOrder, true, true>(C.lds, g, S, E); }
#undef IN
#undef SEAM
}

extern "C" void kernel_launch(void* const* d_in, const int* in_sizes, int n_in, void* d_out, int out_size, void* d_ws, size_t ws_size, hipStream_t stream) {
    static int grid = 0;
    if (grid == 0) {
        if (n_in != 23 || (size_t)out_size != OUT_TOTAL || ws_size < WS_END) { fprintf(stderr, "kernel_launch: unexpected shapes (n_in %d, out %d, ws %zu < %zu)\n", n_in, out_size, ws_size, (size_t)WS_END); grid = -1; return; }
        int dev = 0, cus = 0, per_cu = 0;
        if (hipGetDevice(&dev) != hipSuccess || hipDeviceGetAttribute(&cus, hipDeviceAttributeMultiprocessorCount, dev) != hipSuccess) { grid = -1; return; }
        if (hipFuncSetAttribute((const void*)fwd_kernel, hipFuncAttributeMaxDynamicSharedMemorySize, LDS_BYTES) != hipSuccess) { fprintf(stderr, "kernel_launch: hipFuncSetAttribute failed\n"); grid = -1; return; }
        if (hipOccupancyMaxActiveBlocksPerMultiprocessor(&per_cu, (const void*)fwd_kernel, NWAVES * 64, LDS_BYTES) != hipSuccess || per_cu < 1) { fprintf(stderr, "kernel_launch: occupancy query says %d\n", per_cu); }
        (void)hipGetLastError();
        grid = cus;
    }
    if (grid < 0) return;
    (void)hipMemsetAsync(d_ws, 0, CTL_BYTES, stream);
    Args a{};
    for (int i = 0; i < 23; ++i) a.in[i] = (const float*)d_in[i];
    a.out = (float*)d_out; a.ws = (unsigned char*)d_ws;
#if MK_ONE_LAUNCH
    a.ph_lo = 0; a.ph_hi = N_PHASES;
    hipLaunchKernelGGL(fwd_kernel, dim3(grid), dim3(NWAVES * 64), LDS_BYTES, stream, a);
#else
    for (int p = 0; p < DBG_NPH; ++p) { a.ph_lo = p; a.ph_hi = p + 1; hipLaunchKernelGGL(fwd_kernel, dim3(grid), dim3(NWAVES * 64), LDS_BYTES, stream, a); }
#endif
    SELFCHK_HOOK(d_in, d_out, d_ws, stream);
}
```

```cpp
#include <hip/hip_runtime.h>
#include <cstdio>
#include <cstdint>
namespace pg8 {
#define PG8_LAS __attribute__((address_space(3)))
typedef unsigned short bf16_t;
typedef short bf16x8 __attribute__((ext_vector_type(8)));
typedef float f32x4 __attribute__((ext_vector_type(4)));
typedef unsigned u32x4 __attribute__((ext_vector_type(4)));
constexpr int BM = 256, BK = 64, HALF = 128, HTB = HALF * BK * 2  , STAGE_BYTES = 8 * HTB, NXCD = 8, WGM = 8;

__host__ __device__ __forceinline__ int lds_byte(int r, int c) { const int st = (r >> 4) * 2 + (c >> 5), rr = r & 15, cc = c & 31, ob = rr * 64 + cc * 2; return st * 1024 + (ob ^ (((ob >> 9) & 1) << 5)); }
__host__ __device__ __forceinline__ void stage_rc(int b, int& R, int& C) { const int st = b / 1024, sb = b % 1024, swz = sb ^ (((sb >> 9) & 1) << 5); R = (st >> 1) * 16 + swz / 64; C = (st & 1) * 32 + (swz % 64) / 2; }
__host__ __device__ __forceinline__ int perm32(int rho) { const int n = rho >> 4, i = rho & 15; return 8 * (i >> 2) + 4 * n + (i & 3); }

struct Unit { int pm, pn, kb, nt, ks; };
struct Gemm { const bf16_t* A; const bf16_t* Bt; int M, N, K; };

struct StaticOrder {
    int nM, nN, nwg, G, c, nt_full;
    __host__ __device__ void init(int M, int N, int G_, int c_, int K = 2048) { nM = M / BM; nN = N / BM; nwg = nM * nN; G = G_; c = c_; nt_full = K / BK; }
    __host__ __device__ __forceinline__ bool next(int i, Unit& u) const {
        const long L = (long)i * G + c; if (L >= nwg) return false;
        int wgid = (int)L; { const int q = nwg / NXCD, r = nwg % NXCD, xcd = wgid % NXCD, off = wgid / NXCD; wgid = (xcd < r ? xcd * (q + 1) : r * (q + 1) + (xcd - r) * q) + off; }
        const int nig = WGM * nN, gid = wgid / nig, fm = gid * WGM, gsz = (nM - fm) < WGM ? (nM - fm) : WGM;
        u.pm = fm + ((wgid % nig) % gsz); u.pn = (wgid % nig) / gsz; u.kb = 0; u.nt = nt_full; u.ks = -1; return true;
    }
    __device__ __forceinline__ void a_ready(const Unit&) const {}
    __device__ __forceinline__ void done(const Unit&) const {}
};
struct SplitOrder {
    StaticOrder P; int nP, nN, S, nts, rem, G, c;
    __host__ __device__ void init(int N, int K, int S_, int G_, int c_) { P.init(16384, N, G_, c_, K); nP = 64 * (N / BM); nN = N / BM; S = S_; nts = 2 * ((K / BK) / (2 * S_)); rem = ((K / BK) - S_ * nts) / 2; G = G_; c = c_; }
    __host__ __device__ __forceinline__ bool next(int i, Unit& u) const {
        const bool flip = (nP % G == 0) && (4 * nN * S == G) && (((c >> 3) & 1) != 0);
        const long L0 = (long)i * G + c, L = flip ? (long)(i - 1) * G + c : L0;
        const bool isp = flip ? (i >= 1 && L < nP) : (L0 < nP); const int s = flip ? c : (isp ? 0 : (int)(L0 - nP)); const bool iss = flip ? (i == 0) : (!isp && s < 4 * nN * S);
        int wgid = isp ? (int)L : 0; { const int q = nP / NXCD, r = nP % NXCD, xcd = wgid % NXCD, off = wgid / NXCD; wgid = (xcd < r ? xcd * (q + 1) : r * (q + 1) + (xcd - r) * q) + off; }
        const int nig = WGM * nN, gid = wgid / nig, fm = gid * WGM, gsz = (64 - fm) < WGM ? (64 - fm) : WGM;
        const int pm_p = fm + ((wgid % nig) % gsz), pn_p = (wgid % nig) / gsz;
        const int t = s / S, ks = s % S;
        u.pm = isp ? pm_p : 64 + (t & 3); u.pn = isp ? pn_p : (t >> 2); const int st = ks * nts + 2 * (ks < rem ? ks : rem), ntk = nts + (ks < rem ? 2 : 0);
        u.kb = isp ? 0 : st * BK * 2; u.nt = isp ? P.nt_full : ntk; u.ks = isp ? -1 : ks;
        return isp || iss;
    }
    __device__ __forceinline__ void a_ready(const Unit&) const {}
    __device__ __forceinline__ void done(const Unit&) const {}
};
constexpr int RPROMPT = 16384;
typedef __bf16 bf2_t __attribute__((ext_vector_type(2)));
typedef float f32x2 __attribute__((ext_vector_type(2)));
__device__ __forceinline__ unsigned cvt_pk_bf16(float lo, float hi) { f32x2 v = {lo, hi}; return __builtin_bit_cast(unsigned, __builtin_convertvector(v, bf2_t)); }
__device__ __forceinline__ u32x4 pack8(const f32x4& a, const f32x4& b) { u32x4 w; w.x = cvt_pk_bf16(a[0], a[1]); w.y = cvt_pk_bf16(a[2], a[3]); w.z = cvt_pk_bf16(b[0], b[1]); w.w = cvt_pk_bf16(b[2], b[3]); return w; }
__device__ __forceinline__ float rstd_of(const float* rstd, int row) { return rstd[row]; }
__device__ __forceinline__ float gelu_tanh(float x) {
    const float u = x * (0.7978845608f + 0.0356774081f * x * x);
    const float e = __builtin_amdgcn_exp2f(-2.885390082f * u);
    return x * __builtin_amdgcn_rcpf(1.0f + e);
}
__device__ __forceinline__ float sumsq4(const f32x4& a) { return (a[0] * a[0] + a[1] * a[1]) + (a[2] * a[2] + a[3] * a[3]); }

__device__ __forceinline__ void store_slab(const f32x4 (&acc)[2][2][4][2], const Unit& u, int wr, int wc, int fr, int fq, float* slab_, int N) {
    bf16_t* slab = (bf16_t*)slab_;
    const int col0 = u.pn * BM + wc * 32 + 8 * fq, row0 = (u.pm - 64) * BM + wr * 64 + fr;
#pragma unroll
    for (int ai = 0; ai < 2; ++ai)
#pragma unroll
        for (int m = 0; m < 4; ++m) { bf16_t* op = slab + ((size_t)u.ks * 1024 + row0 + ai * HALF + m * 16) * N + col0;
#pragma unroll
            for (int bj = 0; bj < 2; ++bj) *(u32x4*)(op + bj * HALF) = pack8(acc[ai][bj][m][0], acc[ai][bj][m][1]); }
}
struct EpiA1 {
    static constexpr bool PERM = true, AFTER_DRAIN = false;
    bf16_t* U; bf16_t* V; float* vss; const float* ss; float* slab;
    __device__ __forceinline__ void operator()(const f32x4 (&acc)[2][2][4][2], const Unit& u, int wr, int wc, int fr, int fq) const {
        if (u.ks >= 0) { store_slab(acc, u, wr, wc, fr, fq, slab, 4096); return; }
        const bool isv = u.pn >= 8; bf16_t* dst = isv ? V : U; const int pt = isv ? u.pn - 8 : u.pn;
        const int col0 = pt * BM + wc * 32 + 8 * fq, row0 = u.pm * BM + wr * 64 + fr;
        float rsv[2][4];
#pragma unroll
        for (int ai = 0; ai < 2; ++ai)
#pragma unroll
            for (int m = 0; m < 4; ++m) rsv[ai][m] = rstd_of(ss, row0 + ai * HALF + m * 16);
#pragma unroll
        for (int ai = 0; ai < 2; ++ai)
#pragma unroll
            for (int m = 0; m < 4; ++m) { const int row = row0 + ai * HALF + m * 16; const float rs = rsv[ai][m]; float q = 0.f;
#pragma unroll
                for (int bj = 0; bj < 2; ++bj) { f32x4 v0 = acc[ai][bj][m][0] * rs, v1 = acc[ai][bj][m][1] * rs;
#pragma unroll
                    for (int j = 0; j < 4; ++j) { v0[j] = gelu_tanh(v0[j]); v1[j] = gelu_tanh(v1[j]); }
                    q += sumsq4(v0) + sumsq4(v1);
                    *(u32x4*)(dst + (size_t)row * 2048 + col0 + bj * HALF) = pack8(v0, v1); }
                if (isv) { q += __shfl_xor(q, 16); q += __shfl_xor(q, 32); if (fq == 0) vss[(size_t)row * 32 + pt * 4 + wc] = q; } }
    }
};
template <bool BASE_F32, bool OUT_F32> struct EpiResidT {
    static constexpr bool PERM = true, AFTER_DRAIN = false;
    const float* base0; float* out; bf16_t* xb; float* ss; float* slab;
    __device__ __forceinline__ void operator()(const f32x4 (&acc_)[2][2][4][2], const Unit& u, int wr, int wc, int fr_, int fq_) const {
        if (u.ks >= 0) { store_slab(acc_, u, wr, wc, fr_, fq_, slab, 2048); return; }
        f32x4 (&acc)[2][2][4][2] = const_cast<f32x4 (&)[2][2][4][2]>(acc_);
        int fr = fr_, fq = fq_; asm volatile("" : "+v"(fr), "+v"(fq));
        const int col0 = u.pn * BM + wc * 32 + 8 * fq, row0 = u.pm * BM + wr * 64 + fr;
#pragma unroll
        for (int ai = 0; ai < 2; ++ai) {
            if constexpr (BASE_F32) {
                f32x4 bv[4][2][2];
#pragma unroll
                for (int m = 0; m < 4; ++m) { const int row = row0 + ai * HALF + m * 16; const float* bp = base0 + (size_t)row * 2048 + col0;
#pragma unroll
                    for (int bj = 0; bj < 2; ++bj) { bv[m][bj][0] = *(const f32x4*)(bp + bj * HALF); bv[m][bj][1] = *(const f32x4*)(bp + bj * HALF + 4); } }
#pragma unroll
                for (int m = 0; m < 4; ++m)
#pragma unroll
                    for (int bj = 0; bj < 2; ++bj) { acc[ai][bj][m][0] += bv[m][bj][0]; acc[ai][bj][m][1] += bv[m][bj][1]; }
            } else {
                u32x4 bw[4][2];
#pragma unroll
                for (int m = 0; m < 4; ++m) { const int row = row0 + ai * HALF + m * 16;
#pragma unroll
                    for (int bj = 0; bj < 2; ++bj) bw[m][bj] = *(const u32x4*)(xb + (size_t)row * 2048 + col0 + bj * HALF); }
#pragma unroll
                for (int m = 0; m < 4; ++m)
#pragma unroll
                    for (int bj = 0; bj < 2; ++bj) { const u32x4 w = bw[m][bj];
                        acc[ai][bj][m][0][0] += __uint_as_float(w.x << 16); acc[ai][bj][m][0][1] += __uint_as_float(w.x & 0xffff0000u);
                        acc[ai][bj][m][0][2] += __uint_as_float(w.y << 16); acc[ai][bj][m][0][3] += __uint_as_float(w.y & 0xffff0000u);
                        acc[ai][bj][m][1][0] += __uint_as_float(w.z << 16); acc[ai][bj][m][1][1] += __uint_as_float(w.z & 0xffff0000u);
                        acc[ai][bj][m][1][2] += __uint_as_float(w.w << 16); acc[ai][bj][m][1][3] += __uint_as_float(w.w & 0xffff0000u); }
            }
            __builtin_amdgcn_sched_barrier(0);
#pragma unroll
            for (int m = 0; m < 4; ++m) { const int row = row0 + ai * HALF + m * 16; float q = 0.f;
#pragma unroll
                for (int bj = 0; bj < 2; ++bj) { const f32x4 o0 = acc[ai][bj][m][0], o1 = acc[ai][bj][m][1];
                    q += sumsq4(o0) + sumsq4(o1);
                    if constexpr (OUT_F32) { float* op = out + (size_t)row * 2048 + col0; *(f32x4*)(op + bj * HALF) = o0; *(f32x4*)(op + bj * HALF + 4) = o1; }
                    else *(u32x4*)(xb + (size_t)row * 2048 + col0 + bj * HALF) = pack8(o0, o1); }
                q += __shfl_xor(q, 16); q += __shfl_xor(q, 32); if (fq == 0) ss[(size_t)row * 32 + u.pn * 4 + wc] = q; }
            __builtin_amdgcn_sched_barrier(0);
        }
    }
};
struct EpiScale {
    static constexpr bool PERM = true, AFTER_DRAIN = false;
    bf16_t* O; int ldc; const float* ss; float* convp; float* convs;
    __device__ __forceinline__ void operator()(const f32x4 (&acc)[2][2][4][2], const Unit& u, int wr, int wc, int fr, int fq) const {
        const int col0 = u.pn * BM + wc * 32 + 8 * fq, row0 = u.pm * BM + wr * 64 + fr;
        float rsv[2][4];
#pragma unroll
        for (int ai = 0; ai < 2; ++ai)
#pragma unroll
            for (int m = 0; m < 4; ++m) rsv[ai][m] = rstd_of(ss, row0 + ai * HALF + m * 16);
#pragma unroll
        for (int ai = 0; ai < 2; ++ai)
#pragma unroll
            for (int m = 0; m < 4; ++m) { const int row = row0 + ai * HALF + m * 16; const float rs = rsv[ai][m];
                float* cd = nullptr;
                if (convp) { if (row < RPROMPT) { const int t = row & 2047; if (t >= 2046) cd = convp + (size_t)((row >> 11) * 2 + (t - 2046)) * ldc; }
                             else { const int rr = row - RPROMPT, t = rr & 7; if (t >= 6) cd = convs + (size_t)((rr >> 3) * 2 + (t - 6)) * ldc; } }
#pragma unroll
                for (int bj = 0; bj < 2; ++bj) { const f32x4 v0 = acc[ai][bj][m][0] * rs, v1 = acc[ai][bj][m][1] * rs;
                    *(u32x4*)(O + (size_t)row * ldc + col0 + bj * HALF) = pack8(v0, v1);
                    if (cd) { *(f32x4*)(cd + col0 + bj * HALF) = v0; *(f32x4*)(cd + col0 + bj * HALF + 4) = v1; } } }
    }
};

__device__ __forceinline__ float dpp_f(float old, float src, int ctrl_sel) {
    const int o = __builtin_bit_cast(int, old), x = __builtin_bit_cast(int, src); int r;
    if (ctrl_sel == 0) r = __builtin_amdgcn_update_dpp(o, x, 0x111, 0xf, 0xf, false);
    else if (ctrl_sel == 1) r = __builtin_amdgcn_update_dpp(o, x, 0x112, 0xf, 0xf, false);
    else if (ctrl_sel == 2) r = __builtin_amdgcn_update_dpp(o, x, 0x121, 0xf, 0xf, false);
    else r = __builtin_amdgcn_update_dpp(o, x, 0x122, 0xf, 0xf, false);
    return __builtin_bit_cast(float, r);
}
struct EpiFfn {
    static constexpr bool PERM = true, AFTER_DRAIN = false;
    bf16_t* AB; bf16_t* HID; const float* ss; float* convp; float* convs; const float* cw; const float* cb; PG8_LAS float* xl;
    __device__ __forceinline__ void operator()(const f32x4 (&acc_)[2][2][4][2], const Unit& u, int wr, int wc, int fr, int fq) const {
        f32x4 (&acc)[2][2][4][2] = const_cast<f32x4 (&)[2][2][4][2]>(acc_);
        const int colg = u.pn * 128 + wc * 32 + 8 * fq, colu = 5632 + colg, row0 = u.pm * BM + wr * 64 + fr;
        const bool sample = u.pm >= 64;
        float rsv[2][4];
#pragma unroll
        for (int ai = 0; ai < 2; ++ai)
#pragma unroll
            for (int m = 0; m < 4; ++m) rsv[ai][m] = rstd_of(ss, row0 + ai * HALF + m * 16);
#pragma unroll
        for (int ai = 0; ai < 2; ++ai)
#pragma unroll
            for (int m = 0; m < 4; ++m) { const int row = row0 + ai * HALF + m * 16; const int tr = row & 255; const float rs = rsv[ai][m];
                acc[ai][0][m][0] *= rs; acc[ai][0][m][1] *= rs; acc[ai][1][m][0] *= rs; acc[ai][1][m][1] *= rs;
                float* cd = nullptr;
                if (row < RPROMPT) { const int t = row & 2047; if (t >= 2046) cd = convp + (size_t)((row >> 11) * 2 + (t - 2046)) * 11264; }
                else { const int rr = row - RPROMPT, t = rr & 7; if (t >= 6) cd = convs + (size_t)((rr >> 3) * 2 + (t - 6)) * 11264; }
                if (sample || tr < 2 || tr >= 254) { *(u32x4*)(AB + (size_t)row * 11264 + colg) = pack8(acc[ai][0][m][0], acc[ai][0][m][1]); *(u32x4*)(AB + (size_t)row * 11264 + colu) = pack8(acc[ai][1][m][0], acc[ai][1][m][1]); }
                if (cd) { *(f32x4*)(cd + colg) = acc[ai][0][m][0]; *(f32x4*)(cd + colg + 4) = acc[ai][0][m][1]; *(f32x4*)(cd + colu) = acc[ai][1][m][0]; *(f32x4*)(cd + colu + 4) = acc[ai][1][m][1]; }
                __builtin_amdgcn_sched_barrier(0); }
        const int wave = wr * 4 + wc;
        if (fr >= 14) {
#pragma unroll
            for (int ai = 0; ai < 2; ++ai) { PG8_LAS float* d = xl + ((((wave * 2 + ai) * 2 + (fr - 14)) * 4 + fq) << 4);
                *(PG8_LAS f32x4*)(d) = acc[ai][0][3][0]; *(PG8_LAS f32x4*)(d + 4) = acc[ai][0][3][1]; *(PG8_LAS f32x4*)(d + 8) = acc[ai][1][3][0]; *(PG8_LAS f32x4*)(d + 12) = acc[ai][1][3][1]; } }
        asm volatile("s_waitcnt lgkmcnt(0)" ::: "memory"); __builtin_amdgcn_s_barrier(); asm volatile("" ::: "memory");
        if (sample) return;
#pragma unroll
        for (int n = 0; n < 2; ++n) {
            const f32x4 w0g = *(const f32x4*)(cw + colg + 4 * n), w1g = *(const f32x4*)(cw + 11264 + colg + 4 * n), w2g = *(const f32x4*)(cw + 22528 + colg + 4 * n), bg = *(const f32x4*)(cb + colg + 4 * n);
            const f32x4 w0u = *(const f32x4*)(cw + colu + 4 * n), w1u = *(const f32x4*)(cw + 11264 + colu + 4 * n), w2u = *(const f32x4*)(cw + 22528 + colu + 4 * n), bu = *(const f32x4*)(cb + colu + 4 * n);
#pragma unroll
            for (int ai = 0; ai < 2; ++ai) {
                const int rb = 2 * ai + wr;
                f32x4 c1g = {0.f, 0.f, 0.f, 0.f}, c2g = c1g, c1u = c1g, c2u = c1g;
                if (rb > 0 && fr < 2) { const int pw = ((rb - 1) & 1) * 4 + wc, pai = (rb - 1) >> 1;
                    const PG8_LAS float* r1 = xl + ((((pw * 2 + pai) * 2 + 1) * 4 + fq) << 4);
                    const PG8_LAS float* r2 = xl + ((((pw * 2 + pai) * 2 + 0) * 4 + fq) << 4);
                    c1g = *(const PG8_LAS f32x4*)(r1 + 4 * n); c1u = *(const PG8_LAS f32x4*)(r1 + 8 + 4 * n);
                    const PG8_LAS float* q2 = fr == 0 ? r2 : r1; c2g = *(const PG8_LAS f32x4*)(q2 + 4 * n); c2u = *(const PG8_LAS f32x4*)(q2 + 8 + 4 * n); }
#pragma unroll
                for (int m = 0; m < 4; ++m) { const int row = row0 + ai * HALF + m * 16;
                    const f32x4 xg = acc[ai][0][m][n], xu = acc[ai][1][m][n];
                    if (m > 0) { const f32x4 pg = acc[ai][0][m - 1][n], pu = acc[ai][1][m - 1][n];
#pragma unroll
                        for (int e = 0; e < 4; ++e) { c1g[e] = dpp_f(0.f, pg[e], 2); c2g[e] = dpp_f(0.f, pg[e], 3); c1u[e] = dpp_f(0.f, pu[e], 2); c2u[e] = dpp_f(0.f, pu[e], 3); } }
                    float h[4];
#pragma unroll
                    for (int e = 0; e < 4; ++e) { const float p1g = dpp_f(c1g[e], xg[e], 0), p2g = dpp_f(c2g[e], xg[e], 1), p1u = dpp_f(c1u[e], xu[e], 0), p2u = dpp_f(c2u[e], xu[e], 1);
                        const float cg = bg[e] + w0g[e] * p2g + w1g[e] * p1g + w2g[e] * xg[e], cu = bu[e] + w0u[e] * p2u + w1u[e] * p1u + w2u[e] * xu[e];
                        h[e] = cg * __builtin_amdgcn_rcpf(1.0f + __builtin_amdgcn_exp2f(-1.4426950408889634f * cg)) * cu; }
                    if (!(rb == 0 && m == 0 && fr < 2)) { typedef unsigned u32x2 __attribute__((ext_vector_type(2)));
                        *(u32x2*)(HID + (size_t)row * 5632 + colg + 4 * n) = (u32x2){cvt_pk_bf16(h[0], h[1]), cvt_pk_bf16(h[2], h[3])}; }
                    if (m & 1) __builtin_amdgcn_sched_barrier(0);
                }
            }
        }
    }
};

template <class Epi, class Sched, bool ALIGN_EPI = false, bool SP2 = false>
__device__ __forceinline__ void gemm_phase(PG8_LAS unsigned char* lds, const Gemm g, const Sched& S, const Epi& E) {
    const int tid = threadIdx.x, wid = __builtin_amdgcn_readfirstlane(tid >> 6), lane = tid & 63, wr = wid >> 2, wc = wid & 3, fr = lane & 15, fq = lane >> 4;
    const int K = g.K; int nt;
    unsigned voffA[2], voffB[2];
#pragma unroll
    for (int i = 0; i < 2; ++i) { int R, C; stage_rc(tid * 16 + i * 8192, R, C); const int Rb = Epi::PERM ? ((R & ~31) + perm32(R & 31)) : R;
        voffA[i] = (unsigned)(R * K + C) * 2u; voffB[i] = (unsigned)(Rb * K + C) * 2u; }
    const size_t kstep = (size_t)(BK * 2);
    const size_t hstep = (size_t)HALF * K * 2;
    const size_t tstep = 2 * hstep;
    const unsigned ldsw = (unsigned)wid * 1024u;
    const int aoff = lds_byte(wr * 64 + fr, fq * 8), boff = lds_byte(wc * 32 + fr, fq * 8);
#define PG8_SA(b, h) (((b) * 2 + (h)) * HTB)
#define PG8_SB(b, h) ((4 + (b) * 2 + (h)) * HTB)
#define PG8_STAGE(bufoff, gbase, voff) do { _Pragma("unroll") for (int _i = 0; _i < 2; ++_i) \
        __builtin_amdgcn_global_load_lds((const unsigned*)((const char*)(gbase) + (voff)[_i]), (PG8_LAS unsigned*)(lds + (bufoff) + ldsw + _i * 8192), 16, 0, 0); } while (0)
#define PG8_LDA(dst, b, h) do { _Pragma("unroll") for (int m = 0; m < 4; ++m) _Pragma("unroll") for (int k = 0; k < 2; ++k) dst[m][k] = *(const PG8_LAS bf16x8*)(lds + PG8_SA(b, h) + aoff + m * 2048 + k * 1024); } while (0)
#define PG8_LDB(dst, b, h) do { _Pragma("unroll") for (int n = 0; n < 2; ++n) _Pragma("unroll") for (int k = 0; k < 2; ++k) dst[n][k] = *(const PG8_LAS bf16x8*)(lds + PG8_SB(b, h) + boff + n * 2048 + k * 1024); } while (0)
#define PG8_MMA(ai, bj, At, Bt) do { __builtin_amdgcn_s_setprio(1); _Pragma("unroll") for (int m = 0; m < 4; ++m) _Pragma("unroll") for (int n = 0; n < 2; ++n) _Pragma("unroll") for (int k = 0; k < 2; ++k) \
        acc[ai][bj][m][n] = __builtin_amdgcn_mfma_f32_16x16x32_bf16(Bt[n][k], At[m][k], acc[ai][bj][m][n], 0, 0, 0); __builtin_amdgcn_s_setprio(0); } while (0)
#define PG8_WAIT_V(n) asm volatile("s_waitcnt vmcnt(" #n ")" ::: "memory")
#define PG8_WAIT_L(n) asm volatile("s_waitcnt lgkmcnt(" #n ")" ::: "memory")
#define PG8_BAR __builtin_amdgcn_s_barrier()
#define PG8_SCHED __builtin_amdgcn_sched_barrier(0)
    Unit cur, nxt; int ui = 0;
    if (!S.next(0, cur)) return;
    f32x4 acc[2][2][4][2];
#pragma unroll
    for (int a = 0; a < 2; ++a)
#pragma unroll
        for (int b = 0; b < 2; ++b)
#pragma unroll
            for (int m = 0; m < 4; ++m)
#pragma unroll
                for (int n = 0; n < 2; ++n) acc[a][b][m][n] = (f32x4){0.f, 0.f, 0.f, 0.f};
    bf16x8 At[4][2], B0[2][2], B1[2][2];
    const char* cA = (const char*)g.A + (size_t)cur.pm * tstep + cur.kb; const char* cB = (const char*)g.Bt + (size_t)cur.pn * tstep + cur.kb; nt = cur.nt;
    S.a_ready(cur);
    if constexpr (SP2) {
        PG8_STAGE(PG8_SB(0, 0), cB, voffB); PG8_STAGE(PG8_SB(0, 1), cB + hstep, voffB); PG8_STAGE(PG8_SA(0, 0), cA, voffA); PG8_STAGE(PG8_SA(0, 1), cA + hstep, voffA);
        if (wr == 1) PG8_BAR;
        PG8_WAIT_V(2); PG8_BAR;
        PG8_STAGE(PG8_SB(1, 0), cB + kstep, voffB); PG8_STAGE(PG8_SA(1, 0), cA + kstep, voffA); PG8_STAGE(PG8_SB(1, 1), cB + hstep + kstep, voffB);
        PG8_WAIT_V(6); PG8_BAR;
    } else {
        PG8_STAGE(PG8_SB(0, 0), cB, voffB); PG8_STAGE(PG8_SA(0, 0), cA, voffA); PG8_STAGE(PG8_SB(0, 1), cB + hstep, voffB); PG8_STAGE(PG8_SA(0, 1), cA + hstep, voffA);
        if (wr == 1) PG8_BAR;
        PG8_WAIT_V(4); PG8_BAR;
        PG8_STAGE(PG8_SB(1, 0), cB + kstep, voffB); PG8_STAGE(PG8_SA(1, 0), cA + kstep, voffA); PG8_STAGE(PG8_SB(1, 1), cB + hstep + kstep, voffB);
        PG8_WAIT_V(6); PG8_BAR;
    }
    for (;;) {
        const bool has_next = S.next(ui + 1, nxt);
        const char* nA = has_next ? (const char*)g.A + (size_t)nxt.pm * tstep + nxt.kb : cA; const char* nB = has_next ? (const char*)g.Bt + (size_t)nxt.pn * tstep + nxt.kb : cB;
        for (int t = 0; t < nt; t += 2) {
            const bool last = (t == nt - 2);
            const char* a1 = cA + (size_t)(t + 1) * kstep;
            const char* a2 = last ? nA : cA + (size_t)(t + 2) * kstep; const char* b2 = last ? nB : cB + (size_t)(t + 2) * kstep;
            const char* a3 = a2 + kstep; const char* b3 = b2 + kstep;
            if (last && has_next) S.a_ready(nxt);
            if constexpr (SP2) {
            PG8_LDB(B0, 0, 0); PG8_LDB(B1, 0, 1); PG8_SCHED; PG8_LDA(At, 0, 0); PG8_STAGE(PG8_SA(1, 1), a1 + hstep, voffA);
            PG8_WAIT_V(8); PG8_WAIT_L(0); PG8_BAR; PG8_MMA(0, 0, At, B0); PG8_MMA(0, 1, At, B1); PG8_BAR; PG8_SCHED;
            PG8_LDA(At, 0, 1); PG8_STAGE(PG8_SB(0, 0), b2, voffB); PG8_STAGE(PG8_SB(0, 1), b2 + hstep, voffB); PG8_STAGE(PG8_SA(0, 0), a2, voffA);
            PG8_WAIT_V(8); PG8_WAIT_L(0); PG8_BAR; PG8_MMA(1, 0, At, B0); PG8_MMA(1, 1, At, B1); PG8_BAR; PG8_SCHED;
            PG8_LDB(B0, 1, 0); PG8_LDB(B1, 1, 1); PG8_SCHED; PG8_LDA(At, 1, 0); PG8_STAGE(PG8_SA(0, 1), a2 + hstep, voffA);
            PG8_WAIT_V(8); PG8_WAIT_L(0); PG8_BAR; PG8_MMA(0, 0, At, B0); PG8_MMA(0, 1, At, B1); PG8_BAR; PG8_SCHED;
            PG8_LDA(At, 1, 1); PG8_STAGE(PG8_SB(1, 0), b3, voffB); PG8_STAGE(PG8_SB(1, 1), b3 + hstep, voffB); PG8_STAGE(PG8_SA(1, 0), a3, voffA);
            PG8_WAIT_V(8); PG8_WAIT_L(0); PG8_BAR; PG8_MMA(1, 0, At, B0); PG8_MMA(1, 1, At, B1); PG8_BAR; PG8_SCHED;
            } else {
            PG8_LDB(B0, 0, 0); PG8_SCHED; PG8_LDA(At, 0, 0); PG8_STAGE(PG8_SA(1, 1), a1 + hstep, voffA);
            PG8_WAIT_L(8); PG8_BAR; PG8_WAIT_L(0); PG8_MMA(0, 0, At, B0); PG8_BAR; PG8_SCHED;
            PG8_LDB(B1, 0, 1); PG8_STAGE(PG8_SB(0, 0), b2, voffB);
            PG8_BAR; PG8_WAIT_L(0); PG8_MMA(0, 1, At, B1); PG8_BAR;
            PG8_LDA(At, 0, 1); PG8_STAGE(PG8_SA(0, 0), a2, voffA);
            PG8_BAR; PG8_WAIT_L(0); PG8_MMA(1, 0, At, B0); PG8_BAR; PG8_SCHED;
            PG8_STAGE(PG8_SB(0, 1), b2 + hstep, voffB);
            PG8_WAIT_V(6); PG8_BAR; PG8_MMA(1, 1, At, B1); PG8_BAR;
            PG8_LDB(B0, 1, 0); PG8_SCHED; PG8_LDA(At, 1, 0); PG8_STAGE(PG8_SA(0, 1), a2 + hstep, voffA);
            PG8_WAIT_L(8); PG8_BAR; PG8_WAIT_L(0); PG8_MMA(0, 0, At, B0); PG8_BAR; PG8_SCHED;
            PG8_LDB(B1, 1, 1); PG8_STAGE(PG8_SB(1, 0), b3, voffB);
            PG8_BAR; PG8_WAIT_L(0); PG8_MMA(0, 1, At, B1); PG8_BAR;
            PG8_LDA(At, 1, 1); PG8_STAGE(PG8_SA(1, 0), a3, voffA);
            PG8_BAR; PG8_WAIT_L(0); PG8_MMA(1, 0, At, B0); PG8_BAR; PG8_SCHED;
            PG8_STAGE(PG8_SB(1, 1), b3 + hstep, voffB);
            PG8_WAIT_V(6); PG8_BAR; PG8_MMA(1, 1, At, B1); PG8_BAR;
            }
        }
        if constexpr (ALIGN_EPI) { if (wr == 0) PG8_BAR; }
        if constexpr (!Epi::AFTER_DRAIN) { E(acc, cur, wr, wc, fr, fq); S.done(cur); }
        if (!has_next) break;
#pragma unroll
        for (int a = 0; a < 2; ++a)
#pragma unroll
            for (int b = 0; b < 2; ++b)
#pragma unroll
                for (int m = 0; m < 4; ++m)
#pragma unroll
                    for (int n = 0; n < 2; ++n) acc[a][b][m][n] = (f32x4){0.f, 0.f, 0.f, 0.f};
        cur = nxt; cA = nA; cB = nB; nt = cur.nt; ++ui;
        if constexpr (ALIGN_EPI) { if (wr == 1) PG8_BAR; }
    }
    PG8_WAIT_V(0);
    if constexpr (!ALIGN_EPI) { if (wr == 0) PG8_BAR; }
    PG8_BAR;
    if constexpr (Epi::AFTER_DRAIN) { E.fused(acc, cur, wr, wc, fr, fq, lds, wid, lane); S.done(cur); }
#undef PG8_SA
#undef PG8_SB
#undef PG8_STAGE
#undef PG8_LDA
#undef PG8_LDB
#undef PG8_MMA
#undef PG8_WAIT_V
#undef PG8_WAIT_L
#undef PG8_BAR
#undef PG8_SCHED
}
}
constexpr int NWAVES = 8;
constexpr int RP = 16384, RS = 1024, R = RP + RS;
constexpr int DM = 2048, DFF = 5632, DFF2 = 11264, BPROJ = 4176, NBP = 4352;
constexpr float EPS = 1e-6f;
constexpr float QSCALE = 0.08838834764831845f * 1.4426950408889634f;
constexpr size_t OFF_Y = 0, OFF_KP = 35651584, OFF_VP = 44040192, OFF_IKP = 52428800, OFF_KS = 53477376, OFF_VS = 54001664, OFF_IKS = 54525952,
                 OFF_CV = 54591488, OFF_CP = 56688640, OFF_CS = 57049088, OUT_TOTAL = 62816256;
constexpr size_t CTL_BYTES = 1u << 20;
constexpr size_t WS_WAIN = CTL_BYTES;
constexpr size_t WS_WAOUT = WS_WAIN + (size_t)4096 * 2048 * 2;
constexpr size_t WS_WBIN = WS_WAOUT + (size_t)2048 * 2048 * 2;
constexpr size_t WS_WBO = WS_WBIN + (size_t)NBP * 2048 * 2;
constexpr size_t WS_WFIN = WS_WBO + (size_t)2048 * 2048 * 2;
constexpr size_t WS_WFOUT = WS_WFIN + (size_t)2 * DFF2 * 2048 * 2;
constexpr size_t WS_XB = WS_WFOUT + (size_t)2 * 2048 * DFF * 2;
constexpr size_t WS_SS = WS_XB + (size_t)R * 2048 * 2;
constexpr size_t WS_XA = WS_SS + (size_t)R * 32 * 4;
constexpr size_t WS_U = WS_XA + (size_t)R * 2048 * 4;
constexpr size_t WS_V = WS_U + (size_t)R * 2048 * 2;
constexpr size_t WS_VSS = WS_V + (size_t)R * 2048 * 2;
constexpr size_t WS_GT = WS_VSS + (size_t)R * 32 * 4;
constexpr size_t WS_AB = WS_GT + (size_t)R * 2048 * 2;
constexpr size_t WS_HID = WS_AB + (size_t)R * DFF2 * 2;
constexpr size_t WS_P = WS_HID + (size_t)R * DFF * 2;
constexpr size_t WS_Q = WS_P + (size_t)R * NBP * 2;
constexpr size_t WS_KB = WS_Q + (size_t)R * 2048 * 2;
constexpr size_t WS_VB = WS_KB + (size_t)R * 512 * 2;
constexpr size_t WS_IQ = WS_VB + (size_t)R * 512 * 2;
constexpr size_t WS_IK = WS_IQ + (size_t)R * 1024 * 2;
constexpr size_t WS_IW = WS_IK + (size_t)R * 64 * 2;
constexpr size_t WS_ROPE = WS_IW + (size_t)R * 16 * 4;
constexpr size_t WS_SC = WS_ROPE + (size_t)2056 * 96 * 2 * 4;
constexpr size_t WS_SCS = WS_SC + (size_t)RP * 2048 * 4;
constexpr size_t WS_MASK = WS_SCS + (size_t)RS * 2112 * 4;
constexpr size_t WS_O = WS_MASK + (size_t)R * 34 * 8;
constexpr size_t WS_SLAB = WS_O + (size_t)R * 2048 * 2;
constexpr size_t WS_RSTD = WS_SLAB + (size_t)16384 * 1024 * 4;
constexpr size_t WS_END = WS_RSTD + (size_t)R * 4;
constexpr int CW_BAR = 4096;
constexpr int CW_WQ = 8192;
constexpr int CW_CHK = 16384;
constexpr int LDS_BYTES = 147456;
constexpr int MISC_OFF = 147456 - 512;

#define GAS __attribute__((address_space(1)))
#define LAS __attribute__((address_space(3)))
#define DI __device__ __forceinline__
typedef unsigned short bf16;
typedef unsigned v4u __attribute__((ext_vector_type(4)));
typedef unsigned v2u __attribute__((ext_vector_type(2)));
typedef float f32x4 __attribute__((ext_vector_type(4)));
typedef float f32x16 __attribute__((ext_vector_type(16)));
typedef short bf16x8 __attribute__((ext_vector_type(8)));
typedef GAS unsigned gu32;
#define RLX_AGENT __ATOMIC_RELAXED, __HIP_MEMORY_SCOPE_AGENT
#define LDS_WAIT() asm volatile("s_waitcnt lgkmcnt(0)" ::: "memory")
#define MFMA32(a, b, c) __builtin_amdgcn_mfma_f32_32x32x16_bf16((a), (b), (c), 0, 0, 0)
#define MFMA16(a, b, c) __builtin_amdgcn_mfma_f32_16x16x32_bf16((a), (b), (c), 0, 0, 0)
DI float bf2f(unsigned short h) { return __uint_as_float(((unsigned)h) << 16); }
DI float bflo(unsigned w) { return __uint_as_float(w << 16); }
DI float bfhi(unsigned w) { return __uint_as_float(w & 0xffff0000u); }
DI unsigned pk2(float lo, float hi) { return pg8::cvt_pk_bf16(lo, hi); }
DI unsigned short f2bf(float f) { return (unsigned short)(pk2(f, 0.f) & 0xffffu); }
DI float wave_sum(float v) {
#pragma unroll
    for (int o = 1; o < 64; o <<= 1) v += __shfl_xor(v, o);
    return v;
}
DI float fexp2(float x) { return __builtin_amdgcn_exp2f(x); }
#define XB_TMO      128
#define XB_XCNT(j)  (256  + 64 * (j))
#define XB_XSUB(j)  (1280 + 64 * (j))
#define XB_XGEN(j)  (2304 + 64 * (j))
#define XB_TOP      3328
#define XB_TOPGEN   3392
#define XCD_BAR_WORDS 3456
#define XB_SPIN_CAP (1u << 18)

__device__ __forceinline__ unsigned xb_ld(unsigned* p)              { return __hip_atomic_load(p, __ATOMIC_RELAXED, __HIP_MEMORY_SCOPE_AGENT); }
__device__ __forceinline__ unsigned xb_add(unsigned* p, unsigned v) { return __hip_atomic_fetch_add(p, v, __ATOMIC_RELAXED, __HIP_MEMORY_SCOPE_AGENT); }
__device__ __forceinline__ unsigned xb_xcc_id() { return (unsigned)__builtin_amdgcn_s_getreg((3 << 11) | 20) & 0xFu; }
#define XB_SPIN(cond, bar) do { unsigned _sp = 0; while (cond) { __builtin_amdgcn_s_sleep(1); \
    if ((++_sp & 255u) == 0u) { if (xb_ld(&(bar)[XB_TMO])) break; if (_sp > XB_SPIN_CAP) { atomicAdd(&(bar)[XB_TMO], 1u); break; } } } } while (0)

struct XcdBarrier {
    unsigned* bar; unsigned x;
    volatile LAS unsigned* st;
};

__device__ __forceinline__ XcdBarrier xcd_barrier_post(unsigned* bar, volatile LAS unsigned* st) {
    XcdBarrier b; b.bar = bar; b.x = xb_xcc_id(); b.st = st;
    if (threadIdx.x == 0) (void)xb_add(&bar[XB_XCNT(b.x)], 1u);
    return b;
}
__device__ __forceinline__ void xcd_barrier_complete(unsigned* bar, unsigned x, unsigned& nloc, unsigned& nx) {
    const unsigned G = gridDim.x * gridDim.y * gridDim.z;
    unsigned sum, cnt, mine, sp = 0u;
    for (;;) {
        sum = 0u; cnt = 0u; mine = 0u;
#pragma unroll
        for (unsigned j = 0; j < 16; ++j) { const unsigned c = xb_ld(&bar[XB_XCNT(j)]); sum += c; cnt += (c > 0u) ? 1u : 0u; mine = (j == x) ? c : mine; }
        if (sum == G) break;
        __builtin_amdgcn_s_sleep(1);
        if ((++sp & 255u) == 0u) { if (xb_ld(&bar[XB_TMO])) break; if (sp > XB_SPIN_CAP) { atomicAdd(&bar[XB_TMO], 1u); break; } }
    }
    nloc = mine > 0u ? mine : 1u; nx = cnt > 0u ? cnt : 1u;
}

__device__ __forceinline__ void xcd_barrier(const XcdBarrier& b) {
    asm volatile("s_waitcnt vmcnt(0)" ::: "memory");
    __syncthreads();
    if (threadIdx.x == 0) {
        unsigned* bar = b.bar;
        __builtin_amdgcn_s_waitcnt(0);
        unsigned nloc = b.st[0], nx = b.st[1];
        if (nloc == 0u) { xcd_barrier_complete(bar, b.x, nloc, nx); b.st[0] = nloc; b.st[1] = nx; }
        const unsigned old = xb_add(&bar[XB_XSUB(b.x)], 1u);
        const unsigned gen = old / nloc;
        if (old + 1u == (gen + 1u) * nloc) {
            __builtin_amdgcn_fence(__ATOMIC_RELEASE, "agent");
            asm volatile("s_waitcnt vmcnt(0)" ::: "memory");
            const unsigned og = xb_add(&bar[XB_TOP], 1u);
            const unsigned tg = og / nx;
            if (og + 1u == (tg + 1u) * nx) xb_add(&bar[XB_TOPGEN], 1u);
            else XB_SPIN(xb_ld(&bar[XB_TOPGEN]) == tg, bar);
            __builtin_amdgcn_fence(__ATOMIC_ACQUIRE, "agent");
            xb_add(&bar[XB_XGEN(b.x)], 1u);
            asm volatile("s_waitcnt vmcnt(0)" ::: "memory");
        } else {
            XB_SPIN(xb_ld(&bar[XB_XGEN(b.x)]) == gen, bar);
            __builtin_amdgcn_fence(__ATOMIC_ACQUIRE, "agent");
            asm volatile("s_waitcnt vmcnt(0)" ::: "memory");
        }
    }
    __syncthreads();
}
struct Args { const float* in[23]; float* out; unsigned char* ws; int ph_lo, ph_hi; };
struct Ctx { LAS unsigned char* lds; int tid, lane, wave, G, bx; };

DI void p0_transpose_item(const float* W, const float* gain, int K, int N, int Npad, bf16* WT, LAS float* scr, int item, int lane, bool permF = false) {
    const int nblk = Npad / 64, kb = item / nblk, nb = item % nblk, k0 = 64 * kb, n0 = 64 * nb;
    const int l15 = lane & 15, kq = lane >> 4, n = n0 + 4 * l15;
    const int nout0 = !permF ? n0 : (n0 < 5632 ? 256 * (n0 >> 7) + (n0 & 127) : 256 * ((n0 - 5632) >> 7) + 128 + ((n0 - 5632) & 127));
    f32x4 v[16];
#pragma unroll
    for (int i = 0; i < 16; ++i) { v[i] = (f32x4){0.f, 0.f, 0.f, 0.f}; if (n < N) v[i] = *(const f32x4*)(W + (size_t)(k0 + 4 * i + kq) * N + n); }
    if (gain) {
#pragma unroll
        for (int i = 0; i < 16; ++i) v[i] *= gain[k0 + 4 * i + kq]; }
#pragma unroll
    for (int i = 0; i < 16; ++i) { LAS float* d = scr + (4 * i + kq) * 65 + 4 * l15; d[0] = v[i][0]; d[1] = v[i][1]; d[2] = v[i][2]; d[3] = v[i][3]; }
    LDS_WAIT(); asm volatile("" ::: "memory");
    const int c = lane & 7;
#pragma unroll
    for (int j = 0; j < 8; ++j) { const int nn = (lane >> 3) + 8 * j; const LAS float* s = scr + (8 * c) * 65 + nn;
        v4u o; o.x = pk2(s[0 * 65], s[1 * 65]); o.y = pk2(s[2 * 65], s[3 * 65]); o.z = pk2(s[4 * 65], s[5 * 65]); o.w = pk2(s[6 * 65], s[7 * 65]);
        *(GAS v4u*)(WT + (size_t)(nout0 + nn) * K + k0 + 8 * c) = o; }
    LDS_WAIT(); asm volatile("" ::: "memory");
}
DI void sincos_small(double r, double& s, double& c) {
    const double r2 = r * r;
    double ts = 1.0 / 51090942171709440000.0;
    ts = ts * r2 * (-1.0) + 1.0 / 121645100408832000.0;
    ts = ts * (-r2) + 1.0 / 355687428096000.0;
    ts = ts * (-r2) + 1.0 / 1307674368000.0;
    ts = ts * (-r2) + 1.0 / 6227020800.0;
    ts = ts * (-r2) + 1.0 / 39916800.0;
    ts = ts * (-r2) + 1.0 / 362880.0;
    ts = ts * (-r2) + 1.0 / 5040.0;
    ts = ts * (-r2) + 1.0 / 120.0;
    ts = ts * (-r2) + 1.0 / 6.0;
    ts = ts * (-r2) + 1.0;
    s = ts * r;
    double tc = 1.0 / 2432902008176640000.0;
    tc = tc * (-r2) + 1.0 / 6402373705728000.0;
    tc = tc * (-r2) + 1.0 / 20922789888000.0;
    tc = tc * (-r2) + 1.0 / 87178291200.0;
    tc = tc * (-r2) + 1.0 / 479001600.0;
    tc = tc * (-r2) + 1.0 / 3628800.0;
    tc = tc * (-r2) + 1.0 / 40320.0;
    tc = tc * (-r2) + 1.0 / 720.0;
    tc = tc * (-r2) + 1.0 / 24.0;
    tc = tc * (-r2) + 1.0 / 2.0;
    tc = tc * (-r2) + 1.0;
    c = tc;
}
DI void ph_prologue(const Args& a, const Ctx& C) {
    unsigned char* ws = a.ws;
    LAS float* scr = (LAS float*)(C.lds + C.wave * 16640);
    const int gw = C.bx * NWAVES + C.wave, NGW = C.G * NWAVES;
    constexpr int I_AIN = 32 * 64, I_AOUT = 32 * 32, I_FIN = 32 * (DFF2 / 64), I_BIN = 32 * (NBP / 64), I_FIN1B = I_FIN / 2;
    constexpr int NITEMS = I_AIN + I_AOUT + I_FIN + I_BIN + I_FIN1B;
    for (int it = gw; it < NITEMS; it += NGW) {
        int r = it;
        if (r < I_AIN) { p0_transpose_item(a.in[8], a.in[7], 2048, 4096, 4096, (bf16*)(ws + WS_WAIN), scr, r, C.lane); continue; } r -= I_AIN;
        if (r < I_AOUT) { p0_transpose_item(a.in[12], nullptr, 2048, 2048, 2048, (bf16*)(ws + WS_WAOUT), scr, r, C.lane); continue; } r -= I_AOUT;
        if (r < I_FIN) { p0_transpose_item(a.in[19], a.in[18], 2048, DFF2, DFF2, (bf16*)(ws + WS_WFIN), scr, r, C.lane, true); continue; } r -= I_FIN;
        if (r < I_BIN) { p0_transpose_item(a.in[14], a.in[13], 2048, BPROJ, NBP, (bf16*)(ws + WS_WBIN), scr, r, C.lane); continue; } r -= I_BIN;
        p0_transpose_item(a.in[19] + (size_t)2048 * DFF2, a.in[18] + 2048, 2048, DFF2, DFF2, (bf16*)(ws + WS_WFIN) + (size_t)DFF2 * 2048, scr, I_FIN1B + r, C.lane, true);
    }
    bf16* XB = (bf16*)(ws + WS_XB); float* SS = (float*)(ws + WS_SS);
    for (int row = gw; row < R; row += NGW) {
        const float* src = row < RP ? a.in[0] + (size_t)row * 2048 : a.in[1] + (size_t)(row - RP) * 2048;
        const GAS f32x4* xr = (const GAS f32x4*)src + C.lane; float s = 0.f;
        GAS v2u* o8 = (GAS v2u*)(XB + (size_t)row * 2048) + C.lane;
#pragma unroll
        for (int j = 0; j < 8; ++j) { const f32x4 v = xr[64 * j]; s += (v[0] * v[0] + v[1] * v[1]) + (v[2] * v[2] + v[3] * v[3]); v2u w; w.x = pk2(v[0], v[1]); w.y = pk2(v[2], v[3]); o8[64 * j] = w; }
        s = wave_sum(s);
        if (C.lane < 32) SS[(size_t)row * 32 + C.lane] = C.lane == 0 ? s : 0.f;
        if (C.lane == 0) ((float*)(ws + WS_RSTD))[row] = 1.0f / sqrtf(s * (1.0f / 2048.0f) + EPS);
    }
    float* rope = (float*)(ws + WS_ROPE);
    for (int idx = C.bx * 512 + C.tid; idx < 2056 * 96; idx += C.G * 512) {
        const int pos = idx / 96, i = idx % 96;
        const float ex = i < 64 ? (float)i * (2.0f / 128.0f) : (float)(i - 64) * (2.0f / 64.0f);
        const float inv = exp2f(-ex * 13.287712379549449f);
        const double ang = (double)pos * (double)inv;
        const double k = __builtin_rint(ang * 0.15915494309189535);
        const double rr = ang - k * 6.283185307179586;
        double sn, cs; sincos_small(rr, sn, cs);
        rope[2 * idx] = (float)cs; rope[2 * idx + 1] = (float)sn;
    }
}

constexpr int FQ_FOUT = (DFF / 64) * 32, FQ_BO = 32 * 32, FQ_FIN1A = 32 * (DFF2 / 64) / 2;
DI void filler_pull(const Args& a, const Ctx& C, int q) {
    unsigned char* ws = a.ws; gu32* head = (gu32*)ws + CW_WQ + 64 * (8 + q);
    LAS float* scr = (LAS float*)(C.lds + C.wave * 16640);
    const int n = q == 1 ? FQ_BO + FQ_FIN1A : FQ_FOUT;
    for (;;) {
        int it = 0; if (C.lane == 0) it = (int)__hip_atomic_fetch_add(head, 1u, RLX_AGENT);
        it = __builtin_amdgcn_readfirstlane(it);
        if (it >= n) break;
        if (q == 0) p0_transpose_item(a.in[22], nullptr, DFF, 2048, 2048, (bf16*)(ws + WS_WFOUT), scr, it, C.lane);
        else if (q == 2) p0_transpose_item(a.in[22] + (size_t)DFF * 2048, nullptr, DFF, 2048, 2048, (bf16*)(ws + WS_WFOUT) + (size_t)2048 * DFF, scr, it, C.lane);
        else { if (it < FQ_BO) p0_transpose_item(a.in[17], nullptr, 2048, 2048, 2048, (bf16*)(ws + WS_WBO), scr, it, C.lane);
               else p0_transpose_item(a.in[19] + (size_t)2048 * DFF2, a.in[18] + 2048, 2048, DFF2, DFF2, (bf16*)(ws + WS_WFIN) + (size_t)DFF2 * 2048, scr, it - FQ_BO, C.lane, true); }
    }
}
DI float rstd32(const float* p) { const f32x4* q = (const f32x4*)p; f32x4 a = q[0];
#pragma unroll
    for (int i = 1; i < 8; ++i) a += q[i];
    return 1.0f / sqrtf(((a[0] + a[1]) + (a[2] + a[3])) * (1.0f / 2048.0f) + EPS); }
DI void ph_gate(const Args& a, const Ctx& C) {
    unsigned char* ws = a.ws;
    const bf16* V = (const bf16*)(ws + WS_V); const bf16* U = (const bf16*)(ws + WS_U); bf16* GT = (bf16*)(ws + WS_GT); const float* vss = (const float*)(ws + WS_VSS);
    const float* vgain = a.in[9]; const float* Ws = a.in[10]; const float* bs = a.in[11];
    LAS unsigned char* vt = C.lds;
    LAS float* rsv = (LAS float*)(C.lds + 36864);
    const int l15 = C.lane & 15, kq = C.lane >> 4;
    int gcur = -1; bf16x8 wf[4];
#pragma unroll
    for (int kk = 0; kk < 4; ++kk) wf[kk] = (bf16x8){0, 0, 0, 0, 0, 0, 0, 0};
    v4u vraw[4]; v2u ureg[8]; f32x4 ssr[8];
#define G_LOAD(u_) do { const int g_ = (u_) & 15, r0_ = ((u_) >> 4) * 128; \
        _Pragma("unroll") for (int it = 0; it < 2; ++it) { const int ix_ = C.wave + 8 * it, p_ = 16 * (ix_ & 3) + l15, c_ = 4 * (ix_ >> 2) + kq; \
            vraw[2 * it] = *(const v4u*)(V + (size_t)(r0_ + 2 * p_) * 2048 + g_ * 128 + c_ * 8); vraw[2 * it + 1] = *(const v4u*)(V + (size_t)(r0_ + 2 * p_ + 1) * 2048 + g_ * 128 + c_ * 8); } \
        if (C.tid < 128) { _Pragma("unroll") for (int q = 0; q < 8; ++q) ssr[q] = *(const f32x4*)(vss + (size_t)(r0_ + C.tid) * 32 + 4 * q); } \
        _Pragma("unroll") for (int db = 0; db < 8; ++db) ureg[db] = *(const v2u*)(U + (size_t)(r0_ + 16 * C.wave + l15) * 2048 + g_ * 128 + db * 16 + 4 * kq); } while (0)
    if (C.bx < 2048) G_LOAD(C.bx);
    for (int u = C.bx; u < 2048; u += C.G) {
        const int g = u & 15, chunk = u >> 4, r0 = chunk * 128;
        if (g != gcur) { gcur = g; const int t = 16 * C.wave + l15;
#pragma unroll
            for (int kk = 0; kk < 4; ++kk) { const int s0 = 32 * kk + 8 * kq; const float* wp = Ws + ((size_t)g * 128 + t) * 128 + s0;
                const f32x4 w0 = *(const f32x4*)wp, w1 = *(const f32x4*)(wp + 4); v4u o;
                o.x = pk2(s0 + 0 <= t ? w0[0] : 0.f, s0 + 1 <= t ? w0[1] : 0.f); o.y = pk2(s0 + 2 <= t ? w0[2] : 0.f, s0 + 3 <= t ? w0[3] : 0.f);
                o.z = pk2(s0 + 4 <= t ? w1[0] : 0.f, s0 + 5 <= t ? w1[1] : 0.f); o.w = pk2(s0 + 6 <= t ? w1[2] : 0.f, s0 + 7 <= t ? w1[3] : 0.f);
                wf[kk] = __builtin_bit_cast(bf16x8, o); } }
        if (C.tid < 128) { f32x4 a4 = ssr[0];
#pragma unroll
            for (int q = 1; q < 8; ++q) a4 += ssr[q];
            rsv[C.tid] = 1.0f / sqrtf(((a4[0] + a4[1]) + (a4[2] + a4[3])) * (1.0f / 2048.0f) + EPS); }
        __syncthreads();
#pragma unroll
        for (int it = 0; it < 2; ++it) { const int ix = C.wave + 8 * it, p = 16 * (ix & 3) + l15, c = 4 * (ix >> 2) + kq;
            const v4u ra = vraw[2 * it], rb = vraw[2 * it + 1]; const float rsa = rsv[2 * p], rsb = rsv[2 * p + 1];
            const f32x4 g0 = *(const f32x4*)(vgain + g * 128 + c * 8), g1 = *(const f32x4*)(vgain + g * 128 + c * 8 + 4);
            const float xa[8] = {bflo(ra.x) * g0[0], bfhi(ra.x) * g0[1], bflo(ra.y) * g0[2], bfhi(ra.y) * g0[3], bflo(ra.z) * g1[0], bfhi(ra.z) * g1[1], bflo(ra.w) * g1[2], bfhi(ra.w) * g1[3]};
            const float xb_[8] = {bflo(rb.x) * g0[0], bfhi(rb.x) * g0[1], bflo(rb.y) * g0[2], bfhi(rb.y) * g0[3], bflo(rb.z) * g1[0], bfhi(rb.z) * g1[1], bflo(rb.w) * g1[2], bfhi(rb.w) * g1[3]};
#pragma unroll
            for (int i = 0; i < 8; ++i) *(LAS unsigned*)(vt + (c * 8 + i) * 272 + p * 4) = pk2(xa[i] * rsa, xb_[i] * rsb); }
        v2u ucur[8];
#pragma unroll
        for (int db = 0; db < 8; ++db) ucur[db] = ureg[db];
        __syncthreads();
        if (u + C.G < 2048) G_LOAD(u + C.G);
        __builtin_amdgcn_sched_barrier(0);
        const int t = 16 * C.wave + l15, row = r0 + t; const float bias = bs[g * 128 + t];
#pragma unroll
        for (int db = 0; db < 8; ++db) { f32x4 acc = {0.f, 0.f, 0.f, 0.f};
#pragma unroll
            for (int kk = 0; kk < 4; ++kk) if (kk <= (C.wave >> 1)) { const bf16x8 av = *(const LAS bf16x8*)(vt + (db * 16 + l15) * 272 + (kk * 32 + kq * 8) * 2); acc = MFMA16(av, wf[kk], acc); }
            const size_t off = (size_t)row * 2048 + g * 128 + db * 16 + 4 * kq;
            const v2u uu = ucur[db]; v2u o;
            o.x = pk2(bflo(uu.x) * (acc[0] + bias), bfhi(uu.x) * (acc[1] + bias)); o.y = pk2(bflo(uu.y) * (acc[2] + bias), bfhi(uu.y) * (acc[3] + bias));
            *(v2u*)(GT + off) = o; }
        __syncthreads();
    }
#undef G_LOAD
    float* cvout = a.out + OFF_CV;
    for (int us = C.bx; us < 32; us += C.G) {
        const int r0 = RP + 32 * us;
        if (C.tid < 32) rsv[C.tid] = rstd32(vss + (size_t)(r0 + C.tid) * 32);
        __syncthreads();
#pragma unroll 1
        for (int it = 0; it < 2; ++it) { const int id = C.tid + 512 * it, bl = id >> 8, c = id & 255, col = c * 8, g = col >> 7;
            const f32x4 g0 = *(const f32x4*)(vgain + col), g1 = *(const f32x4*)(vgain + col + 4);
            float vn[8][8];
#pragma unroll
            for (int t = 0; t < 8; ++t) { const size_t off = (size_t)(r0 + 8 * bl + t) * 2048 + col; const v4u raw = *(const v4u*)(V + off); const float rs = rsv[8 * bl + t];
                vn[t][0] = bflo(raw.x) * rs * g0[0]; vn[t][1] = bfhi(raw.x) * rs * g0[1]; vn[t][2] = bflo(raw.y) * rs * g0[2]; vn[t][3] = bfhi(raw.y) * rs * g0[3];
                vn[t][4] = bflo(raw.z) * rs * g1[0]; vn[t][5] = bfhi(raw.z) * rs * g1[1]; vn[t][6] = bflo(raw.w) * rs * g1[2]; vn[t][7] = bfhi(raw.w) * rs * g1[3];
                float* co = cvout + (size_t)(32 * us + 8 * bl + t) * 2048 + col;
                *(f32x4*)co = (f32x4){vn[t][0], vn[t][1], vn[t][2], vn[t][3]}; *(f32x4*)(co + 4) = (f32x4){vn[t][4], vn[t][5], vn[t][6], vn[t][7]}; }
#pragma unroll
            for (int t = 0; t < 8; ++t) { float s[8]; const float bias = bs[g * 128 + t];
#pragma unroll
                for (int i = 0; i < 8; ++i) s[i] = bias;
#pragma unroll
                for (int sp = 0; sp <= t; ++sp) { const float wv = Ws[((size_t)g * 128 + t) * 128 + sp];
#pragma unroll
                    for (int i = 0; i < 8; ++i) s[i] += wv * vn[sp][i]; }
                const size_t off = (size_t)(r0 + 8 * bl + t) * 2048 + col; const v4u uu = *(const v4u*)(U + off); v4u o;
                o.x = pk2(bflo(uu.x) * s[0], bfhi(uu.x) * s[1]); o.y = pk2(bflo(uu.y) * s[2], bfhi(uu.y) * s[3]); o.z = pk2(bflo(uu.z) * s[4], bfhi(uu.z) * s[5]); o.w = pk2(bflo(uu.w) * s[6], bfhi(uu.w) * s[7]);
                *(v4u*)(GT + off) = o; } }
        __syncthreads();
    }
}
DI void up8(const v4u& r, float (&x)[8]) { x[0] = bflo(r.x); x[1] = bfhi(r.x); x[2] = bflo(r.y); x[3] = bfhi(r.y); x[4] = bflo(r.z); x[5] = bfhi(r.z); x[6] = bflo(r.w); x[7] = bfhi(r.w); }
DI void ld8(const float* p, float (&x)[8]) { const f32x4 a = *(const f32x4*)p, b = *(const f32x4*)(p + 4); x[0] = a[0]; x[1] = a[1]; x[2] = a[2]; x[3] = a[3]; x[4] = b[0]; x[5] = b[1]; x[6] = b[2]; x[7] = b[3]; }
DI void ph_conv(const Args& a, const Ctx& C, int layer) {
    unsigned char* ws = a.ws;
    const bf16* AB = (const bf16*)(ws + WS_AB); bf16* HID = (bf16*)(ws + WS_HID);
    const float* cw = a.in[20] + (size_t)layer * 3 * DFF2; const float* cb = a.in[21] + (size_t)layer * DFF2; const float* st = a.in[5] + (size_t)layer * 128 * 2 * DFF2;
    constexpr int NCC = DFF / 8, NBLK = 128 + 64;
    for (int item = C.bx * 512 + C.tid; item < NBLK * NCC; item += C.G * 512) {
        const int braw = item / NCC, cc = item % NCC, col = cc * 8;
        const bool smp = braw >= 32 && braw < 160; const int blk = smp ? braw - 32 : (braw < 32 ? braw : braw - 128);
        const int r0 = smp ? RP + 8 * blk : 256 * blk, nrows = smp ? 8 : 2;
        v4u ga[8], ua[8];
#pragma unroll
        for (int q = 0; q < 8; ++q) { ga[q] = (v4u){0u, 0u, 0u, 0u}; ua[q] = ga[q];
            if (q < nrows) { ga[q] = *(const v4u*)(AB + (size_t)(r0 + q) * DFF2 + col); ua[q] = *(const v4u*)(AB + (size_t)(r0 + q) * DFF2 + DFF + col); } }
        float g1[8], g2[8], u1[8], u2[8];
#pragma unroll
        for (int i = 0; i < 8; ++i) { g1[i] = 0.f; g2[i] = 0.f; u1[i] = 0.f; u2[i] = 0.f; }
        if (smp) {
            ld8(st + (size_t)(blk * 2 + 0) * DFF2 + col, g2); ld8(st + (size_t)(blk * 2 + 1) * DFF2 + col, g1);
            ld8(st + (size_t)(blk * 2 + 0) * DFF2 + DFF + col, u2); ld8(st + (size_t)(blk * 2 + 1) * DFF2 + DFF + col, u1);
        } else if ((r0 & 2047) != 0) {
            up8(*(const v4u*)(AB + (size_t)(r0 - 1) * DFF2 + col), g1); up8(*(const v4u*)(AB + (size_t)(r0 - 2) * DFF2 + col), g2);
            up8(*(const v4u*)(AB + (size_t)(r0 - 1) * DFF2 + DFF + col), u1); up8(*(const v4u*)(AB + (size_t)(r0 - 2) * DFF2 + DFF + col), u2); }
        float w0g[8], w1g[8], w2g[8], bg[8], w0u[8], w1u[8], w2u[8], bu[8];
        ld8(cw + col, w0g); ld8(cw + DFF2 + col, w1g); ld8(cw + 2 * DFF2 + col, w2g); ld8(cb + col, bg);
        ld8(cw + DFF + col, w0u); ld8(cw + DFF2 + DFF + col, w1u); ld8(cw + 2 * DFF2 + DFF + col, w2u); ld8(cb + DFF + col, bu);
        __builtin_amdgcn_sched_barrier(0);
#pragma unroll
        for (int q = 0; q < 8; ++q) { const int row = r0 + q;
            float g0[8], u0[8]; up8(ga[q], g0); up8(ua[q], u0);
            float h[8];
#pragma unroll
            for (int i = 0; i < 8; ++i) { const float cg = bg[i] + w0g[i] * g2[i] + w1g[i] * g1[i] + w2g[i] * g0[i], cu = bu[i] + w0u[i] * u2[i] + w1u[i] * u1[i] + w2u[i] * u0[i];
                h[i] = cg * __builtin_amdgcn_rcpf(1.0f + fexp2(-1.4426950408889634f * cg)) * cu; g2[i] = g1[i]; g1[i] = g0[i]; u2[i] = u1[i]; u1[i] = u0[i]; }
            v4u o; o.x = pk2(h[0], h[1]); o.y = pk2(h[2], h[3]); o.z = pk2(h[4], h[5]); o.w = pk2(h[6], h[7]);
            if (q < nrows) *(v4u*)(HID + (size_t)row * DFF + col) = o; }
    }
}
DI void ph_qkrope(const Args& a, const Ctx& C) {
    unsigned char* ws = a.ws;
    const bf16* P = (const bf16*)(ws + WS_P); const float* rope = (const float*)(ws + WS_ROPE);
    bf16* Q = (bf16*)(ws + WS_Q); bf16* KB = (bf16*)(ws + WS_KB); bf16* VB = (bf16*)(ws + WS_VB); bf16* IQ = (bf16*)(ws + WS_IQ); bf16* IK = (bf16*)(ws + WS_IK); float* IW = (float*)(ws + WS_IW);
    const int gw = C.bx * NWAVES + C.wave, NGW = C.G * NWAVES, lane = C.lane;
    const int sub = lane & 15, hsel = lane >> 4, sub8 = lane & 7, hsel8 = lane >> 3;
    const f32x4 qga = *(const f32x4*)(a.in[15] + 4 * sub), qgb = *(const f32x4*)(a.in[15] + 64 + 4 * sub), kga = *(const f32x4*)(a.in[16] + 4 * sub), kgb = *(const f32x4*)(a.in[16] + 64 + 4 * sub);
    struct QkRow { v2u qa[4], qb[4], ia[2], ib[2], ka, kb, ka2, kb2; v4u vraw; float wv; f32x4 t0, t1, u0, u1; };
    auto load_row = [&](int row, QkRow& L) __attribute__((always_inline)) {
        const bf16* p = P + (size_t)row * NBP;
        const int pos = row < RP ? (row & 2047) : 2048 + ((row - RP) & 7);
        const float* rt = rope + (size_t)pos * 192;
#pragma unroll
        for (int it = 0; it < 4; ++it) { L.qa[it] = *(const v2u*)(p + (4 * it + hsel) * 128 + 4 * sub); L.qb[it] = *(const v2u*)(p + (4 * it + hsel) * 128 + 64 + 4 * sub); }
        L.ka = *(const v2u*)(p + 2048 + hsel * 128 + 4 * sub); L.kb = *(const v2u*)(p + 2048 + hsel * 128 + 64 + 4 * sub);
        L.vraw = *(const v4u*)(p + 2560 + lane * 8);
#pragma unroll
        for (int it = 0; it < 2; ++it) { L.ia[it] = *(const v2u*)(p + 3072 + (8 * it + hsel8) * 64 + 4 * sub8); L.ib[it] = *(const v2u*)(p + 3072 + (8 * it + hsel8) * 64 + 32 + 4 * sub8); }
        L.ka2 = (v2u){0u, 0u}; L.kb2 = (v2u){0u, 0u}; if (lane < 8) { L.ka2 = *(const v2u*)(p + 4096 + 4 * sub8); L.kb2 = *(const v2u*)(p + 4096 + 32 + 4 * sub8); }
        L.wv = 0.f; if (lane < 16) L.wv = bf2f(p[4160 + lane]);
        L.t0 = *(const f32x4*)(rt + 8 * sub); L.t1 = *(const f32x4*)(rt + 8 * sub + 4);
        L.u0 = *(const f32x4*)(rt + 128 + 8 * sub8); L.u1 = *(const f32x4*)(rt + 128 + 8 * sub8 + 4);
    };
    auto finish_row = [&](int row, const QkRow& L) __attribute__((always_inline)) {
        float* kout = row < RP ? a.out + OFF_KP + (size_t)row * 512 : a.out + OFF_KS + (size_t)(row - RP) * 512;
        float* vout = row < RP ? a.out + OFF_VP + (size_t)row * 512 : a.out + OFF_VS + (size_t)(row - RP) * 512;
        float* ikout = row < RP ? a.out + OFF_IKP + (size_t)row * 64 : a.out + OFF_IKS + (size_t)(row - RP) * 64;
        const v2u (&qa)[4] = L.qa; const v2u (&qb)[4] = L.qb; const v2u (&ia)[2] = L.ia; const v2u (&ib)[2] = L.ib;
        const v2u ka = L.ka, kb = L.kb, ka2 = L.ka2, kb2 = L.kb2; const v4u vraw = L.vraw; const float wv = L.wv; const f32x4 t0 = L.t0, t1 = L.t1, u0 = L.u0, u1 = L.u1;
        const float cs[4] = {t0[0], t0[2], t1[0], t1[2]}, sn[4] = {t0[1], t0[3], t1[1], t1[3]};
        const float cs8[4] = {u0[0], u0[2], u1[0], u1[2]}, sn8[4] = {u0[1], u0[3], u1[1], u1[3]};
#pragma unroll
        for (int it = 0; it < 4; ++it) {
            const float x1[4] = {bflo(qa[it].x), bfhi(qa[it].x), bflo(qa[it].y), bfhi(qa[it].y)}, x2[4] = {bflo(qb[it].x), bfhi(qb[it].x), bflo(qb[it].y), bfhi(qb[it].y)};
            float ss = 0.f;
#pragma unroll
            for (int e = 0; e < 4; ++e) ss += x1[e] * x1[e] + x2[e] * x2[e];
            ss += __shfl_xor(ss, 1); ss += __shfl_xor(ss, 2); ss += __shfl_xor(ss, 4); ss += __shfl_xor(ss, 8);
            const float rs = QSCALE / sqrtf(ss * (1.0f / 128.0f) + EPS);
            float o1[4], o2[4];
#pragma unroll
            for (int e = 0; e < 4; ++e) { const float y1 = x1[e] * rs * qga[e], y2 = x2[e] * rs * qgb[e]; o1[e] = y1 * cs[e] - y2 * sn[e]; o2[e] = y2 * cs[e] + y1 * sn[e]; }
            bf16* qd = Q + (size_t)row * 2048 + (4 * it + hsel) * 128 + 4 * sub;
            *(v2u*)qd = (v2u){pk2(o1[0], o1[1]), pk2(o1[2], o1[3])}; *(v2u*)(qd + 64) = (v2u){pk2(o2[0], o2[1]), pk2(o2[2], o2[3])};
        }
        { const float x1[4] = {bflo(ka.x), bfhi(ka.x), bflo(ka.y), bfhi(ka.y)}, x2[4] = {bflo(kb.x), bfhi(kb.x), bflo(kb.y), bfhi(kb.y)};
          float ss = 0.f;
#pragma unroll
          for (int e = 0; e < 4; ++e) ss += x1[e] * x1[e] + x2[e] * x2[e];
          ss += __shfl_xor(ss, 1); ss += __shfl_xor(ss, 2); ss += __shfl_xor(ss, 4); ss += __shfl_xor(ss, 8);
          const float rs = 1.0f / sqrtf(ss * (1.0f / 128.0f) + EPS);
          f32x4 o1, o2;
#pragma unroll
          for (int e = 0; e < 4; ++e) { const float y1 = x1[e] * rs * kga[e], y2 = x2[e] * rs * kgb[e]; o1[e] = y1 * cs[e] - y2 * sn[e]; o2[e] = y2 * cs[e] + y1 * sn[e]; }
          bf16* kd = KB + (size_t)row * 512 + hsel * 128 + 4 * sub;
          *(v2u*)kd = (v2u){pk2(o1[0], o1[1]), pk2(o1[2], o1[3])}; *(v2u*)(kd + 64) = (v2u){pk2(o2[0], o2[1]), pk2(o2[2], o2[3])};
          *(f32x4*)(kout + hsel * 128 + 4 * sub) = o1; *(f32x4*)(kout + hsel * 128 + 64 + 4 * sub) = o2; }
        { *(v4u*)(VB + (size_t)row * 512 + lane * 8) = vraw; float x[8]; up8(vraw, x);
          *(f32x4*)(vout + lane * 8) = (f32x4){x[0], x[1], x[2], x[3]}; *(f32x4*)(vout + lane * 8 + 4) = (f32x4){x[4], x[5], x[6], x[7]}; }
#pragma unroll
        for (int it = 0; it < 2; ++it) {
            const float x1[4] = {bflo(ia[it].x), bfhi(ia[it].x), bflo(ia[it].y), bfhi(ia[it].y)}, x2[4] = {bflo(ib[it].x), bfhi(ib[it].x), bflo(ib[it].y), bfhi(ib[it].y)};
            float o1[4], o2[4];
#pragma unroll
            for (int e = 0; e < 4; ++e) { o1[e] = x1[e] * cs8[e] - x2[e] * sn8[e]; o2[e] = x2[e] * cs8[e] + x1[e] * sn8[e]; }
            bf16* qd = IQ + (size_t)row * 1024 + (8 * it + hsel8) * 64 + 4 * sub8;
            *(v2u*)qd = (v2u){pk2(o1[0], o1[1]), pk2(o1[2], o1[3])}; *(v2u*)(qd + 32) = (v2u){pk2(o2[0], o2[1]), pk2(o2[2], o2[3])};
        }
        if (lane < 8) {
            const float x1[4] = {bflo(ka2.x), bfhi(ka2.x), bflo(ka2.y), bfhi(ka2.y)}, x2[4] = {bflo(kb2.x), bfhi(kb2.x), bflo(kb2.y), bfhi(kb2.y)};
            f32x4 o1, o2;
#pragma unroll
            for (int e = 0; e < 4; ++e) { o1[e] = x1[e] * cs8[e] - x2[e] * sn8[e]; o2[e] = x2[e] * cs8[e] + x1[e] * sn8[e]; }
            bf16* kd = IK + (size_t)row * 64 + 4 * sub8;
            *(v2u*)kd = (v2u){pk2(o1[0], o1[1]), pk2(o1[2], o1[3])}; *(v2u*)(kd + 32) = (v2u){pk2(o2[0], o2[1]), pk2(o2[2], o2[3])};
            *(f32x4*)(ikout + 4 * sub8) = o1; *(f32x4*)(ikout + 32 + 4 * sub8) = o2;
        }
        if (lane < 16) IW[(size_t)row * 16 + lane] = wv * 0.03125f;
    };
    { QkRow A, B;
      if (gw < R) load_row(gw, A);
      for (int row = gw; row < R; row += 2 * NGW) { const int r1 = row + NGW, r2 = row + 2 * NGW;
          if (r1 < R) load_row(r1, B);
          __builtin_amdgcn_sched_barrier(0);
          finish_row(row, A);
          if (r1 < R) { if (r2 < R) load_row(r2, A);
              __builtin_amdgcn_sched_barrier(0);
              finish_row(r1, B); } } }
}
DI int wq_next(gu32* head, volatile LAS int* slot, int tid) {
    __syncthreads();
    if (tid == 0) *slot = (int)__hip_atomic_fetch_add(head, 1u, RLX_AGENT);
    __syncthreads();
    return __builtin_amdgcn_readfirstlane(*slot);
}
DI void idx_prompt_unit(const Args& a, const Ctx& C, int b, int qb, int st_lo, int st_hi) {
    unsigned char* ws = a.ws;
    const bf16* IQ = (const bf16*)(ws + WS_IQ); const bf16* IK = (const bf16*)(ws + WS_IK); const float* IW = (const float*)(ws + WS_IW); float* SC = (float*)(ws + WS_SC);
    LAS unsigned char* iql = C.lds;
    { const bf16* src = IQ + (size_t)(b * 2048 + qb * 64) * 1024;
#pragma unroll 4
      for (int i = 0; i < 16; ++i) { const int id = C.tid + 512 * i, row = id >> 7, ch = id & 127; *(LAS v4u*)(iql + row * 2064 + ch * 16) = *(const v4u*)(src + (size_t)row * 1024 + ch * 8); } }
    __syncthreads();
    const int qg = C.wave & 1, kg = C.wave >> 1, r = C.lane & 31, hh = C.lane >> 5;
    const int qrow = b * 2048 + qb * 64 + qg * 32 + r;
    const float* wrow = IW + (size_t)qrow * 16;
    for (int st = st_lo; st < st_hi; ++st) {
        const int s0 = st * 256 + kg * 64;
        if (s0 <= qb * 64 + 63) {
            bf16x8 ka[2][4];
#pragma unroll
            for (int sb = 0; sb < 2; ++sb)
#pragma unroll
                for (int kk = 0; kk < 4; ++kk) ka[sb][kk] = *(const bf16x8*)(IK + (size_t)(b * 2048 + s0 + sb * 32 + r) * 64 + kk * 16 + hh * 8);
            f32x16 acc0, acc1;
#pragma unroll
            for (int e = 0; e < 16; ++e) { acc0[e] = 0.f; acc1[e] = 0.f; }
#pragma unroll 1
            for (int h = 0; h < 16; h += 2) {
                const float wh0 = wrow[h], wh1 = wrow[h + 1];
                bf16x8 qf0[4], qf1[4];
#pragma unroll
                for (int kk = 0; kk < 4; ++kk) { qf0[kk] = *(const LAS bf16x8*)(iql + (qg * 32 + r) * 2064 + h * 128 + kk * 32 + hh * 16); qf1[kk] = *(const LAS bf16x8*)(iql + (qg * 32 + r) * 2064 + (h + 1) * 128 + kk * 32 + hh * 16); }
                f32x16 c0, c1, d0, d1;
#pragma unroll
                for (int e = 0; e < 16; ++e) { c0[e] = 0.f; c1[e] = 0.f; d0[e] = 0.f; d1[e] = 0.f; }
#pragma unroll
                for (int kk = 0; kk < 4; ++kk) { c0 = MFMA32(ka[0][kk], qf0[kk], c0); c1 = MFMA32(ka[1][kk], qf0[kk], c1); }
#pragma unroll
                for (int kk = 0; kk < 4; ++kk) { d0 = MFMA32(ka[0][kk], qf1[kk], d0); d1 = MFMA32(ka[1][kk], qf1[kk], d1); }
#pragma unroll
                for (int e = 0; e < 16; ++e) { acc0[e] += wh0 * fmaxf(c0[e], 0.f); acc1[e] += wh0 * fmaxf(c1[e], 0.f); }
#pragma unroll
                for (int e = 0; e < 16; ++e) { acc0[e] += wh1 * fmaxf(d0[e], 0.f); acc1[e] += wh1 * fmaxf(d1[e], 0.f); }
            }
            float* dst = SC + (size_t)qrow * 2048 + s0 + 4 * hh;
#pragma unroll
            for (int rg = 0; rg < 4; ++rg) { *(f32x4*)(dst + 8 * rg) = (f32x4){acc0[4 * rg], acc0[4 * rg + 1], acc0[4 * rg + 2], acc0[4 * rg + 3]};
                                             *(f32x4*)(dst + 32 + 8 * rg) = (f32x4){acc1[4 * rg], acc1[4 * rg + 1], acc1[4 * rg + 2], acc1[4 * rg + 3]}; }
        }
    }
}
DI void idx_sample_unit(const Args& a, const Ctx& C, int b) {
    unsigned char* ws = a.ws;
    const bf16* IQ = (const bf16*)(ws + WS_IQ); const bf16* IK = (const bf16*)(ws + WS_IK); const float* IW = (const float*)(ws + WS_IW); float* SCS = (float*)(ws + WS_SCS);
    const float* cik = a.in[4]; const int* pt = (const int*)a.in[6] + b * 16;
    const int r = C.lane & 31, hh = C.lane >> 5;
    bf16x8 qa[4][4];
#pragma unroll
    for (int blk = 0; blk < 4; ++blk)
#pragma unroll
        for (int kk = 0; kk < 4; ++kk) qa[blk][kk] = *(const bf16x8*)(IQ + (size_t)(RP + 8 * b + 2 * blk + (r >> 4)) * 1024 + (r & 15) * 64 + kk * 16 + hh * 8);
    for (int kb = C.wave; kb < 65; kb += 8) {
        bf16x8 kf[4];
        if (kb < 64) { const int s = 32 * kb + r; const float* kp = cik + ((size_t)pt[s >> 7] * 128 + (s & 127)) * 64 + hh * 8;
#pragma unroll
            for (int kk = 0; kk < 4; ++kk) { const f32x4 x0 = *(const f32x4*)(kp + kk * 16), x1 = *(const f32x4*)(kp + kk * 16 + 4); v4u o; o.x = pk2(x0[0], x0[1]); o.y = pk2(x0[2], x0[3]); o.z = pk2(x1[0], x1[1]); o.w = pk2(x1[2], x1[3]); kf[kk] = __builtin_bit_cast(bf16x8, o); } }
        else {
#pragma unroll
            for (int kk = 0; kk < 4; ++kk) { v4u o = {0u, 0u, 0u, 0u}; if (r < 8) o = *(const v4u*)(IK + (size_t)(RP + 8 * b + r) * 64 + kk * 16 + hh * 8); kf[kk] = __builtin_bit_cast(bf16x8, o); } }
#pragma unroll
        for (int blk = 0; blk < 4; ++blk) {
            f32x16 c;
#pragma unroll
            for (int e = 0; e < 16; ++e) c[e] = 0.f;
#pragma unroll
            for (int kk = 0; kk < 4; ++kk) c = MFMA32(qa[blk][kk], kf[kk], c);
            float p0 = 0.f, p1 = 0.f;
            const float* w0p = IW + (size_t)(RP + 8 * b + 2 * blk) * 16 + 4 * hh; const float* w1p = w0p + 16;
            const f32x4 w00 = *(const f32x4*)w0p, w01 = *(const f32x4*)(w0p + 8), w10 = *(const f32x4*)w1p, w11 = *(const f32x4*)(w1p + 8);
#pragma unroll
            for (int j = 0; j < 4; ++j) { p0 += w00[j] * fmaxf(c[j], 0.f) + w01[j] * fmaxf(c[4 + j], 0.f); p1 += w10[j] * fmaxf(c[8 + j], 0.f) + w11[j] * fmaxf(c[12 + j], 0.f); }
            p0 += __shfl_xor(p0, 32); p1 += __shfl_xor(p1, 32);
            SCS[(size_t)(8 * b + 2 * blk + hh) * 2112 + 32 * kb + r] = hh ? p1 : p0;
        }
    }
}
DI void ph_index(const Args& a, const Ctx& C) {
    gu32* head = (gu32*)a.ws + CW_WQ; volatile LAS int* slot = (volatile LAS int*)(C.lds + MISC_OFF + 64);
    for (;;) {
        const int u = wq_next(head, slot, C.tid);
        if (u >= 128 + 640) break;
        if (u < 128) idx_sample_unit(a, C, u);
        else {
            const int v = u - 128, b = v & 7, k = v >> 3; int qb, c;
            if (k < 32) { qb = 31 - (k >> 2); c = k & 3; } else if (k < 56) { const int k2 = k - 32; qb = 23 - k2 / 3; c = k2 % 3; }
            else if (k < 72) { const int k3 = k - 56; qb = 15 - (k3 >> 1); c = k3 & 1; } else { qb = 79 - k; c = 0; }
            const int nsteps = (qb * 64 + 64 + 255) >> 8, lo = 2 * c, hi = lo + 2 < nsteps ? lo + 2 : nsteps;
            idx_prompt_unit(a, C, b, qb, lo, hi); }
    }
}
DI unsigned ordkey(float f) { const unsigned b = __float_as_uint(f); return (b & 0x80000000u) ? ~b : (b | 0x80000000u); }
template <int NS> DI void load_row(const float* sc, float (&f)[NS], int lane) {
#pragma unroll
    for (int j = 0; j < NS; ++j) f[j] = sc[64 * j + lane];
}
template <int NS> DI void select_row(const float (&f)[NS], int n_adm, unsigned long long* mrow, int lane, LAS unsigned* hist) {
    unsigned T = 1u;
    if (n_adm > 256) {
        float lo = 3.0e38f, hi = -3.0e38f;
#pragma unroll
        for (int j = 0; j < NS; ++j) { const bool v = 64 * j + lane < n_adm; lo = v ? fminf(lo, f[j]) : lo; hi = v ? fmaxf(hi, f[j]) : hi; }
#pragma unroll
        for (int o = 1; o < 64; o <<= 1) { lo = fminf(lo, __shfl_xor(lo, o)); hi = fmaxf(hi, __shfl_xor(hi, o)); }
        if (hi > lo) {
            const float scale = 1023.5f / (hi - lo);
#pragma unroll
            for (int q = 0; q < 4; ++q) *(LAS v4u*)(hist + 16 * lane + 4 * q) = (v4u){0u, 0u, 0u, 0u};
            if (lane == 0) hist[1024] = 0u;
            asm volatile("s_waitcnt lgkmcnt(0)" ::: "memory");
#pragma unroll
            for (int j = 0; j < NS; ++j) if (64 * j + lane < n_adm) { int bn = (int)((f[j] - lo) * scale); bn = bn > 1023 ? 1023 : bn; __hip_atomic_fetch_add(hist + bn, 1u, __ATOMIC_RELAXED, __HIP_MEMORY_SCOPE_WAVEFRONT); }
            asm volatile("s_waitcnt lgkmcnt(0)" ::: "memory");
            unsigned c[16];
#pragma unroll
            for (int q = 0; q < 4; ++q) { const v4u t = *(const LAS v4u*)(hist + 16 * lane + 4 * q); c[4 * q] = t.x; c[4 * q + 1] = t.y; c[4 * q + 2] = t.z; c[4 * q + 3] = t.w; }
            unsigned s = 0;
#pragma unroll
            for (int q = 0; q < 16; ++q) s += c[q];
            unsigned t = s;
#pragma unroll
            for (int o = 1; o < 64; o <<= 1) { const unsigned v = (unsigned)__shfl_down((int)t, o); t += (lane + o < 64) ? v : 0u; }
            const unsigned excl = t - s;
            int B = 0; unsigned above = 0;
            { unsigned run = excl; bool found = false;
#pragma unroll
              for (int q = 15; q >= 0; --q) { const unsigned nr = run + c[q]; if (!found && nr >= 256u) { found = true; B = 16 * lane + q; above = run; } run = nr; } }
            const unsigned long long own = __ballot(excl < 256u && t >= 256u);
            const int src = (int)__ffsll((long long)own) - 1;
            B = __builtin_amdgcn_readlane(B, src); above = (unsigned)__builtin_amdgcn_readlane((int)above, src);
            const unsigned need = 256u - above;
#pragma unroll
            for (int j = 0; j < NS; ++j) if (64 * j + lane < n_adm) { int bn = (int)((f[j] - lo) * scale); bn = bn > 1023 ? 1023 : bn;
                if (bn == B) { const unsigned idx = __hip_atomic_fetch_add(hist + 1024, 1u, __ATOMIC_RELAXED, __HIP_MEMORY_SCOPE_WAVEFRONT); if (idx < 64u) hist[1025 + idx] = ordkey(f[j]); } }
            asm volatile("s_waitcnt lgkmcnt(0)" ::: "memory");
            const unsigned nc = (unsigned)__builtin_amdgcn_readfirstlane((int)hist[1024]);
            bool done = false;
            if (nc <= 64u && need <= nc) {
                const unsigned ci = lane < (int)nc ? hist[1025 + lane] : 0u; unsigned gt = 0, ge = 0;
                for (unsigned k = 0; k < nc; ++k) { const unsigned ck = (unsigned)__builtin_amdgcn_readlane((int)ci, (int)k); gt += ck > ci ? 1u : 0u; ge += ck >= ci ? 1u : 0u; }
                const unsigned long long hit = __ballot(lane < (int)nc && gt < need && need <= ge);
                if (hit != 0ull) { T = (unsigned)__builtin_amdgcn_readlane((int)ci, (int)__ffsll((long long)hit) - 1); done = true; }
            }
            if (!done) {
                T = 0u;
#pragma unroll 1
                for (int bit = 31; bit >= 0; --bit) { const unsigned cand = T | (1u << bit); int cnt = 0;
#pragma unroll
                    for (int j = 0; j < NS; ++j) cnt += __popcll(__ballot(64 * j + lane < n_adm && ordkey(f[j]) >= cand));
                    if (cnt >= 256) T = cand;
                    if (cnt == 256) break; }
            }
        }
    }
    unsigned long long mine = 0ull;
#pragma unroll
    for (int j = 0; j < NS; ++j) { const unsigned long long bm = __ballot(64 * j + lane < n_adm && ordkey(f[j]) >= T); if (lane == j) mine = bm; }
    if (lane < 34) mrow[lane] = lane < NS ? mine : 0ull;
}
DI void ph_select(const Args& a, const Ctx& C) {
    unsigned char* ws = a.ws;
    const float* SC = (const float*)(ws + WS_SC); const float* SCS = (const float*)(ws + WS_SCS); unsigned long long* MASK = (unsigned long long*)(ws + WS_MASK);
    const int gw = C.bx * NWAVES + C.wave, NGW = C.G * NWAVES;
    LAS unsigned* hist = (LAS unsigned*)(C.lds + C.wave * 5120);
    if (gw < RP) {
        float fa[32], fb[32];
        load_row<32>(SC + (size_t)gw * 2048, fa, C.lane);
        for (int row = gw; row < RP; row += 2 * NGW) {
            const int r1 = row + NGW, r2 = row + 2 * NGW;
            if (r1 < RP) load_row<32>(SC + (size_t)r1 * 2048, fb, C.lane);
            __builtin_amdgcn_sched_barrier(0);
            select_row<32>(fa, (row & 2047) + 1, MASK + (size_t)row * 34, C.lane, hist);
            if (r1 < RP) {
                if (r2 < RP) load_row<32>(SC + (size_t)r2 * 2048, fa, C.lane);
                __builtin_amdgcn_sched_barrier(0);
                select_row<32>(fb, (r1 & 2047) + 1, MASK + (size_t)r1 * 34, C.lane, hist);
            }
        }
    }
    for (int row = RP + gw; row < R; row += NGW) { float fs[33]; load_row<33>(SCS + (size_t)(row - RP) * 2112, fs, C.lane);
        select_row<33>(fs, 2049 + ((row - RP) & 7), MASK + (size_t)row * 34, C.lane, hist); }
}
constexpr float NEG_BIG = -1.0e30f;
DI bf16x8 pack_p(const f32x16& x, int sp) {
    v4u o; o.x = pk2(x[8 * sp + 0], x[8 * sp + 1]); o.y = pk2(x[8 * sp + 2], x[8 * sp + 3]); o.z = pk2(x[8 * sp + 4], x[8 * sp + 5]); o.w = pk2(x[8 * sp + 6], x[8 * sp + 7]);
    return __builtin_bit_cast(bf16x8, o);
}
DI void mask_init(f32x16& s0, f32x16& s1, unsigned long long wq) {
    const unsigned wlo = (unsigned)wq, whi = (unsigned)(wq >> 32);
    int one = 1; asm volatile("" : "+s"(one));
#pragma unroll
    for (int e = 0; e < 16; ++e) { const int sh = (e & 3) + 8 * (e >> 2);
        const int t0 = __builtin_amdgcn_sbfe((int)wlo, sh, one), t1 = __builtin_amdgcn_sbfe((int)whi, sh, one);
        s0[e] = __builtin_bit_cast(float, ~t0 & (int)0xf149f2ca); s1[e] = __builtin_bit_cast(float, ~t1 & (int)0xf149f2ca); }
}
constexpr float M_INIT = -5.0e29f;
DI void softmax_tile(f32x16& s0, f32x16& s1, float& m, float& l, f32x16 (&o)[4]) {
    float mx = fmaxf(s0[0], s1[0]);
#pragma unroll
    for (int e = 1; e < 16; ++e) mx = fmaxf(mx, fmaxf(s0[e], s1[e]));
    mx = fmaxf(mx, __shfl_xor(mx, 32));
    const float mn = fmaxf(m, mx);
    if (__ballot(mn > m) != 0ull) { const float alpha = fexp2(m - mn); l *= alpha;
#pragma unroll
        for (int db = 0; db < 4; ++db)
#pragma unroll
            for (int e = 0; e < 16; ++e) o[db][e] *= alpha; }
    m = mn;
    float ls = 0.f;
#pragma unroll
    for (int e = 0; e < 16; ++e) { s0[e] = fexp2(s0[e] - mn); s1[e] = fexp2(s1[e] - mn); ls += s0[e] + s1[e]; }
    l += ls;
}
constexpr int KT_BYTES = 64 * 272, VT_BYTES = 128 * 144;
DI void attn_prompt_unit(const Args& a, const Ctx& C, int b, int kvh, int qb) {
    unsigned char* ws = a.ws;
    const bf16* Q = (const bf16*)(ws + WS_Q); const bf16* KB = (const bf16*)(ws + WS_KB); const bf16* VB = (const bf16*)(ws + WS_VB);
    const unsigned long long* MASK = (const unsigned long long*)(ws + WS_MASK); bf16* O = (bf16*)(ws + WS_O);
    const int hg = C.wave & 3, qh = C.wave >> 2, r = C.lane & 31, hh = C.lane >> 5, head = 4 * kvh + hg;
    const int qrow = b * 2048 + qb * 64 + qh * 32 + r;
    bf16x8 qf[8];
#pragma unroll
    for (int kk = 0; kk < 8; ++kk) qf[kk] = *(const bf16x8*)(Q + (size_t)qrow * 2048 + head * 128 + kk * 16 + hh * 8);
    f32x16 o[4];
#pragma unroll
    for (int db = 0; db < 4; ++db)
#pragma unroll
        for (int e = 0; e < 16; ++e) o[db][e] = 0.f;
    float m = M_INIT, l = 0.f;
    const unsigned long long* mrow = MASK + (size_t)qrow * 34;
    LAS unsigned char* kbuf = C.lds; LAS unsigned char* vbuf = C.lds + 2 * KT_BYTES;
    const int krow0 = C.tid >> 4, kch = C.tid & 15;
    const unsigned char* kgu = (const unsigned char*)(KB + (size_t)(b * 2048) * 512 + kvh * 128); const unsigned char* vgu = (const unsigned char*)(VB + (size_t)(b * 2048) * 512 + kvh * 128);
    const unsigned klo = (unsigned)(krow0 * 1024 + kch * 16), vlo = (unsigned)(krow0 * 2048 + kch * 16);
    v4u kr[2], vr[2];
#define LOADK(kt) do { const unsigned char* kp_ = kgu + (size_t)(kt) * 65536; kr[0] = *(const v4u*)(kp_ + klo); kr[1] = *(const v4u*)(kp_ + 32768 + klo); } while (0)
#define LOADV(kt) do { const unsigned char* vp_ = vgu + (size_t)(kt) * 65536; vr[0] = *(const v4u*)(vp_ + vlo); vr[1] = *(const v4u*)(vp_ + vlo + 1024); } while (0)
#define WRITEK(buf) do { *(LAS v4u*)(kbuf + (buf) * KT_BYTES + krow0 * 272 + kch * 16) = kr[0]; *(LAS v4u*)(kbuf + (buf) * KT_BYTES + (32 + krow0) * 272 + kch * 16) = kr[1]; } while (0)
#define WRITEV(buf) do { \
        LAS unsigned char* vb_ = vbuf + (buf) * VT_BYTES + vwo; \
        const unsigned a_[4] = {vr[0].x, vr[0].y, vr[0].z, vr[0].w}, b_[4] = {vr[1].x, vr[1].y, vr[1].z, vr[1].w}; \
        _Pragma("unroll") for (int i_ = 0; i_ < 4; ++i_) { *(LAS unsigned*)(vb_ + (2 * i_) * 144) = (a_[i_] & 0xffffu) | (b_[i_] << 16); *(LAS unsigned*)(vb_ + (2 * i_ + 1) * 144) = (a_[i_] >> 16) | (b_[i_] & 0xffff0000u); } } while (0)
#define QK_TILE(buf) do { const LAS unsigned char* kb_ = kbuf + (buf) * KT_BYTES + r * 272 + hh * 16; bf16x8 ka_[4][2]; \
        _Pragma("unroll") for (int kk = 0; kk < 3; ++kk) { ka_[kk][0] = *(const LAS bf16x8*)(kb_ + kk * 32); ka_[kk][1] = *(const LAS bf16x8*)(kb_ + 32 * 272 + kk * 32); } \
        _Pragma("unroll") for (int kk = 0; kk < 8; ++kk) { \
            if (kk + 3 < 8) { ka_[(kk + 3) & 3][0] = *(const LAS bf16x8*)(kb_ + (kk + 3) * 32); ka_[(kk + 3) & 3][1] = *(const LAS bf16x8*)(kb_ + 32 * 272 + (kk + 3) * 32); } \
            s0 = MFMA32(ka_[kk & 3][0], qf[kk], s0); s1 = MFMA32(ka_[kk & 3][1], qf[kk], s1); \
            __builtin_amdgcn_sched_barrier(0); } } while (0)
#define PV_TILE(vsel) do { const LAS unsigned char* vb_ = vbuf + (vsel) * VT_BYTES + r * 144 + hh * 16; bf16x8 va_[2][4]; \
        _Pragma("unroll") for (int db = 0; db < 4; ++db) va_[0][db] = *(const LAS bf16x8*)(vb_ + db * 32 * 144 + 16 * (0 ^ (2 * db))); \
        _Pragma("unroll") for (int ps = 0; ps < 4; ++ps) { \
            if (ps < 3) { _Pragma("unroll") for (int db = 0; db < 4; ++db) va_[(ps + 1) & 1][db] = *(const LAS bf16x8*)(vb_ + db * 32 * 144 + 16 * ((2 * (ps + 1)) ^ (2 * db))); } \
            const bf16x8 pf = pack_p(ps < 2 ? s0 : s1, ps & 1); \
            _Pragma("unroll") for (int db = 0; db < 4; ++db) o[db] = MFMA32(va_[ps & 1][db], pf, o[db]); \
            __builtin_amdgcn_sched_barrier(0); } } while (0)
#define VNEXT(v) ((v) == 2 ? 0 : (v) + 1)
    const int vwo = (kch * 8) * 144 + 16 * ((2 * (krow0 >> 3) + ((krow0 >> 1) & 1)) ^ (2 * (kch >> 2))) + 8 * ((krow0 >> 2) & 1) + 4 * (krow0 & 1);
#ifndef ATT_STAGGER
#define ATT_STAGGER 1
#endif
    const bool late = ATT_STAGGER && __builtin_amdgcn_readfirstlane(C.wave) >= 4;
    LOADK(0); LOADV(0); WRITEK(0); WRITEV(0);
    unsigned long long wnext = mrow[0];
    __syncthreads();
    asm volatile("; q fragments ready" :: "v"(qf[0]), "v"(qf[1]), "v"(qf[2]), "v"(qf[3]), "v"(qf[4]), "v"(qf[5]), "v"(qf[6]), "v"(qf[7]), "v"(wnext));
    f32x16 s0, s1;
    if (!late) {
        int vsel = 0;
        for (int kt = 0; kt <= qb; ++kt) {
            const unsigned long long wq = wnext >> (4 * hh);
            const int vn = VNEXT(vsel);
            if (kt < qb) { LOADK(kt + 1); LOADV(kt + 1); wnext = mrow[kt + 1]; }
            __builtin_amdgcn_sched_barrier(0);
            mask_init(s0, s1, wq);
            QK_TILE(kt & 1);
            softmax_tile(s0, s1, m, l, o);
            PV_TILE(vsel);
            if (kt < qb) { WRITEK((kt + 1) & 1); WRITEV(vn); }
            vsel = vn;
            __syncthreads();
        }
    } else {
        { const unsigned long long wq = wnext >> (4 * hh);
          if (0 < qb) { LOADK(1); LOADV(1); wnext = mrow[1]; }
          __builtin_amdgcn_sched_barrier(0);
          mask_init(s0, s1, wq);
          QK_TILE(0);
          if (0 < qb) { WRITEK(1); WRITEV(1); }
          __syncthreads(); }
        int vsel = 0;
        for (int kt = 1; kt <= qb; ++kt) {
            const unsigned long long wq = wnext >> (4 * hh);
            const int vc = VNEXT(vsel), vn = VNEXT(vc);
            if (kt < qb) { LOADK(kt + 1); LOADV(kt + 1); wnext = mrow[kt + 1]; }
            __builtin_amdgcn_sched_barrier(0);
            softmax_tile(s0, s1, m, l, o);
            PV_TILE(vsel);
            mask_init(s0, s1, wq);
            QK_TILE(kt & 1);
            if (kt < qb) { WRITEK((kt + 1) & 1); WRITEV(vn); }
            vsel = vc;
            __syncthreads();
        }
        softmax_tile(s0, s1, m, l, o);
        PV_TILE(vsel);
    }
#undef LOADK
#undef LOADV
#undef WRITEK
#undef WRITEV
#undef QK_TILE
#undef PV_TILE
#undef VNEXT
    l += __shfl_xor(l, 32); const float inv = 1.0f / l;
#pragma unroll
    for (int db = 0; db < 4; ++db)
#pragma unroll
        for (int rg = 0; rg < 4; ++rg) { v2u w; w.x = pk2(o[db][4 * rg] * inv, o[db][4 * rg + 1] * inv); w.y = pk2(o[db][4 * rg + 2] * inv, o[db][4 * rg + 3] * inv);
            *(v2u*)(O + (size_t)qrow * 2048 + head * 128 + 32 * db + 8 * rg + 4 * hh) = w; }
}
DI bf16x8 cvt8(const f32x4& x0, const f32x4& x1) { v4u o; o.x = pk2(x0[0], x0[1]); o.y = pk2(x0[2], x0[3]); o.z = pk2(x1[0], x1[1]); o.w = pk2(x1[2], x1[3]); return __builtin_bit_cast(bf16x8, o); }
DI void attn_sample_unit(const Args& a, const Ctx& C, int b, int kvh) {
    unsigned char* ws = a.ws;
    const bf16* Q = (const bf16*)(ws + WS_Q); const bf16* KB = (const bf16*)(ws + WS_KB); const bf16* VB = (const bf16*)(ws + WS_VB);
    const unsigned long long* MASK = (const unsigned long long*)(ws + WS_MASK); bf16* O = (bf16*)(ws + WS_O);
    const float* ck = a.in[2]; const float* cv = a.in[3]; const int* pt = (const int*)a.in[6] + b * 16;
    const int r = C.lane & 31, hh = C.lane >> 5, t = r & 7, head = 4 * kvh + (r >> 3), qrow = RP + 8 * b + t;
    const bf16* qp = Q + (size_t)qrow * 2048 + head * 128 + hh * 8;
    f32x16 o[4];
#pragma unroll
    for (int db = 0; db < 4; ++db)
#pragma unroll
        for (int e = 0; e < 16; ++e) o[db][e] = 0.f;
    float m = M_INIT, l = 0.f;
    const unsigned long long* mrow = MASK + (size_t)qrow * 34;
    const unsigned kvo = (unsigned)((r * 4 + kvh) * 128 + hh * 8);
    const unsigned vvo = (unsigned)((4 * hh * 4 + kvh) * 128 + r);
    f32x4 buf[2][8];
#define SA_ROWBASE(i) ((unsigned)__builtin_amdgcn_readfirstlane(pt[(C.wave + 8 * (i)) >> 1] * 128 + ((C.wave + 8 * (i)) & 1) * 64))
#define SA_LOADK(P, rb, g, um) do { const float* k0_ = ck + (size_t)(rb) * 512 + kvo + (g) * 32; const float* k1_ = k0_ + 32 * 512; const f32x4 z_ = {0.f, 0.f, 0.f, 0.f}; \
        buf[P][0] = z_; buf[P][1] = z_; buf[P][4] = z_; buf[P][5] = z_; buf[P][2] = z_; buf[P][3] = z_; buf[P][6] = z_; buf[P][7] = z_; \
        if (((um) >> r) & 1ull) { buf[P][0] = *(const f32x4*)(k0_); buf[P][1] = *(const f32x4*)(k0_ + 4); buf[P][4] = *(const f32x4*)(k0_ + 16); buf[P][5] = *(const f32x4*)(k0_ + 20); } \
        if (((um) >> (32 + r)) & 1ull) { buf[P][2] = *(const f32x4*)(k1_); buf[P][3] = *(const f32x4*)(k1_ + 4); buf[P][6] = *(const f32x4*)(k1_ + 16); buf[P][7] = *(const f32x4*)(k1_ + 20); } \
        } while (0)
#define SA_LOADV(P, rb, g, um) do { const float* v0_ = cv + (size_t)((rb) + 16 * (g)) * 512 + vvo; const unsigned vb_ = (unsigned)((um) >> (16 * (g) + 4 * hh)); \
        _Pragma("unroll") for (int j_ = 0; j_ < 8; ++j_) { const bool on_ = (vb_ >> (8 * (j_ >> 2) + (j_ & 3))) & 1u; \
            _Pragma("unroll") for (int db_ = 0; db_ < 4; ++db_) buf[P][2 * db_ + (j_ >> 2)][j_ & 3] = on_ ? v0_[(8 * (j_ >> 2) + (j_ & 3)) * 512 + 32 * db_] : 0.f; } } while (0)
#define SA_QK(P, g) do { const bf16x8 q0_ = *(const bf16x8*)(qp + (g) * 32), q1_ = *(const bf16x8*)(qp + (g) * 32 + 16); \
        s0 = MFMA32(cvt8(buf[P][0], buf[P][1]), q0_, s0); s1 = MFMA32(cvt8(buf[P][2], buf[P][3]), q0_, s1); \
        s0 = MFMA32(cvt8(buf[P][4], buf[P][5]), q1_, s0); s1 = MFMA32(cvt8(buf[P][6], buf[P][7]), q1_, s1); } while (0)
#define SA_PV(P, pf) do { _Pragma("unroll") for (int db_ = 0; db_ < 4; ++db_) o[db_] = MFMA32(cvt8(buf[P][2 * db_], buf[P][2 * db_ + 1]), pf, o[db_]); } while (0)
#define SA_SB() __builtin_amdgcn_sched_barrier(0)
#define SA_UNION(w) ({ unsigned long long u_ = (w); u_ |= __shfl_xor(u_, 1); u_ |= __shfl_xor(u_, 2); u_ |= __shfl_xor(u_, 4); u_; })
    unsigned rb = SA_ROWBASE(0);
    unsigned long long wcur = mrow[C.wave], um = SA_UNION(wcur);
    SA_LOADK(0, rb, 0, um); SA_SB();
#pragma unroll 1
    for (int i = 0; i < 4; ++i) {
        const unsigned rbn = SA_ROWBASE(i < 3 ? i + 1 : 3);
        const unsigned long long wq = wcur >> (4 * hh), wnx = mrow[C.wave + 8 * (i < 3 ? i + 1 : 3)];
        f32x16 s0, s1; mask_init(s0, s1, wq);
        SA_LOADK(1, rb, 1, um); SA_SB(); SA_QK(0, 0); SA_SB();
        SA_LOADK(0, rb, 2, um); SA_SB(); SA_QK(1, 1); SA_SB();
        SA_LOADK(1, rb, 3, um); SA_SB(); SA_QK(0, 2); SA_SB();
        SA_LOADV(0, rb, 0, um); SA_SB(); SA_QK(1, 3); SA_SB();
        softmax_tile(s0, s1, m, l, o);
        SA_LOADV(1, rb, 1, um); SA_SB(); { const bf16x8 pf = pack_p(s0, 0); SA_PV(0, pf); } SA_SB();
        SA_LOADV(0, rb, 2, um); SA_SB(); { const bf16x8 pf = pack_p(s0, 1); SA_PV(1, pf); } SA_SB();
        SA_LOADV(1, rb, 3, um); SA_SB(); { const bf16x8 pf = pack_p(s1, 0); SA_PV(0, pf); } SA_SB();
        const unsigned long long umn = SA_UNION(wnx);
        if (i < 3) SA_LOADK(0, rbn, 0, umn); SA_SB();
        { const bf16x8 pf = pack_p(s1, 1); SA_PV(1, pf); } SA_SB();
        rb = rbn; wcur = wnx; um = umn;
    }
#undef SA_UNION
#undef SA_ROWBASE
#undef SA_LOADK
#undef SA_LOADV
#undef SA_QK
#undef SA_PV
#undef SA_SB
    if (C.wave == 0) {
        const unsigned long long wq = mrow[32] >> (4 * hh);
        f32x16 s0, s1; mask_init(s0, s1, wq);
#pragma unroll
        for (int kk = 0; kk < 8; ++kk) { v4u kv = {0u, 0u, 0u, 0u}; if (r < 8) kv = *(const v4u*)(KB + (size_t)(RP + 8 * b + r) * 512 + kvh * 128 + kk * 16 + hh * 8);
            s0 = MFMA32(__builtin_bit_cast(bf16x8, kv), *(const bf16x8*)(qp + kk * 16), s0); }
        softmax_tile(s0, s1, m, l, o);
        const bf16x8 pf = pack_p(s0, 0);
#pragma unroll
        for (int db = 0; db < 4; ++db) { const bf16* vp = VB + (size_t)(RP + 8 * b + 4 * hh) * 512 + kvh * 128 + 32 * db + r;
            v4u av; av.x = (unsigned)vp[0] | ((unsigned)vp[512] << 16); av.y = (unsigned)vp[1024] | ((unsigned)vp[1536] << 16); av.z = 0u; av.w = 0u;
            o[db] = MFMA32(__builtin_bit_cast(bf16x8, av), pf, o[db]); }
    }
    l += __shfl_xor(l, 32);
    LAS float* ml = (LAS float*)C.lds;
    LAS float* ob = (LAS float*)(C.lds + 4096);
    if (hh == 0) { ml[(C.wave * 32 + r) * 2] = m; ml[(C.wave * 32 + r) * 2 + 1] = l; }
    __syncthreads();
    float M = M_INIT;
#pragma unroll
    for (int w = 0; w < 8; ++w) M = fmaxf(M, ml[(w * 32 + r) * 2]);
    float L = 0.f;
#pragma unroll
    for (int w = 0; w < 8; ++w) L += ml[(w * 32 + r) * 2 + 1] * fexp2(ml[(w * 32 + r) * 2] - M);
    { const float sc = fexp2(m - M);
#pragma unroll
      for (int db = 0; db < 4; ++db)
#pragma unroll
          for (int e = 0; e < 16; ++e) o[db][e] *= sc; }
#define OB_WRITE(slot) do { _Pragma("unroll") for (int db = 0; db < 4; ++db) _Pragma("unroll") for (int e = 0; e < 16; ++e) ob[(((slot) * 64 + db * 16 + e) << 6) + C.lane] = o[db][e]; } while (0)
#define OB_ADD(slot) do { _Pragma("unroll") for (int db = 0; db < 4; ++db) _Pragma("unroll") for (int e = 0; e < 16; ++e) o[db][e] += ob[(((slot) * 64 + db * 16 + e) << 6) + C.lane]; } while (0)
    if (C.wave >= 4) OB_WRITE(C.wave - 4);
    __syncthreads();
    if (C.wave < 4) OB_ADD(C.wave);
    __syncthreads();
    if (C.wave == 2 || C.wave == 3) OB_WRITE(C.wave - 2);
    __syncthreads();
    if (C.wave < 2) OB_ADD(C.wave);
    __syncthreads();
    if (C.wave == 1) OB_WRITE(0);
    __syncthreads();
    if (C.wave == 0) { OB_ADD(0); const float inv = 1.0f / L;
#pragma unroll
        for (int db = 0; db < 4; ++db)
#pragma unroll
            for (int rg = 0; rg < 4; ++rg) { v2u w; w.x = pk2(o[db][4 * rg] * inv, o[db][4 * rg + 1] * inv); w.y = pk2(o[db][4 * rg + 2] * inv, o[db][4 * rg + 3] * inv);
                *(v2u*)(O + (size_t)qrow * 2048 + head * 128 + 32 * db + 8 * rg + 4 * hh) = w; } }
#undef OB_WRITE
#undef OB_ADD
}
DI void ph_attn(const Args& a, const Ctx& C) {
    volatile LAS int* slot = (volatile LAS int*)(C.lds + MISC_OFF + 64);
    { gu32* head = (gu32*)a.ws + CW_WQ + 64;
      for (;;) { const int u = wq_next(head, slot, C.tid); if (u >= 512) break; attn_sample_unit(a, C, u >> 2, u & 3); } }
#if defined(DBG_MIDSTAMP)
    if (C.bx == 0 && C.tid == 0) ((volatile LAS unsigned long long*)(C.lds + MISC_OFF + 128))[17] = wall_clock64();
#endif
    { gu32* head = (gu32*)a.ws + CW_WQ + 128;
      for (;;) { const int v = wq_next(head, slot, C.tid); if (v >= 1024) break; attn_prompt_unit(a, C, (v & 31) >> 2, v & 3, 31 - (v >> 5)); } }
}
template <int S> DI f32x4 slab_sum(const float* slab_, int row, int N, int col) { v2u v[S];
    const unsigned short* slab = (const unsigned short*)slab_;
#pragma unroll
    for (int s = 0; s < S; ++s) v[s] = *(const v2u*)(slab + ((size_t)s * 1024 + row) * N + col);
    f32x4 a = {0.f, 0.f, 0.f, 0.f};
#pragma unroll
    for (int s = 0; s < S; ++s) { a[0] += __uint_as_float(v[s].x << 16); a[1] += __uint_as_float(v[s].x & 0xffff0000u); a[2] += __uint_as_float(v[s].y << 16); a[3] += __uint_as_float(v[s].y & 0xffff0000u); }
    return a; }
DI float grp16_sum(float q) { q += __shfl_xor(q, 1); q += __shfl_xor(q, 2); q += __shfl_xor(q, 4); q += __shfl_xor(q, 8); return q; }
template <int S> DI void ph_reduce_resid(const Args& a, const Ctx& C, const float* base, float* out) {
    unsigned char* ws = a.ws; const float* slab = (const float*)(ws + WS_SLAB); bf16* XB = (bf16*)(ws + WS_XB) + (size_t)RP * 2048; float* SS = (float*)(ws + WS_SS) + (size_t)RP * 32;
    const int gw = C.bx * NWAVES + C.wave, NGW = C.G * NWAVES, lane = C.lane;
    float* RSTD = (float*)(ws + WS_RSTD);
    for (int row = gw; row < RS; row += NGW) { float tot = 0.f;
#pragma unroll
        for (int j = 0; j < 8; ++j) { const int col = 4 * lane + 256 * j; const f32x4 o = slab_sum<S>(slab, row, 2048, col) + *(const f32x4*)(base + (size_t)row * 2048 + col);
            *(f32x4*)(out + (size_t)row * 2048 + col) = o; *(v2u*)(XB + (size_t)row * 2048 + col) = (v2u){pk2(o[0], o[1]), pk2(o[2], o[3])};
            tot += (o[0] * o[0] + o[1] * o[1]) + (o[2] * o[2] + o[3] * o[3]); }
        tot = wave_sum(tot); if (lane == 0) RSTD[RP + row] = 1.0f / sqrtf(tot * (1.0f / 2048.0f) + EPS);
    }
    const float* SSP = (const float*)(ws + WS_SS);
    for (int row = C.bx * 512 + C.tid; row < RP; row += C.G * 512) RSTD[row] = rstd32(SSP + (size_t)row * 32);
}
template <int S> DI void ph_reduce_a1(const Args& a, const Ctx& C) {
    unsigned char* ws = a.ws; const float* slab = (const float*)(ws + WS_SLAB); const float* SS = (const float*)(ws + WS_SS);
    bf16* U = (bf16*)(ws + WS_U); bf16* V = (bf16*)(ws + WS_V); float* VSS = (float*)(ws + WS_VSS);
    const int gw = C.bx * NWAVES + C.wave, NGW = C.G * NWAVES, lane = C.lane;
    for (int row = gw; row < RS; row += NGW) { const float rs = ((const float*)(ws + WS_RSTD))[RP + row];
#pragma unroll
        for (int j = 0; j < 16; ++j) { const int col = 4 * lane + 256 * j; f32x4 z = slab_sum<S>(slab, row, 4096, col) * rs;
#pragma unroll
            for (int e = 0; e < 4; ++e) z[e] = pg8::gelu_tanh(z[e]);
            const v2u w = {pk2(z[0], z[1]), pk2(z[2], z[3])};
            if (j < 8) *(v2u*)(U + (size_t)(RP + row) * 2048 + col) = w;
            else { *(v2u*)(V + (size_t)(RP + row) * 2048 + col - 2048) = w; const float q = grp16_sum((z[0] * z[0] + z[1] * z[1]) + (z[2] * z[2] + z[3] * z[3])); if ((lane & 15) == 0) VSS[(size_t)(RP + row) * 32 + 4 * (j - 8) + (lane >> 4)] = q; } }
    }
}
#define SELFCHK_HOOK(a,b,c,d) do {} while (0)
#ifndef MK_ONE_LAUNCH
#define MK_ONE_LAUNCH 1
#endif
constexpr int N_PHASES = 16;
#ifndef DBG_NPH
#define DBG_NPH 16
#endif
__global__ void __launch_bounds__(NWAVES * 64, 2) fwd_kernel(Args args) {
    extern __shared__ __attribute__((aligned(16))) unsigned char lds_raw[];
    Ctx C; C.lds = (LAS unsigned char*)lds_raw; C.tid = threadIdx.x; C.lane = C.tid & 63; C.wave = __builtin_amdgcn_readfirstlane(C.tid >> 6); C.G = gridDim.x; C.bx = blockIdx.x;
    unsigned char* ws = args.ws;
    for (int u = C.tid; u < 128; u += NWAVES * 64) ((LAS unsigned*)(C.lds + MISC_OFF))[u] = 0u;
    __syncthreads();
#if MK_ONE_LAUNCH
    XcdBarrier bar = xcd_barrier_post((unsigned*)ws + CW_BAR, (volatile LAS unsigned*)(C.lds + MISC_OFF) + 8);
#define GRID_BAR() xcd_barrier(bar)
#else
#define GRID_BAR() do {} while (0)
#endif
    const int lo = args.ph_lo, hi = args.ph_hi;
#ifndef PH_MASK
#define PH_MASK 0xFFFF
#endif
#define IN(k) (((PH_MASK >> (k)) & 1) && lo <= (k) && (k) < hi)
#ifndef DBG_TPHASE
#define DBG_TPHASE -1
#define DBG_TPHASE_HI 11
#endif
#ifndef DBG_TMULT
#define DBG_TMULT 7
#endif
    volatile LAS unsigned long long* stamps = (volatile LAS unsigned long long*)(C.lds + MISC_OFF + 128);
#define STAMP(k) do { if (DBG_TPHASE >= 0 && C.bx == 0 && C.tid == 0) stamps[(k)] = wall_clock64(); } while (0)
#define SEAM(k) do { if (IN(k) && IN((k) + 1)) GRID_BAR(); STAMP((k) + 1); } while (0)
    STAMP(0);
    bf16* XB = (bf16*)(ws + WS_XB); float* SS = (float*)(ws + WS_SS); float* XA = (float*)(ws + WS_XA); float* Y = args.out + OFF_Y; float* SLAB = (float*)(ws + WS_SLAB); const float* RSTD = (const float*)(ws + WS_RSTD);
    using pg8::Gemm; using pg8::StaticOrder;
    if (IN(0)) { ph_prologue(args, C); } SEAM(0);
    if (IN(1)) { Gemm g{XB, (const bf16*)(ws + WS_WAIN), R, 4096, 2048}; pg8::SplitOrder S; S.init(4096, 2048, 4, C.G, C.bx);
        pg8::EpiA1 E{(bf16*)(ws + WS_U), (bf16*)(ws + WS_V), (float*)(ws + WS_VSS), RSTD, SLAB};
        pg8::gemm_phase<pg8::EpiA1, pg8::SplitOrder, true, true>(C.lds, g, S, E); GRID_BAR(); ph_reduce_a1<4>(args, C); } SEAM(1);
    if (IN(2)) { ph_gate(args, C); } SEAM(2);
    if (IN(3)) { Gemm g{(const bf16*)(ws + WS_GT), (const bf16*)(ws + WS_WAOUT), R, 2048, 2048}; pg8::SplitOrder S; S.init(2048, 2048, 8, C.G, C.bx);
        pg8::EpiResidT<false, false> E{nullptr, nullptr, XB, SS, SLAB};
        pg8::gemm_phase<pg8::EpiResidT<false, false>, pg8::SplitOrder, true, true>(C.lds, g, S, E); GRID_BAR(); ph_reduce_resid<8>(args, C, args.in[1], XA + (size_t)RP * 2048); } SEAM(3);
    if (IN(4)) { Gemm g{XB, (const bf16*)(ws + WS_WFIN), R, DFF2, 2048}; StaticOrder S; S.init(R, DFF2, C.G, C.bx);
        pg8::EpiFfn E{(bf16*)(ws + WS_AB), (bf16*)(ws + WS_HID), RSTD, args.out + OFF_CP, args.out + OFF_CS, args.in[20], args.in[21], (PG8_LAS float*)(C.lds + 131072)};
        pg8::gemm_phase<pg8::EpiFfn, StaticOrder, true, true>(C.lds, g, S, E); filler_pull(args, C, 0); } SEAM(4);
    if (IN(5)) { ph_conv(args, C, 0); } SEAM(5);
    if (IN(6)) { Gemm g{(const bf16*)(ws + WS_HID), (const bf16*)(ws + WS_WFOUT), R, 2048, DFF}; pg8::SplitOrder S; S.init(2048, DFF, 8, C.G, C.bx);
        pg8::EpiResidT<false, false> E{nullptr, nullptr, XB, SS, SLAB};
        pg8::gemm_phase<pg8::EpiResidT<false, false>, pg8::SplitOrder, true, true>(C.lds, g, S, E); GRID_BAR(); ph_reduce_resid<8>(args, C, XA + (size_t)RP * 2048, Y + (size_t)RP * 2048); } SEAM(6);
    if (IN(7)) { Gemm g{XB, (const bf16*)(ws + WS_WBIN), R, NBP, 2048}; StaticOrder S; S.init(R, NBP, C.G, C.bx);
        pg8::EpiScale E{(bf16*)(ws + WS_P), NBP, RSTD, nullptr, nullptr};
        pg8::gemm_phase<pg8::EpiScale, StaticOrder, true, true>(C.lds, g, S, E); filler_pull(args, C, 1); } SEAM(7);
    if (IN(8)) { ph_qkrope(args, C); } SEAM(8);
    if (IN(9)) { ph_index(args, C); } SEAM(9);
    if (IN(10)) { ph_select(args, C); } SEAM(10);
    if (IN(11)) { ph_attn(args, C); } SEAM(11);
    if (IN(12)) { Gemm g{(const bf16*)(ws + WS_O), (const bf16*)(ws + WS_WBO), R, 2048, 2048}; pg8::SplitOrder S; S.init(2048, 2048, 8, C.G, C.bx);
        pg8::EpiResidT<false, false> E{nullptr, nullptr, XB, SS, SLAB};
        pg8::gemm_phase<pg8::EpiResidT<false, false>, pg8::SplitOrder, true, true>(C.lds, g, S, E); GRID_BAR(); ph_reduce_resid<8>(args, C, Y + (size_t)RP * 2048, XA + (size_t)RP * 2048); } SEAM(12);
    if (IN(13)) { Gemm g{XB, (const bf16*)(ws + WS_WFIN) + (size_t)DFF2 * 2048, R, DFF2, 2048}; StaticOrder S; S.init(R, DFF2, C.G, C.bx);
        pg8::EpiFfn E{(bf16*)(ws + WS_AB), (bf16*)(ws + WS_HID), RSTD, args.out + OFF_CP + (size_t)8 * 2 * DFF2, args.out + OFF_CS + (size_t)128 * 2 * DFF2, args.in[20] + (size_t)3 * DFF2, args.in[21] + DFF2, (PG8_LAS float*)(C.lds + 131072)};
        pg8::gemm_phase<pg8::EpiFfn, StaticOrder, true, true>(C.lds, g, S, E); filler_pull(args, C, 2); } SEAM(13);
    if (IN(14)) { ph_conv(args, C, 1); } SEAM(14);
    if (IN(15)) { Gemm g{(const bf16*)(ws + WS_HID), (const bf16*)(ws + WS_WFOUT) + (size_t)2048 * DFF, R, 2048, DFF}; pg8::SplitOrder S; S.init(2048, DFF, 8, C.G, C.bx);
        pg8::EpiResidT<false, true> E{nullptr, Y, XB, SS, SLAB};
        pg8::gemm_phase<pg8::EpiResidT<false, true>, pg8::SplitOrder, true, true>(C.lds, g, S, E); GRID_BAR(); ph_reduce_resid<8>(args, C, XA + (size_t)RP * 2048, Y + (size_t)RP * 2048); }
    if (DBG_TPHASE >= 0) {
        STAMP(16);
        if (C.bx == 0 && C.tid == 0) { const unsigned long long d = (stamps[DBG_TPHASE_HI] - stamps[DBG_TPHASE]) * DBG_TMULT, t0 = wall_clock64();
            while (wall_clock64() - t0 < d) __builtin_amdgcn_s_sleep(16); }
    }
#undef IN
#undef SEAM
}

extern "C" void kernel_launch(void* const* d_in, const int* in_sizes, int n_in, void* d_out, int out_size, void* d_ws, size_t ws_size, hipStream_t stream) {
    static int grid = 0;
    if (grid == 0) {
        if (n_in != 23 || (size_t)out_size != OUT_TOTAL || ws_size < WS_END) { fprintf(stderr, "kernel_launch: unexpected shapes (n_in %d, out %d, ws %zu < %zu)\n", n_in, out_size, ws_size, (size_t)WS_END); grid = -1; return; }
        int dev = 0, cus = 0, per_cu = 0;
        if (hipGetDevice(&dev) != hipSuccess || hipDeviceGetAttribute(&cus, hipDeviceAttributeMultiprocessorCount, dev) != hipSuccess) { grid = -1; return; }
        if (hipFuncSetAttribute((const void*)fwd_kernel, hipFuncAttributeMaxDynamicSharedMemorySize, LDS_BYTES) != hipSuccess) { fprintf(stderr, "kernel_launch: hipFuncSetAttribute failed\n"); grid = -1; return; }
        if (hipOccupancyMaxActiveBlocksPerMultiprocessor(&per_cu, (const void*)fwd_kernel, NWAVES * 64, LDS_BYTES) != hipSuccess || per_cu < 1) { fprintf(stderr, "kernel_launch: occupancy query says %d\n", per_cu); }
        (void)hipGetLastError();
        grid = cus;
    }
    if (grid < 0) return;
    (void)hipMemsetAsync(d_ws, 0, CTL_BYTES, stream);
    Args a{};
    for (int i = 0; i < 23; ++i) a.in[i] = (const float*)d_in[i];
    a.out = (float*)d_out; a.ws = (unsigned char*)d_ws;
#if MK_ONE_LAUNCH
    a.ph_lo = 0; a.ph_hi = N_PHASES;
    hipLaunchKernelGGL(fwd_kernel, dim3(grid), dim3(NWAVES * 64), LDS_BYTES, stream, a);
#else
    for (int p = 0; p < DBG_NPH; ++p) { a.ph_lo = p; a.ph_hi = p + 1; hipLaunchKernelGGL(fwd_kernel, dim3(grid), dim3(NWAVES * 64), LDS_BYTES, stream, a); }
#endif
    SELFCHK_HOOK(d_in, d_out, d_ws, stream);
}
```

```cpp
#include <hip/hip_runtime.h>
#include <cstdio>
#include <cstdint>
namespace pg8 {
#define PG8_LAS __attribute__((address_space(3)))
typedef unsigned short bf16_t;
typedef short bf16x8 __attribute__((ext_vector_type(8)));
typedef float f32x4 __attribute__((ext_vector_type(4)));
typedef unsigned u32x4 __attribute__((ext_vector_type(4)));
constexpr int BM = 256, BK = 64, HALF = 128, HTB = HALF * BK * 2  , STAGE_BYTES = 8 * HTB, NXCD = 8, WGM = 8;

__host__ __device__ __forceinline__ int lds_byte(int r, int c) { const int st = (r >> 4) * 2 + (c >> 5), rr = r & 15, cc = c & 31, ob = rr * 64 + cc * 2; return st * 1024 + (ob ^ (((ob >> 9) & 1) << 5)); }
__host__ __device__ __forceinline__ void stage_rc(int b, int& R, int& C) { const int st = b / 1024, sb = b % 1024, swz = sb ^ (((sb >> 9) & 1) << 5); R = (st >> 1) * 16 + swz / 64; C = (st & 1) * 32 + (swz % 64) / 2; }
__host__ __device__ __forceinline__ int perm32(int rho) { const int n = rho >> 4, i = rho & 15; return 8 * (i >> 2) + 4 * n + (i & 3); }

struct Unit { int pm, pn, kb, nt, ks; };
struct Gemm { const bf16_t* A; const bf16_t* Bt; int M, N, K; };

struct StaticOrder {
    int nM, nN, nwg, G, c, nt_full;
    __host__ __device__ void init(int M, int N, int G_, int c_, int K = 2048) { nM = M / BM; nN = N / BM; nwg = nM * nN; G = G_; c = c_; nt_full = K / BK; }
    __host__ __device__ __forceinline__ bool next(int i, Unit& u) const {
        const long L = (long)i * G + c; if (L >= nwg) return false;
        int wgid = (int)L; { const int q = nwg / NXCD, r = nwg % NXCD, xcd = wgid % NXCD, off = wgid / NXCD; wgid = (xcd < r ? xcd * (q + 1) : r * (q + 1) + (xcd - r) * q) + off; }
        const int nig = WGM * nN, gid = wgid / nig, fm = gid * WGM, gsz = (nM - fm) < WGM ? (nM - fm) : WGM;
        u.pm = fm + ((wgid % nig) % gsz); u.pn = (wgid % nig) / gsz; u.kb = 0; u.nt = nt_full; u.ks = -1; return true;
    }
    __device__ __forceinline__ void a_ready(const Unit&) const {}
    __device__ __forceinline__ void done(const Unit&) const {}
};
struct SplitOrder {
    StaticOrder P; int nP, nN, S, nts, rem, G, c;
    __host__ __device__ void init(int N, int K, int S_, int G_, int c_) { P.init(16384, N, G_, c_, K); nP = 64 * (N / BM); nN = N / BM; S = S_; nts = 2 * ((K / BK) / (2 * S_)); rem = ((K / BK) - S_ * nts) / 2; G = G_; c = c_; }
    __host__ __device__ __forceinline__ bool next(int i, Unit& u) const {
        const bool flip = (nP % G == 0) && (4 * nN * S == G) && (((c >> 3) & 1) != 0);
        const long L0 = (long)i * G + c, L = flip ? (long)(i - 1) * G + c : L0;
        const bool isp = flip ? (i >= 1 && L < nP) : (L0 < nP); const int s = flip ? c : (isp ? 0 : (int)(L0 - nP)); const bool iss = flip ? (i == 0) : (!isp && s < 4 * nN * S);
        int wgid = isp ? (int)L : 0; { const int q = nP / NXCD, r = nP % NXCD, xcd = wgid % NXCD, off = wgid / NXCD; wgid = (xcd < r ? xcd * (q + 1) : r * (q + 1) + (xcd - r) * q) + off; }
        const int nig = WGM * nN, gid = wgid / nig, fm = gid * WGM, gsz = (64 - fm) < WGM ? (64 - fm) : WGM;
        const int pm_p = fm + ((wgid % nig) % gsz), pn_p = (wgid % nig) / gsz;
        const int t = s / S, ks = s % S;
        u.pm = isp ? pm_p : 64 + (t & 3); u.pn = isp ? pn_p : (t >> 2); const int st = ks * nts + 2 * (ks < rem ? ks : rem), ntk = nts + (ks < rem ? 2 : 0);
        u.kb = isp ? 0 : st * BK * 2; u.nt = isp ? P.nt_full : ntk; u.ks = isp ? -1 : ks;
        return isp || iss;
    }
    __device__ __forceinline__ void a_ready(const Unit&) const {}
    __device__ __forceinline__ void done(const Unit&) const {}
};
constexpr int RPROMPT = 16384;
typedef __bf16 bf2_t __attribute__((ext_vector_type(2)));
typedef float f32x2 __attribute__((ext_vector_type(2)));
__device__ __forceinline__ unsigned cvt_pk_bf16(float lo, float hi) { f32x2 v = {lo, hi}; return __builtin_bit_cast(unsigned, __builtin_convertvector(v, bf2_t)); }
__device__ __forceinline__ u32x4 pack8(const f32x4& a, const f32x4& b) { u32x4 w; w.x = cvt_pk_bf16(a[0], a[1]); w.y = cvt_pk_bf16(a[2], a[3]); w.z = cvt_pk_bf16(b[0], b[1]); w.w = cvt_pk_bf16(b[2], b[3]); return w; }
__device__ __forceinline__ float rstd_of(const float* rstd, int row) { return rstd[row]; }
__device__ __forceinline__ float gelu_tanh(float x) {
    const float u = x * (0.7978845608f + 0.0356774081f * x * x);
    const float e = __builtin_amdgcn_exp2f(-2.885390082f * u);
    return x * __builtin_amdgcn_rcpf(1.0f + e);
}
__device__ __forceinline__ float sumsq4(const f32x4& a) { return (a[0] * a[0] + a[1] * a[1]) + (a[2] * a[2] + a[3] * a[3]); }

__device__ __forceinline__ void store_slab(const f32x4 (&acc)[2][2][4][2], const Unit& u, int wr, int wc, int fr, int fq, float* slab_, int N) {
    bf16_t* slab = (bf16_t*)slab_;
    const int col0 = u.pn * BM + wc * 32 + 8 * fq, row0 = (u.pm - 64) * BM + wr * 64 + fr;
#pragma unroll
    for (int ai = 0; ai < 2; ++ai)
#pragma unroll
        for (int m = 0; m < 4; ++m) { bf16_t* op = slab + ((size_t)u.ks * 1024 + row0 + ai * HALF + m * 16) * N + col0;
#pragma unroll
            for (int bj = 0; bj < 2; ++bj) *(u32x4*)(op + bj * HALF) = pack8(acc[ai][bj][m][0], acc[ai][bj][m][1]); }
}
struct EpiA1 {
    static constexpr bool PERM = true, AFTER_DRAIN = false;
    bf16_t* U; bf16_t* V; float* vss; const float* ss; float* slab;
    __device__ __forceinline__ void operator()(const f32x4 (&acc)[2][2][4][2], const Unit& u, int wr, int wc, int fr, int fq) const {
        if (u.ks >= 0) { store_slab(acc, u, wr, wc, fr, fq, slab, 4096); return; }
        const bool isv = u.pn >= 8; bf16_t* dst = isv ? V : U; const int pt = isv ? u.pn - 8 : u.pn;
        const int col0 = pt * BM + wc * 32 + 8 * fq, row0 = u.pm * BM + wr * 64 + fr;
        float rsv[2][4];
#pragma unroll
        for (int ai = 0; ai < 2; ++ai)
#pragma unroll
            for (int m = 0; m < 4; ++m) rsv[ai][m] = rstd_of(ss, row0 + ai * HALF + m * 16);
#pragma unroll
        for (int ai = 0; ai < 2; ++ai)
#pragma unroll
            for (int m = 0; m < 4; ++m) { const int row = row0 + ai * HALF + m * 16; const float rs = rsv[ai][m]; float q = 0.f;
#pragma unroll
                for (int bj = 0; bj < 2; ++bj) { f32x4 v0 = acc[ai][bj][m][0] * rs, v1 = acc[ai][bj][m][1] * rs;
#pragma unroll
                    for (int j = 0; j < 4; ++j) { v0[j] = gelu_tanh(v0[j]); v1[j] = gelu_tanh(v1[j]); }
                    q += sumsq4(v0) + sumsq4(v1);
                    *(u32x4*)(dst + (size_t)row * 2048 + col0 + bj * HALF) = pack8(v0, v1); }
                if (isv) { q += __shfl_xor(q, 16); q += __shfl_xor(q, 32); if (fq == 0) vss[(size_t)row * 32 + pt * 4 + wc] = q; } }
    }
};
template <bool BASE_F32, bool OUT_F32> struct EpiResidT {
    static constexpr bool PERM = true, AFTER_DRAIN = false;
    const float* base0; float* out; bf16_t* xb; float* ss; float* slab;
    __device__ __forceinline__ void operator()(const f32x4 (&acc_)[2][2][4][2], const Unit& u, int wr, int wc, int fr_, int fq_) const {
        if (u.ks >= 0) { store_slab(acc_, u, wr, wc, fr_, fq_, slab, 2048); return; }
        f32x4 (&acc)[2][2][4][2] = const_cast<f32x4 (&)[2][2][4][2]>(acc_);
        int fr = fr_, fq = fq_; asm volatile("" : "+v"(fr), "+v"(fq));
        const int col0 = u.pn * BM + wc * 32 + 8 * fq, row0 = u.pm * BM + wr * 64 + fr;
#pragma unroll
        for (int ai = 0; ai < 2; ++ai) {
            if constexpr (BASE_F32) {
                f32x4 bv[4][2][2];
#pragma unroll
                for (int m = 0; m < 4; ++m) { const int row = row0 + ai * HALF + m * 16; const float* bp = base0 + (size_t)row * 2048 + col0;
#pragma unroll
                    for (int bj = 0; bj < 2; ++bj) { bv[m][bj][0] = *(const f32x4*)(bp + bj * HALF); bv[m][bj][1] = *(const f32x4*)(bp + bj * HALF + 4); } }
#pragma unroll
                for (int m = 0; m < 4; ++m)
#pragma unroll
                    for (int bj = 0; bj < 2; ++bj) { acc[ai][bj][m][0] += bv[m][bj][0]; acc[ai][bj][m][1] += bv[m][bj][1]; }
            } else {
                u32x4 bw[4][2];
#pragma unroll
                for (int m = 0; m < 4; ++m) { const int row = row0 + ai * HALF + m * 16;
#pragma unroll
                    for (int bj = 0; bj < 2; ++bj) bw[m][bj] = *(const u32x4*)(xb + (size_t)row * 2048 + col0 + bj * HALF); }
#pragma unroll
                for (int m = 0; m < 4; ++m)
#pragma unroll
                    for (int bj = 0; bj < 2; ++bj) { const u32x4 w = bw[m][bj];
                        acc[ai][bj][m][0][0] += __uint_as_float(w.x << 16); acc[ai][bj][m][0][1] += __uint_as_float(w.x & 0xffff0000u);
                        acc[ai][bj][m][0][2] += __uint_as_float(w.y << 16); acc[ai][bj][m][0][3] += __uint_as_float(w.y & 0xffff0000u);
                        acc[ai][bj][m][1][0] += __uint_as_float(w.z << 16); acc[ai][bj][m][1][1] += __uint_as_float(w.z & 0xffff0000u);
                        acc[ai][bj][m][1][2] += __uint_as_float(w.w << 16); acc[ai][bj][m][1][3] += __uint_as_float(w.w & 0xffff0000u); }
            }
            __builtin_amdgcn_sched_barrier(0);
#pragma unroll
            for (int m = 0; m < 4; ++m) { const int row = row0 + ai * HALF + m * 16; float q = 0.f;
#pragma unroll
                for (int bj = 0; bj < 2; ++bj) { const f32x4 o0 = acc[ai][bj][m][0], o1 = acc[ai][bj][m][1];
                    q += sumsq4(o0) + sumsq4(o1);
                    if constexpr (OUT_F32) { float* op = out + (size_t)row * 2048 + col0; __builtin_nontemporal_store(o0, (f32x4*)(op + bj * HALF)); __builtin_nontemporal_store(o1, (f32x4*)(op + bj * HALF + 4)); }
                    else *(u32x4*)(xb + (size_t)row * 2048 + col0 + bj * HALF) = pack8(o0, o1); }
                q += __shfl_xor(q, 16); q += __shfl_xor(q, 32); if (fq == 0) ss[(size_t)row * 32 + u.pn * 4 + wc] = q; }
            __builtin_amdgcn_sched_barrier(0);
        }
    }
};
struct EpiScale {
    static constexpr bool PERM = true, AFTER_DRAIN = false;
    bf16_t* O; int ldc; const float* ss; float* convp; float* convs;
    __device__ __forceinline__ void operator()(const f32x4 (&acc)[2][2][4][2], const Unit& u, int wr, int wc, int fr, int fq) const {
        const int col0 = u.pn * BM + wc * 32 + 8 * fq, row0 = u.pm * BM + wr * 64 + fr;
        float rsv[2][4];
#pragma unroll
        for (int ai = 0; ai < 2; ++ai)
#pragma unroll
            for (int m = 0; m < 4; ++m) rsv[ai][m] = rstd_of(ss, row0 + ai * HALF + m * 16);
#pragma unroll
        for (int ai = 0; ai < 2; ++ai)
#pragma unroll
            for (int m = 0; m < 4; ++m) { const int row = row0 + ai * HALF + m * 16; const float rs = rsv[ai][m];
                float* cd = nullptr;
                if (convp) { if (row < RPROMPT) { const int t = row & 2047; if (t >= 2046) cd = convp + (size_t)((row >> 11) * 2 + (t - 2046)) * ldc; }
                             else { const int rr = row - RPROMPT, t = rr & 7; if (t >= 6) cd = convs + (size_t)((rr >> 3) * 2 + (t - 6)) * ldc; } }
#pragma unroll
                for (int bj = 0; bj < 2; ++bj) { const f32x4 v0 = acc[ai][bj][m][0] * rs, v1 = acc[ai][bj][m][1] * rs;
                    *(u32x4*)(O + (size_t)row * ldc + col0 + bj * HALF) = pack8(v0, v1);
                    if (cd) { *(f32x4*)(cd + col0 + bj * HALF) = v0; *(f32x4*)(cd + col0 + bj * HALF + 4) = v1; } } }
    }
};

__device__ __forceinline__ float dpp_f(float old, float src, int ctrl_sel) {
    const int o = __builtin_bit_cast(int, old), x = __builtin_bit_cast(int, src); int r;
    if (ctrl_sel == 0) r = __builtin_amdgcn_update_dpp(o, x, 0x111, 0xf, 0xf, false);
    else if (ctrl_sel == 1) r = __builtin_amdgcn_update_dpp(o, x, 0x112, 0xf, 0xf, false);
    else if (ctrl_sel == 2) r = __builtin_amdgcn_update_dpp(o, x, 0x121, 0xf, 0xf, false);
    else r = __builtin_amdgcn_update_dpp(o, x, 0x122, 0xf, 0xf, false);
    return __builtin_bit_cast(float, r);
}
struct EpiFfn {
    static constexpr bool PERM = true, AFTER_DRAIN = false;
    bf16_t* AB; bf16_t* HID; const float* ss; float* convp; float* convs; const float* cw; const float* cb; PG8_LAS float* xl;
    __device__ __forceinline__ void operator()(const f32x4 (&acc_)[2][2][4][2], const Unit& u, int wr, int wc, int fr, int fq) const {
        f32x4 (&acc)[2][2][4][2] = const_cast<f32x4 (&)[2][2][4][2]>(acc_);
        const int colg = u.pn * 128 + wc * 32 + 8 * fq, colu = 5632 + colg, row0 = u.pm * BM + wr * 64 + fr;
        const bool sample = u.pm >= 64;
        float rsv[2][4];
#pragma unroll
        for (int ai = 0; ai < 2; ++ai)
#pragma unroll
            for (int m = 0; m < 4; ++m) rsv[ai][m] = rstd_of(ss, row0 + ai * HALF + m * 16);
#pragma unroll
        for (int ai = 0; ai < 2; ++ai)
#pragma unroll
            for (int m = 0; m < 4; ++m) { const int row = row0 + ai * HALF + m * 16; const int tr = row & 255; const float rs = rsv[ai][m];
                acc[ai][0][m][0] *= rs; acc[ai][0][m][1] *= rs; acc[ai][1][m][0] *= rs; acc[ai][1][m][1] *= rs;
                float* cd = nullptr;
                if (row < RPROMPT) { const int t = row & 2047; if (t >= 2046) cd = convp + (size_t)((row >> 11) * 2 + (t - 2046)) * 11264; }
                else { const int rr = row - RPROMPT, t = rr & 7; if (t >= 6) cd = convs + (size_t)((rr >> 3) * 2 + (t - 6)) * 11264; }
                if (sample || tr < 2 || tr >= 254) { *(u32x4*)(AB + (size_t)row * 11264 + colg) = pack8(acc[ai][0][m][0], acc[ai][0][m][1]); *(u32x4*)(AB + (size_t)row * 11264 + colu) = pack8(acc[ai][1][m][0], acc[ai][1][m][1]); }
                if (cd) { *(f32x4*)(cd + colg) = acc[ai][0][m][0]; *(f32x4*)(cd + colg + 4) = acc[ai][0][m][1]; *(f32x4*)(cd + colu) = acc[ai][1][m][0]; *(f32x4*)(cd + colu + 4) = acc[ai][1][m][1]; }
                __builtin_amdgcn_sched_barrier(0); }
        const int wave = wr * 4 + wc;
        if (fr >= 14) {
#pragma unroll
            for (int ai = 0; ai < 2; ++ai) { PG8_LAS float* d = xl + ((((wave * 2 + ai) * 2 + (fr - 14)) * 4 + fq) << 4);
                *(PG8_LAS f32x4*)(d) = acc[ai][0][3][0]; *(PG8_LAS f32x4*)(d + 4) = acc[ai][0][3][1]; *(PG8_LAS f32x4*)(d + 8) = acc[ai][1][3][0]; *(PG8_LAS f32x4*)(d + 12) = acc[ai][1][3][1]; } }
        asm volatile("s_waitcnt lgkmcnt(0)" ::: "memory"); __builtin_amdgcn_s_barrier(); asm volatile("" ::: "memory");
        if (sample) return;
#pragma unroll
        for (int n = 0; n < 2; ++n) {
            const f32x4 w0g = *(const f32x4*)(cw + colg + 4 * n), w1g = *(const f32x4*)(cw + 11264 + colg + 4 * n), w2g = *(const f32x4*)(cw + 22528 + colg + 4 * n), bg = *(const f32x4*)(cb + colg + 4 * n);
            const f32x4 w0u = *(const f32x4*)(cw + colu + 4 * n), w1u = *(const f32x4*)(cw + 11264 + colu + 4 * n), w2u = *(const f32x4*)(cw + 22528 + colu + 4 * n), bu = *(const f32x4*)(cb + colu + 4 * n);
#pragma unroll
            for (int ai = 0; ai < 2; ++ai) {
                const int rb = 2 * ai + wr;
                f32x4 c1g = {0.f, 0.f, 0.f, 0.f}, c2g = c1g, c1u = c1g, c2u = c1g;
                if (rb > 0 && fr < 2) { const int pw = ((rb - 1) & 1) * 4 + wc, pai = (rb - 1) >> 1;
                    const PG8_LAS float* r1 = xl + ((((pw * 2 + pai) * 2 + 1) * 4 + fq) << 4);
                    const PG8_LAS float* r2 = xl + ((((pw * 2 + pai) * 2 + 0) * 4 + fq) << 4);
                    c1g = *(const PG8_LAS f32x4*)(r1 + 4 * n); c1u = *(const PG8_LAS f32x4*)(r1 + 8 + 4 * n);
                    const PG8_LAS float* q2 = fr == 0 ? r2 : r1; c2g = *(const PG8_LAS f32x4*)(q2 + 4 * n); c2u = *(const PG8_LAS f32x4*)(q2 + 8 + 4 * n); }
#pragma unroll
                for (int m = 0; m < 4; ++m) { const int row = row0 + ai * HALF + m * 16;
                    const f32x4 xg = acc[ai][0][m][n], xu = acc[ai][1][m][n];
                    if (m > 0) { const f32x4 pg = acc[ai][0][m - 1][n], pu = acc[ai][1][m - 1][n];
#pragma unroll
                        for (int e = 0; e < 4; ++e) { c1g[e] = dpp_f(0.f, pg[e], 2); c2g[e] = dpp_f(0.f, pg[e], 3); c1u[e] = dpp_f(0.f, pu[e], 2); c2u[e] = dpp_f(0.f, pu[e], 3); } }
                    float h[4];
#pragma unroll
                    for (int e = 0; e < 4; ++e) { const float p1g = dpp_f(c1g[e], xg[e], 0), p2g = dpp_f(c2g[e], xg[e], 1), p1u = dpp_f(c1u[e], xu[e], 0), p2u = dpp_f(c2u[e], xu[e], 1);
                        const float cg = bg[e] + w0g[e] * p2g + w1g[e] * p1g + w2g[e] * xg[e], cu = bu[e] + w0u[e] * p2u + w1u[e] * p1u + w2u[e] * xu[e];
                        h[e] = cg * __builtin_amdgcn_rcpf(1.0f + __builtin_amdgcn_exp2f(-1.4426950408889634f * cg)) * cu; }
                    if (!(rb == 0 && m == 0 && fr < 2)) { typedef unsigned u32x2 __attribute__((ext_vector_type(2)));
                        *(u32x2*)(HID + (size_t)row * 5632 + colg + 4 * n) = (u32x2){cvt_pk_bf16(h[0], h[1]), cvt_pk_bf16(h[2], h[3])}; }
                    if (m & 1) __builtin_amdgcn_sched_barrier(0);
                }
            }
        }
    }
};

template <class Epi, class Sched, bool ALIGN_EPI = false, bool SP2 = false>
__device__ __forceinline__ void gemm_phase(PG8_LAS unsigned char* lds, const Gemm g, const Sched& S, const Epi& E) {
    const int tid = threadIdx.x, wid = __builtin_amdgcn_readfirstlane(tid >> 6), lane = tid & 63, wr = wid >> 2, wc = wid & 3, fr = lane & 15, fq = lane >> 4;
    const int K = g.K; int nt;
    unsigned voffA[2], voffB[2];
#pragma unroll
    for (int i = 0; i < 2; ++i) { int R, C; stage_rc(tid * 16 + i * 8192, R, C); const int Rb = Epi::PERM ? ((R & ~31) + perm32(R & 31)) : R;
        voffA[i] = (unsigned)(R * K + C) * 2u; voffB[i] = (unsigned)(Rb * K + C) * 2u; }
    const size_t kstep = (size_t)(BK * 2);
    const size_t hstep = (size_t)HALF * K * 2;
    const size_t tstep = 2 * hstep;
    const unsigned ldsw = (unsigned)wid * 1024u;
    const int aoff = lds_byte(wr * 64 + fr, fq * 8), boff = lds_byte(wc * 32 + fr, fq * 8);
#define PG8_SA(b, h) (((b) * 2 + (h)) * HTB)
#define PG8_SB(b, h) ((4 + (b) * 2 + (h)) * HTB)
#define PG8_STAGE(bufoff, gbase, voff) do { _Pragma("unroll") for (int _i = 0; _i < 2; ++_i) \
        __builtin_amdgcn_global_load_lds((const unsigned*)((const char*)(gbase) + (voff)[_i]), (PG8_LAS unsigned*)(lds + (bufoff) + ldsw + _i * 8192), 16, 0, 0); } while (0)
#define PG8_LDA(dst, b, h) do { _Pragma("unroll") for (int m = 0; m < 4; ++m) _Pragma("unroll") for (int k = 0; k < 2; ++k) dst[m][k] = *(const PG8_LAS bf16x8*)(lds + PG8_SA(b, h) + aoff + m * 2048 + k * 1024); } while (0)
#define PG8_LDB(dst, b, h) do { _Pragma("unroll") for (int n = 0; n < 2; ++n) _Pragma("unroll") for (int k = 0; k < 2; ++k) dst[n][k] = *(const PG8_LAS bf16x8*)(lds + PG8_SB(b, h) + boff + n * 2048 + k * 1024); } while (0)
#define PG8_MMA(ai, bj, At, Bt) do { __builtin_amdgcn_s_setprio(1); _Pragma("unroll") for (int m = 0; m < 4; ++m) _Pragma("unroll") for (int n = 0; n < 2; ++n) _Pragma("unroll") for (int k = 0; k < 2; ++k) \
        acc[ai][bj][m][n] = __builtin_amdgcn_mfma_f32_16x16x32_bf16(Bt[n][k], At[m][k], acc[ai][bj][m][n], 0, 0, 0); __builtin_amdgcn_s_setprio(0); } while (0)
#define PG8_WAIT_V(n) asm volatile("s_waitcnt vmcnt(" #n ")" ::: "memory")
#define PG8_WAIT_L(n) asm volatile("s_waitcnt lgkmcnt(" #n ")" ::: "memory")
#define PG8_BAR __builtin_amdgcn_s_barrier()
#define PG8_SCHED __builtin_amdgcn_sched_barrier(0)
    Unit cur, nxt; int ui = 0;
    if (!S.next(0, cur)) return;
    f32x4 acc[2][2][4][2];
#pragma unroll
    for (int a = 0; a < 2; ++a)
#pragma unroll
        for (int b = 0; b < 2; ++b)
#pragma unroll
            for (int m = 0; m < 4; ++m)
#pragma unroll
                for (int n = 0; n < 2; ++n) acc[a][b][m][n] = (f32x4){0.f, 0.f, 0.f, 0.f};
    bf16x8 At[4][2], B0[2][2], B1[2][2];
    const char* cA = (const char*)g.A + (size_t)cur.pm * tstep + cur.kb; const char* cB = (const char*)g.Bt + (size_t)cur.pn * tstep + cur.kb; nt = cur.nt;
    S.a_ready(cur);
    if constexpr (SP2) {
        PG8_STAGE(PG8_SB(0, 0), cB, voffB); PG8_STAGE(PG8_SB(0, 1), cB + hstep, voffB); PG8_STAGE(PG8_SA(0, 0), cA, voffA); PG8_STAGE(PG8_SA(0, 1), cA + hstep, voffA);
        if (wr == 1) PG8_BAR;
        PG8_WAIT_V(2); PG8_BAR;
        PG8_STAGE(PG8_SB(1, 0), cB + kstep, voffB); PG8_STAGE(PG8_SA(1, 0), cA + kstep, voffA); PG8_STAGE(PG8_SB(1, 1), cB + hstep + kstep, voffB);
        PG8_WAIT_V(6); PG8_BAR;
    } else {
        PG8_STAGE(PG8_SB(0, 0), cB, voffB); PG8_STAGE(PG8_SA(0, 0), cA, voffA); PG8_STAGE(PG8_SB(0, 1), cB + hstep, voffB); PG8_STAGE(PG8_SA(0, 1), cA + hstep, voffA);
        if (wr == 1) PG8_BAR;
        PG8_WAIT_V(4); PG8_BAR;
        PG8_STAGE(PG8_SB(1, 0), cB + kstep, voffB); PG8_STAGE(PG8_SA(1, 0), cA + kstep, voffA); PG8_STAGE(PG8_SB(1, 1), cB + hstep + kstep, voffB);
        PG8_WAIT_V(6); PG8_BAR;
    }
    for (;;) {
        const bool has_next = S.next(ui + 1, nxt);
        const char* nA = has_next ? (const char*)g.A + (size_t)nxt.pm * tstep + nxt.kb : cA; const char* nB = has_next ? (const char*)g.Bt + (size_t)nxt.pn * tstep + nxt.kb : cB;
        for (int t = 0; t < nt; t += 2) {
            const bool last = (t == nt - 2);
            const char* a1 = cA + (size_t)(t + 1) * kstep;
            const char* a2 = last ? nA : cA + (size_t)(t + 2) * kstep; const char* b2 = last ? nB : cB + (size_t)(t + 2) * kstep;
            const char* a3 = a2 + kstep; const char* b3 = b2 + kstep;
            if (last && has_next) S.a_ready(nxt);
            if constexpr (SP2) {
            PG8_LDB(B0, 0, 0); PG8_LDB(B1, 0, 1); PG8_SCHED; PG8_LDA(At, 0, 0); PG8_STAGE(PG8_SA(1, 1), a1 + hstep, voffA);
            PG8_WAIT_V(8); PG8_WAIT_L(0); PG8_BAR; PG8_MMA(0, 0, At, B0); PG8_MMA(0, 1, At, B1); PG8_BAR; PG8_SCHED;
            PG8_LDA(At, 0, 1); PG8_STAGE(PG8_SB(0, 0), b2, voffB); PG8_STAGE(PG8_SB(0, 1), b2 + hstep, voffB); PG8_STAGE(PG8_SA(0, 0), a2, voffA);
            PG8_WAIT_V(8); PG8_WAIT_L(0); PG8_BAR; PG8_MMA(1, 0, At, B0); PG8_MMA(1, 1, At, B1); PG8_BAR; PG8_SCHED;
            PG8_LDB(B0, 1, 0); PG8_LDB(B1, 1, 1); PG8_SCHED; PG8_LDA(At, 1, 0); PG8_STAGE(PG8_SA(0, 1), a2 + hstep, voffA);
            PG8_WAIT_V(8); PG8_WAIT_L(0); PG8_BAR; PG8_MMA(0, 0, At, B0); PG8_MMA(0, 1, At, B1); PG8_BAR; PG8_SCHED;
            PG8_LDA(At, 1, 1); PG8_STAGE(PG8_SB(1, 0), b3, voffB); PG8_STAGE(PG8_SB(1, 1), b3 + hstep, voffB); PG8_STAGE(PG8_SA(1, 0), a3, voffA);
            PG8_WAIT_V(8); PG8_WAIT_L(0); PG8_BAR; PG8_MMA(1, 0, At, B0); PG8_MMA(1, 1, At, B1); PG8_BAR; PG8_SCHED;
            } else {
            PG8_LDB(B0, 0, 0); PG8_SCHED; PG8_LDA(At, 0, 0); PG8_STAGE(PG8_SA(1, 1), a1 + hstep, voffA);
            PG8_WAIT_L(8); PG8_BAR; PG8_WAIT_L(0); PG8_MMA(0, 0, At, B0); PG8_BAR; PG8_SCHED;
            PG8_LDB(B1, 0, 1); PG8_STAGE(PG8_SB(0, 0), b2, voffB);
            PG8_BAR; PG8_WAIT_L(0); PG8_MMA(0, 1, At, B1); PG8_BAR;
            PG8_LDA(At, 0, 1); PG8_STAGE(PG8_SA(0, 0), a2, voffA);
            PG8_BAR; PG8_WAIT_L(0); PG8_MMA(1, 0, At, B0); PG8_BAR; PG8_SCHED;
            PG8_STAGE(PG8_SB(0, 1), b2 + hstep, voffB);
            PG8_WAIT_V(6); PG8_BAR; PG8_MMA(1, 1, At, B1); PG8_BAR;
            PG8_LDB(B0, 1, 0); PG8_SCHED; PG8_LDA(At, 1, 0); PG8_STAGE(PG8_SA(0, 1), a2 + hstep, voffA);
            PG8_WAIT_L(8); PG8_BAR; PG8_WAIT_L(0); PG8_MMA(0, 0, At, B0); PG8_BAR; PG8_SCHED;
            PG8_LDB(B1, 1, 1); PG8_STAGE(PG8_SB(1, 0), b3, voffB);
            PG8_BAR; PG8_WAIT_L(0); PG8_MMA(0, 1, At, B1); PG8_BAR;
            PG8_LDA(At, 1, 1); PG8_STAGE(PG8_SA(1, 0), a3, voffA);
            PG8_BAR; PG8_WAIT_L(0); PG8_MMA(1, 0, At, B0); PG8_BAR; PG8_SCHED;
            PG8_STAGE(PG8_SB(1, 1), b3 + hstep, voffB);
            PG8_WAIT_V(6); PG8_BAR; PG8_MMA(1, 1, At, B1); PG8_BAR;
            }
        }
        if constexpr (ALIGN_EPI) { if (wr == 0) PG8_BAR; }
        if constexpr (!Epi::AFTER_DRAIN) { E(acc, cur, wr, wc, fr, fq); S.done(cur); }
        if (!has_next) break;
#pragma unroll
        for (int a = 0; a < 2; ++a)
#pragma unroll
            for (int b = 0; b < 2; ++b)
#pragma unroll
                for (int m = 0; m < 4; ++m)
#pragma unroll
                    for (int n = 0; n < 2; ++n) acc[a][b][m][n] = (f32x4){0.f, 0.f, 0.f, 0.f};
        cur = nxt; cA = nA; cB = nB; nt = cur.nt; ++ui;
        if constexpr (ALIGN_EPI) { if (wr == 1) PG8_BAR; }
    }
    PG8_WAIT_V(0);
    if constexpr (!ALIGN_EPI) { if (wr == 0) PG8_BAR; }
    PG8_BAR;
    if constexpr (Epi::AFTER_DRAIN) { E.fused(acc, cur, wr, wc, fr, fq, lds, wid, lane); S.done(cur); }
#undef PG8_SA
#undef PG8_SB
#undef PG8_STAGE
#undef PG8_LDA
#undef PG8_LDB
#undef PG8_MMA
#undef PG8_WAIT_V
#undef PG8_WAIT_L
#undef PG8_BAR
#undef PG8_SCHED
}
}
constexpr int NWAVES = 8;
constexpr int RP = 16384, RS = 1024, R = RP + RS;
constexpr int DM = 2048, DFF = 5632, DFF2 = 11264, BPROJ = 4176, NBP = 4352;
constexpr float EPS = 1e-6f;
constexpr float QSCALE = 0.08838834764831845f * 1.4426950408889634f;
constexpr size_t OFF_Y = 0, OFF_KP = 35651584, OFF_VP = 44040192, OFF_IKP = 52428800, OFF_KS = 53477376, OFF_VS = 54001664, OFF_IKS = 54525952,
                 OFF_CV = 54591488, OFF_CP = 56688640, OFF_CS = 57049088, OUT_TOTAL = 62816256;
constexpr size_t CTL_BYTES = 1u << 20;
constexpr size_t WS_WAIN = CTL_BYTES;
constexpr size_t WS_WAOUT = WS_WAIN + (size_t)4096 * 2048 * 2;
constexpr size_t WS_WBIN = WS_WAOUT + (size_t)2048 * 2048 * 2;
constexpr size_t WS_WBO = WS_WBIN + (size_t)NBP * 2048 * 2;
constexpr size_t WS_WFIN = WS_WBO + (size_t)2048 * 2048 * 2;
constexpr size_t WS_WFOUT = WS_WFIN + (size_t)2 * DFF2 * 2048 * 2;
constexpr size_t WS_XB = WS_WFOUT + (size_t)2 * 2048 * DFF * 2;
constexpr size_t WS_SS = WS_XB + (size_t)R * 2048 * 2;
constexpr size_t WS_XA = WS_SS + (size_t)R * 32 * 4;
constexpr size_t WS_U = WS_XA + (size_t)R * 2048 * 4;
constexpr size_t WS_V = WS_U + (size_t)R * 2048 * 2;
constexpr size_t WS_VSS = WS_V + (size_t)R * 2048 * 2;
constexpr size_t WS_GT = WS_VSS + (size_t)R * 32 * 4;
constexpr size_t WS_AB = WS_GT + (size_t)R * 2048 * 2;
constexpr size_t WS_HID = WS_AB + (size_t)R * DFF2 * 2;
constexpr size_t WS_P = WS_HID + (size_t)R * DFF * 2;
constexpr size_t WS_Q = WS_P + (size_t)R * NBP * 2;
constexpr size_t WS_KB = WS_Q + (size_t)R * 2048 * 2;
constexpr size_t WS_VB = WS_KB + (size_t)R * 512 * 2;
constexpr size_t WS_IQ = WS_VB + (size_t)R * 512 * 2;
constexpr size_t WS_IK = WS_IQ + (size_t)R * 1024 * 2;
constexpr size_t WS_IW = WS_IK + (size_t)R * 64 * 2;
constexpr size_t WS_ROPE = WS_IW + (size_t)R * 16 * 4;
constexpr size_t WS_SC = WS_ROPE + (size_t)2056 * 96 * 2 * 4;
constexpr size_t WS_SCS = WS_SC + (size_t)RP * 2048 * 4;
constexpr size_t WS_MASK = WS_SCS + (size_t)RS * 2112 * 4;
constexpr size_t WS_O = WS_MASK + (size_t)R * 34 * 8;
constexpr size_t WS_SLAB = WS_O + (size_t)R * 2048 * 2;
constexpr size_t WS_RSTD = WS_SLAB + (size_t)16384 * 1024 * 4;
constexpr size_t WS_END = WS_RSTD + (size_t)R * 4;
constexpr int CW_BAR = 4096;
constexpr int CW_WQ = 8192;
constexpr int CW_CHK = 16384;
constexpr int LDS_BYTES = 147456;
constexpr int MISC_OFF = 147456 - 512;

#define GAS __attribute__((address_space(1)))
#define LAS __attribute__((address_space(3)))
#define DI __device__ __forceinline__
typedef unsigned short bf16;
typedef unsigned v4u __attribute__((ext_vector_type(4)));
typedef unsigned v2u __attribute__((ext_vector_type(2)));
typedef float f32x4 __attribute__((ext_vector_type(4)));
typedef float f32x16 __attribute__((ext_vector_type(16)));
typedef short bf16x8 __attribute__((ext_vector_type(8)));
typedef GAS unsigned gu32;
#define RLX_AGENT __ATOMIC_RELAXED, __HIP_MEMORY_SCOPE_AGENT
#define LDS_WAIT() asm volatile("s_waitcnt lgkmcnt(0)" ::: "memory")
#define MFMA32(a, b, c) __builtin_amdgcn_mfma_f32_32x32x16_bf16((a), (b), (c), 0, 0, 0)
#define MFMA16(a, b, c) __builtin_amdgcn_mfma_f32_16x16x32_bf16((a), (b), (c), 0, 0, 0)
DI float bf2f(unsigned short h) { return __uint_as_float(((unsigned)h) << 16); }
DI float bflo(unsigned w) { return __uint_as_float(w << 16); }
DI float bfhi(unsigned w) { return __uint_as_float(w & 0xffff0000u); }
DI unsigned pk2(float lo, float hi) { return pg8::cvt_pk_bf16(lo, hi); }
DI unsigned short f2bf(float f) { return (unsigned short)(pk2(f, 0.f) & 0xffffu); }
DI float wave_sum(float v) {
#pragma unroll
    for (int o = 1; o < 64; o <<= 1) v += __shfl_xor(v, o);
    return v;
}
DI float fexp2(float x) { return __builtin_amdgcn_exp2f(x); }
#define XB_TMO      128
#define XB_XCNT(j)  (256  + 64 * (j))
#define XB_XSUB(j)  (1280 + 64 * (j))
#define XB_XGEN(j)  (2304 + 64 * (j))
#define XB_TOP      3328
#define XB_TOPGEN   3392
#define XCD_BAR_WORDS 3456
#define XB_SPIN_CAP (1u << 18)

__device__ __forceinline__ unsigned xb_ld(unsigned* p)              { return __hip_atomic_load(p, __ATOMIC_RELAXED, __HIP_MEMORY_SCOPE_AGENT); }
__device__ __forceinline__ unsigned xb_add(unsigned* p, unsigned v) { return __hip_atomic_fetch_add(p, v, __ATOMIC_RELAXED, __HIP_MEMORY_SCOPE_AGENT); }
__device__ __forceinline__ unsigned xb_xcc_id() { return (unsigned)__builtin_amdgcn_s_getreg((3 << 11) | 20) & 0xFu; }
#define XB_SPIN(cond, bar) do { unsigned _sp = 0; while (cond) { __builtin_amdgcn_s_sleep(1); \
    if ((++_sp & 255u) == 0u) { if (xb_ld(&(bar)[XB_TMO])) break; if (_sp > XB_SPIN_CAP) { atomicAdd(&(bar)[XB_TMO], 1u); break; } } } } while (0)

struct XcdBarrier {
    unsigned* bar; unsigned x;
    volatile LAS unsigned* st;
};

__device__ __forceinline__ XcdBarrier xcd_barrier_post(unsigned* bar, volatile LAS unsigned* st) {
    XcdBarrier b; b.bar = bar; b.x = xb_xcc_id(); b.st = st;
    if (threadIdx.x == 0) (void)xb_add(&bar[XB_XCNT(b.x)], 1u);
    return b;
}
__device__ __forceinline__ void xcd_barrier_complete(unsigned* bar, unsigned x, unsigned& nloc, unsigned& nx) {
    const unsigned G = gridDim.x * gridDim.y * gridDim.z;
    unsigned sum, cnt, mine, sp = 0u;
    for (;;) {
        sum = 0u; cnt = 0u; mine = 0u;
#pragma unroll
        for (unsigned j = 0; j < 16; ++j) { const unsigned c = xb_ld(&bar[XB_XCNT(j)]); sum += c; cnt += (c > 0u) ? 1u : 0u; mine = (j == x) ? c : mine; }
        if (sum == G) break;
        __builtin_amdgcn_s_sleep(1);
        if ((++sp & 255u) == 0u) { if (xb_ld(&bar[XB_TMO])) break; if (sp > XB_SPIN_CAP) { atomicAdd(&bar[XB_TMO], 1u); break; } }
    }
    nloc = mine > 0u ? mine : 1u; nx = cnt > 0u ? cnt : 1u;
}

__device__ __forceinline__ void xcd_barrier(const XcdBarrier& b) {
    asm volatile("s_waitcnt vmcnt(0)" ::: "memory");
    __syncthreads();
    if (threadIdx.x == 0) {
        unsigned* bar = b.bar;
        __builtin_amdgcn_s_waitcnt(0);
        unsigned nloc = b.st[0], nx = b.st[1];
        if (nloc == 0u) { xcd_barrier_complete(bar, b.x, nloc, nx); b.st[0] = nloc; b.st[1] = nx; }
        const unsigned old = xb_add(&bar[XB_XSUB(b.x)], 1u);
        const unsigned gen = old / nloc;
        if (old + 1u == (gen + 1u) * nloc) {
            __builtin_amdgcn_fence(__ATOMIC_RELEASE, "agent");
            asm volatile("s_waitcnt vmcnt(0)" ::: "memory");
            const unsigned og = xb_add(&bar[XB_TOP], 1u);
            const unsigned tg = og / nx;
            if (og + 1u == (tg + 1u) * nx) xb_add(&bar[XB_TOPGEN], 1u);
            else XB_SPIN(xb_ld(&bar[XB_TOPGEN]) == tg, bar);
            __builtin_amdgcn_fence(__ATOMIC_ACQUIRE, "agent");
            xb_add(&bar[XB_XGEN(b.x)], 1u);
            asm volatile("s_waitcnt vmcnt(0)" ::: "memory");
        } else {
            XB_SPIN(xb_ld(&bar[XB_XGEN(b.x)]) == gen, bar);
            __builtin_amdgcn_fence(__ATOMIC_ACQUIRE, "agent");
            asm volatile("s_waitcnt vmcnt(0)" ::: "memory");
        }
    }
    __syncthreads();
}
struct Args { const float* in[23]; float* out; unsigned char* ws; int ph_lo, ph_hi; };
struct Ctx { LAS unsigned char* lds; int tid, lane, wave, G, bx; };

DI void p0_transpose_item(const float* W, const float* gain, int K, int N, int Npad, bf16* WT, LAS float* scr, int item, int lane, bool permF = false) {
    const int nblk = Npad / 64, kb = item / nblk, nb = item % nblk, k0 = 64 * kb, n0 = 64 * nb;
    const int l15 = lane & 15, kq = lane >> 4, n = n0 + 4 * l15;
    const int nout0 = !permF ? n0 : (n0 < 5632 ? 256 * (n0 >> 7) + (n0 & 127) : 256 * ((n0 - 5632) >> 7) + 128 + ((n0 - 5632) & 127));
    f32x4 v[16];
#pragma unroll
    for (int i = 0; i < 16; ++i) { v[i] = (f32x4){0.f, 0.f, 0.f, 0.f}; if (n < N) v[i] = *(const f32x4*)(W + (size_t)(k0 + 4 * i + kq) * N + n); }
    if (gain) {
#pragma unroll
        for (int i = 0; i < 16; ++i) v[i] *= gain[k0 + 4 * i + kq]; }
#pragma unroll
    for (int i = 0; i < 16; ++i) { LAS float* d = scr + (4 * i + kq) * 65 + 4 * l15; d[0] = v[i][0]; d[1] = v[i][1]; d[2] = v[i][2]; d[3] = v[i][3]; }
    LDS_WAIT(); asm volatile("" ::: "memory");
    const int c = lane & 7;
#pragma unroll
    for (int j = 0; j < 8; ++j) { const int nn = (lane >> 3) + 8 * j; const LAS float* s = scr + (8 * c) * 65 + nn;
        v4u o; o.x = pk2(s[0 * 65], s[1 * 65]); o.y = pk2(s[2 * 65], s[3 * 65]); o.z = pk2(s[4 * 65], s[5 * 65]); o.w = pk2(s[6 * 65], s[7 * 65]);
        *(GAS v4u*)(WT + (size_t)(nout0 + nn) * K + k0 + 8 * c) = o; }
    LDS_WAIT(); asm volatile("" ::: "memory");
}
DI void sincos_small(double r, double& s, double& c) {
    const double r2 = r * r;
    double ts = 1.0 / 51090942171709440000.0;
    ts = ts * r2 * (-1.0) + 1.0 / 121645100408832000.0;
    ts = ts * (-r2) + 1.0 / 355687428096000.0;
    ts = ts * (-r2) + 1.0 / 1307674368000.0;
    ts = ts * (-r2) + 1.0 / 6227020800.0;
    ts = ts * (-r2) + 1.0 / 39916800.0;
    ts = ts * (-r2) + 1.0 / 362880.0;
    ts = ts * (-r2) + 1.0 / 5040.0;
    ts = ts * (-r2) + 1.0 / 120.0;
    ts = ts * (-r2) + 1.0 / 6.0;
    ts = ts * (-r2) + 1.0;
    s = ts * r;
    double tc = 1.0 / 2432902008176640000.0;
    tc = tc * (-r2) + 1.0 / 6402373705728000.0;
    tc = tc * (-r2) + 1.0 / 20922789888000.0;
    tc = tc * (-r2) + 1.0 / 87178291200.0;
    tc = tc * (-r2) + 1.0 / 479001600.0;
    tc = tc * (-r2) + 1.0 / 3628800.0;
    tc = tc * (-r2) + 1.0 / 40320.0;
    tc = tc * (-r2) + 1.0 / 720.0;
    tc = tc * (-r2) + 1.0 / 24.0;
    tc = tc * (-r2) + 1.0 / 2.0;
    tc = tc * (-r2) + 1.0;
    c = tc;
}
DI void ph_prologue(const Args& a, const Ctx& C) {
    unsigned char* ws = a.ws;
    LAS float* scr = (LAS float*)(C.lds + C.wave * 16640);
    const int gw = C.bx * NWAVES + C.wave, NGW = C.G * NWAVES;
    constexpr int I_AIN = 32 * 64, I_AOUT = 32 * 32, I_FIN = 32 * (DFF2 / 64), I_BIN = 32 * (NBP / 64), I_FIN1B = I_FIN / 2;
    constexpr int NITEMS = I_AIN + I_AOUT + I_FIN + I_BIN + I_FIN1B;
    for (int it = gw; it < NITEMS; it += NGW) {
        int r = it;
        if (r < I_AIN) { p0_transpose_item(a.in[8], a.in[7], 2048, 4096, 4096, (bf16*)(ws + WS_WAIN), scr, r, C.lane); continue; } r -= I_AIN;
        if (r < I_AOUT) { p0_transpose_item(a.in[12], nullptr, 2048, 2048, 2048, (bf16*)(ws + WS_WAOUT), scr, r, C.lane); continue; } r -= I_AOUT;
        if (r < I_FIN) { p0_transpose_item(a.in[19], a.in[18], 2048, DFF2, DFF2, (bf16*)(ws + WS_WFIN), scr, r, C.lane, true); continue; } r -= I_FIN;
        if (r < I_BIN) { p0_transpose_item(a.in[14], a.in[13], 2048, BPROJ, NBP, (bf16*)(ws + WS_WBIN), scr, r, C.lane); continue; } r -= I_BIN;
        p0_transpose_item(a.in[19] + (size_t)2048 * DFF2, a.in[18] + 2048, 2048, DFF2, DFF2, (bf16*)(ws + WS_WFIN) + (size_t)DFF2 * 2048, scr, I_FIN1B + r, C.lane, true);
    }
    bf16* XB = (bf16*)(ws + WS_XB); float* SS = (float*)(ws + WS_SS);
    for (int row = gw; row < R; row += NGW) {
        const float* src = row < RP ? a.in[0] + (size_t)row * 2048 : a.in[1] + (size_t)(row - RP) * 2048;
        const GAS f32x4* xr = (const GAS f32x4*)src + C.lane; float s = 0.f;
        GAS v2u* o8 = (GAS v2u*)(XB + (size_t)row * 2048) + C.lane;
#pragma unroll
        for (int j = 0; j < 8; ++j) { const f32x4 v = xr[64 * j]; s += (v[0] * v[0] + v[1] * v[1]) + (v[2] * v[2] + v[3] * v[3]); v2u w; w.x = pk2(v[0], v[1]); w.y = pk2(v[2], v[3]); o8[64 * j] = w; }
        s = wave_sum(s);
        if (C.lane < 32) SS[(size_t)row * 32 + C.lane] = C.lane == 0 ? s : 0.f;
        if (C.lane == 0) ((float*)(ws + WS_RSTD))[row] = 1.0f / sqrtf(s * (1.0f / 2048.0f) + EPS);
    }
    float* rope = (float*)(ws + WS_ROPE);
    for (int idx = C.bx * 512 + C.tid; idx < 2056 * 96; idx += C.G * 512) {
        const int pos = idx / 96, i = idx % 96;
        const float ex = i < 64 ? (float)i * (2.0f / 128.0f) : (float)(i - 64) * (2.0f / 64.0f);
        const float inv = exp2f(-ex * 13.287712379549449f);
        const double ang = (double)pos * (double)inv;
        const double k = __builtin_rint(ang * 0.15915494309189535);
        const double rr = ang - k * 6.283185307179586;
        double sn, cs; sincos_small(rr, sn, cs);
        rope[2 * idx] = (float)cs; rope[2 * idx + 1] = (float)sn;
    }
}

constexpr int FQ_FOUT = (DFF / 64) * 32, FQ_BO = 32 * 32, FQ_FIN1A = 32 * (DFF2 / 64) / 2;
DI void filler_pull(const Args& a, const Ctx& C, int q) {
    unsigned char* ws = a.ws; gu32* head = (gu32*)ws + CW_WQ + 64 * (8 + q);
    LAS float* scr = (LAS float*)(C.lds + C.wave * 16640);
    const int n = q == 1 ? FQ_BO + FQ_FIN1A : FQ_FOUT;
    for (;;) {
        int it = 0; if (C.lane == 0) it = (int)__hip_atomic_fetch_add(head, 1u, RLX_AGENT);
        it = __builtin_amdgcn_readfirstlane(it);
        if (it >= n) break;
        if (q == 0) p0_transpose_item(a.in[22], nullptr, DFF, 2048, 2048, (bf16*)(ws + WS_WFOUT), scr, it, C.lane);
        else if (q == 2) p0_transpose_item(a.in[22] + (size_t)DFF * 2048, nullptr, DFF, 2048, 2048, (bf16*)(ws + WS_WFOUT) + (size_t)2048 * DFF, scr, it, C.lane);
        else { if (it < FQ_BO) p0_transpose_item(a.in[17], nullptr, 2048, 2048, 2048, (bf16*)(ws + WS_WBO), scr, it, C.lane);
               else p0_transpose_item(a.in[19] + (size_t)2048 * DFF2, a.in[18] + 2048, 2048, DFF2, DFF2, (bf16*)(ws + WS_WFIN) + (size_t)DFF2 * 2048, scr, it - FQ_BO, C.lane, true); }
    }
}
DI float rstd32(const float* p) { const f32x4* q = (const f32x4*)p; f32x4 a = q[0];
#pragma unroll
    for (int i = 1; i < 8; ++i) a += q[i];
    return 1.0f / sqrtf(((a[0] + a[1]) + (a[2] + a[3])) * (1.0f / 2048.0f) + EPS); }
DI void ph_gate(const Args& a, const Ctx& C) {
    unsigned char* ws = a.ws;
    const bf16* V = (const bf16*)(ws + WS_V); const bf16* U = (const bf16*)(ws + WS_U); bf16* GT = (bf16*)(ws + WS_GT); const float* vss = (const float*)(ws + WS_VSS);
    const float* vgain = a.in[9]; const float* Ws = a.in[10]; const float* bs = a.in[11];
    LAS unsigned char* vt = C.lds;
    LAS float* rsv = (LAS float*)(C.lds + 36864);
    const int l15 = C.lane & 15, kq = C.lane >> 4;
    int gcur = -1; bf16x8 wf[4];
#pragma unroll
    for (int kk = 0; kk < 4; ++kk) wf[kk] = (bf16x8){0, 0, 0, 0, 0, 0, 0, 0};
    v4u vraw[4]; v2u ureg[8]; f32x4 ssr[8];
#define G_LOAD(u_) do { const int g_ = (u_) & 15, r0_ = ((u_) >> 4) * 128; \
        _Pragma("unroll") for (int it = 0; it < 2; ++it) { const int ix_ = C.wave + 8 * it, p_ = 16 * (ix_ & 3) + l15, c_ = 4 * (ix_ >> 2) + kq; \
            vraw[2 * it] = *(const v4u*)(V + (size_t)(r0_ + 2 * p_) * 2048 + g_ * 128 + c_ * 8); vraw[2 * it + 1] = *(const v4u*)(V + (size_t)(r0_ + 2 * p_ + 1) * 2048 + g_ * 128 + c_ * 8); } \
        if (C.tid < 128) { _Pragma("unroll") for (int q = 0; q < 8; ++q) ssr[q] = *(const f32x4*)(vss + (size_t)(r0_ + C.tid) * 32 + 4 * q); } \
        _Pragma("unroll") for (int db = 0; db < 8; ++db) ureg[db] = *(const v2u*)(U + (size_t)(r0_ + 16 * C.wave + l15) * 2048 + g_ * 128 + db * 16 + 4 * kq); } while (0)
    if (C.bx < 2048) G_LOAD(C.bx);
    for (int u = C.bx; u < 2048; u += C.G) {
        const int g = u & 15, chunk = u >> 4, r0 = chunk * 128;
        if (g != gcur) { gcur = g; const int t = 16 * C.wave + l15;
#pragma unroll
            for (int kk = 0; kk < 4; ++kk) { const int s0 = 32 * kk + 8 * kq; const float* wp = Ws + ((size_t)g * 128 + t) * 128 + s0;
                const f32x4 w0 = *(const f32x4*)wp, w1 = *(const f32x4*)(wp + 4); v4u o;
                o.x = pk2(s0 + 0 <= t ? w0[0] : 0.f, s0 + 1 <= t ? w0[1] : 0.f); o.y = pk2(s0 + 2 <= t ? w0[2] : 0.f, s0 + 3 <= t ? w0[3] : 0.f);
                o.z = pk2(s0 + 4 <= t ? w1[0] : 0.f, s0 + 5 <= t ? w1[1] : 0.f); o.w = pk2(s0 + 6 <= t ? w1[2] : 0.f, s0 + 7 <= t ? w1[3] : 0.f);
                wf[kk] = __builtin_bit_cast(bf16x8, o); } }
        if (C.tid < 128) { f32x4 a4 = ssr[0];
#pragma unroll
            for (int q = 1; q < 8; ++q) a4 += ssr[q];
            rsv[C.tid] = 1.0f / sqrtf(((a4[0] + a4[1]) + (a4[2] + a4[3])) * (1.0f / 2048.0f) + EPS); }
        __syncthreads();
#pragma unroll
        for (int it = 0; it < 2; ++it) { const int ix = C.wave + 8 * it, p = 16 * (ix & 3) + l15, c = 4 * (ix >> 2) + kq;
            const v4u ra = vraw[2 * it], rb = vraw[2 * it + 1]; const float rsa = rsv[2 * p], rsb = rsv[2 * p + 1];
            const f32x4 g0 = *(const f32x4*)(vgain + g * 128 + c * 8), g1 = *(const f32x4*)(vgain + g * 128 + c * 8 + 4);
            const float xa[8] = {bflo(ra.x) * g0[0], bfhi(ra.x) * g0[1], bflo(ra.y) * g0[2], bfhi(ra.y) * g0[3], bflo(ra.z) * g1[0], bfhi(ra.z) * g1[1], bflo(ra.w) * g1[2], bfhi(ra.w) * g1[3]};
            const float xb_[8] = {bflo(rb.x) * g0[0], bfhi(rb.x) * g0[1], bflo(rb.y) * g0[2], bfhi(rb.y) * g0[3], bflo(rb.z) * g1[0], bfhi(rb.z) * g1[1], bflo(rb.w) * g1[2], bfhi(rb.w) * g1[3]};
#pragma unroll
            for (int i = 0; i < 8; ++i) *(LAS unsigned*)(vt + (c * 8 + i) * 272 + p * 4) = pk2(xa[i] * rsa, xb_[i] * rsb); }
        v2u ucur[8];
#pragma unroll
        for (int db = 0; db < 8; ++db) ucur[db] = ureg[db];
        __syncthreads();
        if (u + C.G < 2048) G_LOAD(u + C.G);
        __builtin_amdgcn_sched_barrier(0);
        const int t = 16 * C.wave + l15, row = r0 + t; const float bias = bs[g * 128 + t];
#pragma unroll
        for (int db = 0; db < 8; ++db) { f32x4 acc = {0.f, 0.f, 0.f, 0.f};
#pragma unroll
            for (int kk = 0; kk < 4; ++kk) if (kk <= (C.wave >> 1)) { const bf16x8 av = *(const LAS bf16x8*)(vt + (db * 16 + l15) * 272 + (kk * 32 + kq * 8) * 2); acc = MFMA16(av, wf[kk], acc); }
            const size_t off = (size_t)row * 2048 + g * 128 + db * 16 + 4 * kq;
            const v2u uu = ucur[db]; v2u o;
            o.x = pk2(bflo(uu.x) * (acc[0] + bias), bfhi(uu.x) * (acc[1] + bias)); o.y = pk2(bflo(uu.y) * (acc[2] + bias), bfhi(uu.y) * (acc[3] + bias));
            *(v2u*)(GT + off) = o; }
        __syncthreads();
    }
#undef G_LOAD
    float* cvout = a.out + OFF_CV;
    for (int us = C.bx; us < 32; us += C.G) {
        const int r0 = RP + 32 * us;
        if (C.tid < 32) rsv[C.tid] = rstd32(vss + (size_t)(r0 + C.tid) * 32);
        __syncthreads();
#pragma unroll 1
        for (int it = 0; it < 2; ++it) { const int id = C.tid + 512 * it, bl = id >> 8, c = id & 255, col = c * 8, g = col >> 7;
            const f32x4 g0 = *(const f32x4*)(vgain + col), g1 = *(const f32x4*)(vgain + col + 4);
            float vn[8][8];
#pragma unroll
            for (int t = 0; t < 8; ++t) { const size_t off = (size_t)(r0 + 8 * bl + t) * 2048 + col; const v4u raw = *(const v4u*)(V + off); const float rs = rsv[8 * bl + t];
                vn[t][0] = bflo(raw.x) * rs * g0[0]; vn[t][1] = bfhi(raw.x) * rs * g0[1]; vn[t][2] = bflo(raw.y) * rs * g0[2]; vn[t][3] = bfhi(raw.y) * rs * g0[3];
                vn[t][4] = bflo(raw.z) * rs * g1[0]; vn[t][5] = bfhi(raw.z) * rs * g1[1]; vn[t][6] = bflo(raw.w) * rs * g1[2]; vn[t][7] = bfhi(raw.w) * rs * g1[3];
                float* co = cvout + (size_t)(32 * us + 8 * bl + t) * 2048 + col;
                *(f32x4*)co = (f32x4){vn[t][0], vn[t][1], vn[t][2], vn[t][3]}; *(f32x4*)(co + 4) = (f32x4){vn[t][4], vn[t][5], vn[t][6], vn[t][7]}; }
#pragma unroll
            for (int t = 0; t < 8; ++t) { float s[8]; const float bias = bs[g * 128 + t];
#pragma unroll
                for (int i = 0; i < 8; ++i) s[i] = bias;
#pragma unroll
                for (int sp = 0; sp <= t; ++sp) { const float wv = Ws[((size_t)g * 128 + t) * 128 + sp];
#pragma unroll
                    for (int i = 0; i < 8; ++i) s[i] += wv * vn[sp][i]; }
                const size_t off = (size_t)(r0 + 8 * bl + t) * 2048 + col; const v4u uu = *(const v4u*)(U + off); v4u o;
                o.x = pk2(bflo(uu.x) * s[0], bfhi(uu.x) * s[1]); o.y = pk2(bflo(uu.y) * s[2], bfhi(uu.y) * s[3]); o.z = pk2(bflo(uu.z) * s[4], bfhi(uu.z) * s[5]); o.w = pk2(bflo(uu.w) * s[6], bfhi(uu.w) * s[7]);
                *(v4u*)(GT + off) = o; } }
        __syncthreads();
    }
}
DI void up8(const v4u& r, float (&x)[8]) { x[0] = bflo(r.x); x[1] = bfhi(r.x); x[2] = bflo(r.y); x[3] = bfhi(r.y); x[4] = bflo(r.z); x[5] = bfhi(r.z); x[6] = bflo(r.w); x[7] = bfhi(r.w); }
DI void ld8(const float* p, float (&x)[8]) { const f32x4 a = *(const f32x4*)p, b = *(const f32x4*)(p + 4); x[0] = a[0]; x[1] = a[1]; x[2] = a[2]; x[3] = a[3]; x[4] = b[0]; x[5] = b[1]; x[6] = b[2]; x[7] = b[3]; }
DI void ph_conv(const Args& a, const Ctx& C, int layer) {
    unsigned char* ws = a.ws;
    const bf16* AB = (const bf16*)(ws + WS_AB); bf16* HID = (bf16*)(ws + WS_HID);
    const float* cw = a.in[20] + (size_t)layer * 3 * DFF2; const float* cb = a.in[21] + (size_t)layer * DFF2; const float* st = a.in[5] + (size_t)layer * 128 * 2 * DFF2;
    constexpr int NCC = DFF / 8, NBLK = 128 + 64;
    for (int item = C.bx * 512 + C.tid; item < NBLK * NCC; item += C.G * 512) {
        const int blk = item / NCC, cc = item % NCC, col = cc * 8;
        const int r0 = blk < 128 ? RP + 8 * blk : 256 * (blk - 128), nrows = blk < 128 ? 8 : 2;
        float w0g[8], w1g[8], w2g[8], bg[8], w0u[8], w1u[8], w2u[8], bu[8];
        ld8(cw + col, w0g); ld8(cw + DFF2 + col, w1g); ld8(cw + 2 * DFF2 + col, w2g); ld8(cb + col, bg);
        ld8(cw + DFF + col, w0u); ld8(cw + DFF2 + DFF + col, w1u); ld8(cw + 2 * DFF2 + DFF + col, w2u); ld8(cb + DFF + col, bu);
        float g1[8], g2[8], u1[8], u2[8];
#pragma unroll
        for (int i = 0; i < 8; ++i) { g1[i] = 0.f; g2[i] = 0.f; u1[i] = 0.f; u2[i] = 0.f; }
        if (r0 < RP && (r0 & 2047) != 0) {
            up8(*(const v4u*)(AB + (size_t)(r0 - 1) * DFF2 + col), g1); up8(*(const v4u*)(AB + (size_t)(r0 - 2) * DFF2 + col), g2);
            up8(*(const v4u*)(AB + (size_t)(r0 - 1) * DFF2 + DFF + col), u1); up8(*(const v4u*)(AB + (size_t)(r0 - 2) * DFF2 + DFF + col), u2); }
#pragma unroll 1
        for (int r4 = 0; r4 < nrows; r4 += 4) {
            v4u ga[4], ua[4];
#pragma unroll
            for (int q = 0; q < 4; ++q) { const int rq = r0 + (r4 + q < nrows ? r4 + q : nrows - 1); ga[q] = *(const v4u*)(AB + (size_t)rq * DFF2 + col); ua[q] = *(const v4u*)(AB + (size_t)rq * DFF2 + DFF + col); }
            if (r0 >= RP && (r4 & 7) == 0) { const int b = (r0 + r4 - RP) >> 3;
                ld8(st + (size_t)(b * 2 + 0) * DFF2 + col, g2); ld8(st + (size_t)(b * 2 + 1) * DFF2 + col, g1);
                ld8(st + (size_t)(b * 2 + 0) * DFF2 + DFF + col, u2); ld8(st + (size_t)(b * 2 + 1) * DFF2 + DFF + col, u1); }
#pragma unroll
            for (int q = 0; q < 4; ++q) { const int row = r0 + r4 + q;
                float g0[8], u0[8]; up8(ga[q], g0); up8(ua[q], u0);
                float h[8];
#pragma unroll
                for (int i = 0; i < 8; ++i) { const float cg = bg[i] + w0g[i] * g2[i] + w1g[i] * g1[i] + w2g[i] * g0[i], cu = bu[i] + w0u[i] * u2[i] + w1u[i] * u1[i] + w2u[i] * u0[i];
                    h[i] = cg * __builtin_amdgcn_rcpf(1.0f + fexp2(-1.4426950408889634f * cg)) * cu; g2[i] = g1[i]; g1[i] = g0[i]; u2[i] = u1[i]; u1[i] = u0[i]; }
                v4u o; o.x = pk2(h[0], h[1]); o.y = pk2(h[2], h[3]); o.z = pk2(h[4], h[5]); o.w = pk2(h[6], h[7]);
                if (r4 + q < nrows) *(v4u*)(HID + (size_t)row * DFF + col) = o; }
        }
    }
}
DI void ph_qkrope(const Args& a, const Ctx& C) {
    unsigned char* ws = a.ws;
    const bf16* P = (const bf16*)(ws + WS_P); const float* rope = (const float*)(ws + WS_ROPE);
    bf16* Q = (bf16*)(ws + WS_Q); bf16* KB = (bf16*)(ws + WS_KB); bf16* VB = (bf16*)(ws + WS_VB); bf16* IQ = (bf16*)(ws + WS_IQ); bf16* IK = (bf16*)(ws + WS_IK); float* IW = (float*)(ws + WS_IW);
    const int gw = C.bx * NWAVES + C.wave, NGW = C.G * NWAVES, lane = C.lane;
    const int sub = lane & 15, hsel = lane >> 4, sub8 = lane & 7, hsel8 = lane >> 3;
    const f32x4 qga = *(const f32x4*)(a.in[15] + 4 * sub), qgb = *(const f32x4*)(a.in[15] + 64 + 4 * sub), kga = *(const f32x4*)(a.in[16] + 4 * sub), kgb = *(const f32x4*)(a.in[16] + 64 + 4 * sub);
    struct QkRow { v2u qa[4], qb[4], ia[2], ib[2], ka, kb, ka2, kb2; v4u vraw; float wv; f32x4 t0, t1, u0, u1; };
    auto load_row = [&](int row, QkRow& L) __attribute__((always_inline)) {
        const bf16* p = P + (size_t)row * NBP;
        const int pos = row < RP ? (row & 2047) : 2048 + ((row - RP) & 7);
        const float* rt = rope + (size_t)pos * 192;
#pragma unroll
        for (int it = 0; it < 4; ++it) { L.qa[it] = *(const v2u*)(p + (4 * it + hsel) * 128 + 4 * sub); L.qb[it] = *(const v2u*)(p + (4 * it + hsel) * 128 + 64 + 4 * sub); }
        L.ka = *(const v2u*)(p + 2048 + hsel * 128 + 4 * sub); L.kb = *(const v2u*)(p + 2048 + hsel * 128 + 64 + 4 * sub);
        L.vraw = *(const v4u*)(p + 2560 + lane * 8);
#pragma unroll
        for (int it = 0; it < 2; ++it) { L.ia[it] = *(const v2u*)(p + 3072 + (8 * it + hsel8) * 64 + 4 * sub8); L.ib[it] = *(const v2u*)(p + 3072 + (8 * it + hsel8) * 64 + 32 + 4 * sub8); }
        L.ka2 = (v2u){0u, 0u}; L.kb2 = (v2u){0u, 0u}; if (lane < 8) { L.ka2 = *(const v2u*)(p + 4096 + 4 * sub8); L.kb2 = *(const v2u*)(p + 4096 + 32 + 4 * sub8); }
        L.wv = 0.f; if (lane < 16) L.wv = bf2f(p[4160 + lane]);
        L.t0 = *(const f32x4*)(rt + 8 * sub); L.t1 = *(const f32x4*)(rt + 8 * sub + 4);
        L.u0 = *(const f32x4*)(rt + 128 + 8 * sub8); L.u1 = *(const f32x4*)(rt + 128 + 8 * sub8 + 4);
    };
    auto finish_row = [&](int row, const QkRow& L) __attribute__((always_inline)) {
        float* kout = row < RP ? a.out + OFF_KP + (size_t)row * 512 : a.out + OFF_KS + (size_t)(row - RP) * 512;
        float* vout = row < RP ? a.out + OFF_VP + (size_t)row * 512 : a.out + OFF_VS + (size_t)(row - RP) * 512;
        float* ikout = row < RP ? a.out + OFF_IKP + (size_t)row * 64 : a.out + OFF_IKS + (size_t)(row - RP) * 64;
        const v2u (&qa)[4] = L.qa; const v2u (&qb)[4] = L.qb; const v2u (&ia)[2] = L.ia; const v2u (&ib)[2] = L.ib;
        const v2u ka = L.ka, kb = L.kb, ka2 = L.ka2, kb2 = L.kb2; const v4u vraw = L.vraw; const float wv = L.wv; const f32x4 t0 = L.t0, t1 = L.t1, u0 = L.u0, u1 = L.u1;
        const float cs[4] = {t0[0], t0[2], t1[0], t1[2]}, sn[4] = {t0[1], t0[3], t1[1], t1[3]};
        const float cs8[4] = {u0[0], u0[2], u1[0], u1[2]}, sn8[4] = {u0[1], u0[3], u1[1], u1[3]};
#pragma unroll
        for (int it = 0; it < 4; ++it) {
            const float x1[4] = {bflo(qa[it].x), bfhi(qa[it].x), bflo(qa[it].y), bfhi(qa[it].y)}, x2[4] = {bflo(qb[it].x), bfhi(qb[it].x), bflo(qb[it].y), bfhi(qb[it].y)};
            float ss = 0.f;
#pragma unroll
            for (int e = 0; e < 4; ++e) ss += x1[e] * x1[e] + x2[e] * x2[e];
            ss += __shfl_xor(ss, 1); ss += __shfl_xor(ss, 2); ss += __shfl_xor(ss, 4); ss += __shfl_xor(ss, 8);
            const float rs = QSCALE / sqrtf(ss * (1.0f / 128.0f) + EPS);
            float o1[4], o2[4];
#pragma unroll
            for (int e = 0; e < 4; ++e) { const float y1 = x1[e] * rs * qga[e], y2 = x2[e] * rs * qgb[e]; o1[e] = y1 * cs[e] - y2 * sn[e]; o2[e] = y2 * cs[e] + y1 * sn[e]; }
            bf16* qd = Q + (size_t)row * 2048 + (4 * it + hsel) * 128 + 4 * sub;
            *(v2u*)qd = (v2u){pk2(o1[0], o1[1]), pk2(o1[2], o1[3])}; *(v2u*)(qd + 64) = (v2u){pk2(o2[0], o2[1]), pk2(o2[2], o2[3])};
        }
        { const float x1[4] = {bflo(ka.x), bfhi(ka.x), bflo(ka.y), bfhi(ka.y)}, x2[4] = {bflo(kb.x), bfhi(kb.x), bflo(kb.y), bfhi(kb.y)};
          float ss = 0.f;
#pragma unroll
          for (int e = 0; e < 4; ++e) ss += x1[e] * x1[e] + x2[e] * x2[e];
          ss += __shfl_xor(ss, 1); ss += __shfl_xor(ss, 2); ss += __shfl_xor(ss, 4); ss += __shfl_xor(ss, 8);
          const float rs = 1.0f / sqrtf(ss * (1.0f / 128.0f) + EPS);
          f32x4 o1, o2;
#pragma unroll
          for (int e = 0; e < 4; ++e) { const float y1 = x1[e] * rs * kga[e], y2 = x2[e] * rs * kgb[e]; o1[e] = y1 * cs[e] - y2 * sn[e]; o2[e] = y2 * cs[e] + y1 * sn[e]; }
          bf16* kd = KB + (size_t)row * 512 + hsel * 128 + 4 * sub;
          *(v2u*)kd = (v2u){pk2(o1[0], o1[1]), pk2(o1[2], o1[3])}; *(v2u*)(kd + 64) = (v2u){pk2(o2[0], o2[1]), pk2(o2[2], o2[3])};
          __builtin_nontemporal_store(o1, (f32x4*)(kout + hsel * 128 + 4 * sub)); __builtin_nontemporal_store(o2, (f32x4*)(kout + hsel * 128 + 64 + 4 * sub)); }
        { *(v4u*)(VB + (size_t)row * 512 + lane * 8) = vraw; float x[8]; up8(vraw, x);
          __builtin_nontemporal_store((f32x4){x[0], x[1], x[2], x[3]}, (f32x4*)(vout + lane * 8)); __builtin_nontemporal_store((f32x4){x[4], x[5], x[6], x[7]}, (f32x4*)(vout + lane * 8 + 4)); }
#pragma unroll
        for (int it = 0; it < 2; ++it) {
            const float x1[4] = {bflo(ia[it].x), bfhi(ia[it].x), bflo(ia[it].y), bfhi(ia[it].y)}, x2[4] = {bflo(ib[it].x), bfhi(ib[it].x), bflo(ib[it].y), bfhi(ib[it].y)};
            float o1[4], o2[4];
#pragma unroll
            for (int e = 0; e < 4; ++e) { o1[e] = x1[e] * cs8[e] - x2[e] * sn8[e]; o2[e] = x2[e] * cs8[e] + x1[e] * sn8[e]; }
            bf16* qd = IQ + (size_t)row * 1024 + (8 * it + hsel8) * 64 + 4 * sub8;
            *(v2u*)qd = (v2u){pk2(o1[0], o1[1]), pk2(o1[2], o1[3])}; *(v2u*)(qd + 32) = (v2u){pk2(o2[0], o2[1]), pk2(o2[2], o2[3])};
        }
        if (lane < 8) {
            const float x1[4] = {bflo(ka2.x), bfhi(ka2.x), bflo(ka2.y), bfhi(ka2.y)}, x2[4] = {bflo(kb2.x), bfhi(kb2.x), bflo(kb2.y), bfhi(kb2.y)};
            f32x4 o1, o2;
#pragma unroll
            for (int e = 0; e < 4; ++e) { o1[e] = x1[e] * cs8[e] - x2[e] * sn8[e]; o2[e] = x2[e] * cs8[e] + x1[e] * sn8[e]; }
            bf16* kd = IK + (size_t)row * 64 + 4 * sub8;
            *(v2u*)kd = (v2u){pk2(o1[0], o1[1]), pk2(o1[2], o1[3])}; *(v2u*)(kd + 32) = (v2u){pk2(o2[0], o2[1]), pk2(o2[2], o2[3])};
            *(f32x4*)(ikout + 4 * sub8) = o1; *(f32x4*)(ikout + 32 + 4 * sub8) = o2;
        }
        if (lane < 16) IW[(size_t)row * 16 + lane] = wv * 0.03125f;
    };
    { QkRow A, B;
      if (gw < R) load_row(gw, A);
      for (int row = gw; row < R; row += 2 * NGW) { const int r1 = row + NGW, r2 = row + 2 * NGW;
          if (r1 < R) load_row(r1, B);
          __builtin_amdgcn_sched_barrier(0);
          finish_row(row, A);
          if (r1 < R) { if (r2 < R) load_row(r2, A);
              __builtin_amdgcn_sched_barrier(0);
              finish_row(r1, B); } } }
}
DI int wq_next(gu32* head, volatile LAS int* slot, int tid) {
    __syncthreads();
    if (tid == 0) *slot = (int)__hip_atomic_fetch_add(head, 1u, RLX_AGENT);
    __syncthreads();
    return __builtin_amdgcn_readfirstlane(*slot);
}
DI void idx_prompt_unit(const Args& a, const Ctx& C, int b, int qb, int st_lo, int st_hi) {
    unsigned char* ws = a.ws;
    const bf16* IQ = (const bf16*)(ws + WS_IQ); const bf16* IK = (const bf16*)(ws + WS_IK); const float* IW = (const float*)(ws + WS_IW); float* SC = (float*)(ws + WS_SC);
    LAS unsigned char* iql = C.lds;
    { const bf16* src = IQ + (size_t)(b * 2048 + qb * 64) * 1024;
#pragma unroll 4
      for (int i = 0; i < 16; ++i) { const int id = C.tid + 512 * i, row = id >> 7, ch = id & 127; *(LAS v4u*)(iql + row * 2064 + ch * 16) = *(const v4u*)(src + (size_t)row * 1024 + ch * 8); } }
    __syncthreads();
    const int qg = C.wave & 1, kg = C.wave >> 1, r = C.lane & 31, hh = C.lane >> 5;
    const int qrow = b * 2048 + qb * 64 + qg * 32 + r;
    const float* wrow = IW + (size_t)qrow * 16;
    for (int st = st_lo; st < st_hi; ++st) {
        const int s0 = st * 256 + kg * 64;
        if (s0 <= qb * 64 + 63) {
            bf16x8 ka[2][4];
#pragma unroll
            for (int sb = 0; sb < 2; ++sb)
#pragma unroll
                for (int kk = 0; kk < 4; ++kk) ka[sb][kk] = *(const bf16x8*)(IK + (size_t)(b * 2048 + s0 + sb * 32 + r) * 64 + kk * 16 + hh * 8);
            f32x16 acc0, acc1;
#pragma unroll
            for (int e = 0; e < 16; ++e) { acc0[e] = 0.f; acc1[e] = 0.f; }
#pragma unroll 1
            for (int h = 0; h < 16; h += 2) {
                const float wh0 = wrow[h], wh1 = wrow[h + 1];
                bf16x8 qf0[4], qf1[4];
#pragma unroll
                for (int kk = 0; kk < 4; ++kk) { qf0[kk] = *(const LAS bf16x8*)(iql + (qg * 32 + r) * 2064 + h * 128 + kk * 32 + hh * 16); qf1[kk] = *(const LAS bf16x8*)(iql + (qg * 32 + r) * 2064 + (h + 1) * 128 + kk * 32 + hh * 16); }
                f32x16 c0, c1, d0, d1;
#pragma unroll
                for (int e = 0; e < 16; ++e) { c0[e] = 0.f; c1[e] = 0.f; d0[e] = 0.f; d1[e] = 0.f; }
#pragma unroll
                for (int kk = 0; kk < 4; ++kk) { c0 = MFMA32(ka[0][kk], qf0[kk], c0); c1 = MFMA32(ka[1][kk], qf0[kk], c1); }
#pragma unroll
                for (int kk = 0; kk < 4; ++kk) { d0 = MFMA32(ka[0][kk], qf1[kk], d0); d1 = MFMA32(ka[1][kk], qf1[kk], d1); }
#pragma unroll
                for (int e = 0; e < 16; ++e) { acc0[e] += wh0 * fmaxf(c0[e], 0.f); acc1[e] += wh0 * fmaxf(c1[e], 0.f); }
#pragma unroll
                for (int e = 0; e < 16; ++e) { acc0[e] += wh1 * fmaxf(d0[e], 0.f); acc1[e] += wh1 * fmaxf(d1[e], 0.f); }
            }
            float* dst = SC + (size_t)qrow * 2048 + s0 + 4 * hh;
#pragma unroll
            for (int rg = 0; rg < 4; ++rg) { *(f32x4*)(dst + 8 * rg) = (f32x4){acc0[4 * rg], acc0[4 * rg + 1], acc0[4 * rg + 2], acc0[4 * rg + 3]};
                                             *(f32x4*)(dst + 32 + 8 * rg) = (f32x4){acc1[4 * rg], acc1[4 * rg + 1], acc1[4 * rg + 2], acc1[4 * rg + 3]}; }
        }
    }
}
DI void idx_sample_unit(const Args& a, const Ctx& C, int b) {
    unsigned char* ws = a.ws;
    const bf16* IQ = (const bf16*)(ws + WS_IQ); const bf16* IK = (const bf16*)(ws + WS_IK); const float* IW = (const float*)(ws + WS_IW); float* SCS = (float*)(ws + WS_SCS);
    const float* cik = a.in[4]; const int* pt = (const int*)a.in[6] + b * 16;
    const int r = C.lane & 31, hh = C.lane >> 5;
    bf16x8 qa[4][4];
#pragma unroll
    for (int blk = 0; blk < 4; ++blk)
#pragma unroll
        for (int kk = 0; kk < 4; ++kk) qa[blk][kk] = *(const bf16x8*)(IQ + (size_t)(RP + 8 * b + 2 * blk + (r >> 4)) * 1024 + (r & 15) * 64 + kk * 16 + hh * 8);
    for (int kb = C.wave; kb < 65; kb += 8) {
        bf16x8 kf[4];
        if (kb < 64) { const int s = 32 * kb + r; const float* kp = cik + ((size_t)pt[s >> 7] * 128 + (s & 127)) * 64 + hh * 8;
#pragma unroll
            for (int kk = 0; kk < 4; ++kk) { const f32x4 x0 = *(const f32x4*)(kp + kk * 16), x1 = *(const f32x4*)(kp + kk * 16 + 4); v4u o; o.x = pk2(x0[0], x0[1]); o.y = pk2(x0[2], x0[3]); o.z = pk2(x1[0], x1[1]); o.w = pk2(x1[2], x1[3]); kf[kk] = __builtin_bit_cast(bf16x8, o); } }
        else {
#pragma unroll
            for (int kk = 0; kk < 4; ++kk) { v4u o = {0u, 0u, 0u, 0u}; if (r < 8) o = *(const v4u*)(IK + (size_t)(RP + 8 * b + r) * 64 + kk * 16 + hh * 8); kf[kk] = __builtin_bit_cast(bf16x8, o); } }
#pragma unroll
        for (int blk = 0; blk < 4; ++blk) {
            f32x16 c;
#pragma unroll
            for (int e = 0; e < 16; ++e) c[e] = 0.f;
#pragma unroll
            for (int kk = 0; kk < 4; ++kk) c = MFMA32(qa[blk][kk], kf[kk], c);
            float p0 = 0.f, p1 = 0.f;
            const float* w0p = IW + (size_t)(RP + 8 * b + 2 * blk) * 16 + 4 * hh; const float* w1p = w0p + 16;
            const f32x4 w00 = *(const f32x4*)w0p, w01 = *(const f32x4*)(w0p + 8), w10 = *(const f32x4*)w1p, w11 = *(const f32x4*)(w1p + 8);
#pragma unroll
            for (int j = 0; j < 4; ++j) { p0 += w00[j] * fmaxf(c[j], 0.f) + w01[j] * fmaxf(c[4 + j], 0.f); p1 += w10[j] * fmaxf(c[8 + j], 0.f) + w11[j] * fmaxf(c[12 + j], 0.f); }
            p0 += __shfl_xor(p0, 32); p1 += __shfl_xor(p1, 32);
            SCS[(size_t)(8 * b + 2 * blk + hh) * 2112 + 32 * kb + r] = hh ? p1 : p0;
        }
    }
}
DI void ph_index(const Args& a, const Ctx& C) {
    gu32* head = (gu32*)a.ws + CW_WQ; volatile LAS int* slot = (volatile LAS int*)(C.lds + MISC_OFF + 64);
    for (;;) {
        const int u = wq_next(head, slot, C.tid);
        if (u >= 128 + 640) break;
        if (u < 128) idx_sample_unit(a, C, u);
        else {
            const int v = u - 128, b = v & 7, k = v >> 3; int qb, c;
            if (k < 32) { qb = 31 - (k >> 2); c = k & 3; } else if (k < 56) { const int k2 = k - 32; qb = 23 - k2 / 3; c = k2 % 3; }
            else if (k < 72) { const int k3 = k - 56; qb = 15 - (k3 >> 1); c = k3 & 1; } else { qb = 79 - k; c = 0; }
            const int nsteps = (qb * 64 + 64 + 255) >> 8, lo = 2 * c, hi = lo + 2 < nsteps ? lo + 2 : nsteps;
            idx_prompt_unit(a, C, b, qb, lo, hi); }
    }
}
DI unsigned ordkey(float f) { const unsigned b = __float_as_uint(f); return (b & 0x80000000u) ? ~b : (b | 0x80000000u); }
template <int NS> DI void load_row(const float* sc, float (&f)[NS], int lane) {
#pragma unroll
    for (int j = 0; j < NS; ++j) f[j] = sc[64 * j + lane];
}
template <int NS> DI void select_row(const float (&f)[NS], int n_adm, unsigned long long* mrow, int lane, LAS unsigned* hist) {
    unsigned T = 1u;
    if (n_adm > 256) {
        float lo = 3.0e38f, hi = -3.0e38f;
#pragma unroll
        for (int j = 0; j < NS; ++j) { const bool v = 64 * j + lane < n_adm; lo = v ? fminf(lo, f[j]) : lo; hi = v ? fmaxf(hi, f[j]) : hi; }
#pragma unroll
        for (int o = 1; o < 64; o <<= 1) { lo = fminf(lo, __shfl_xor(lo, o)); hi = fmaxf(hi, __shfl_xor(hi, o)); }
        if (hi > lo) {
            const float scale = 1023.5f / (hi - lo);
#pragma unroll
            for (int q = 0; q < 4; ++q) *(LAS v4u*)(hist + 16 * lane + 4 * q) = (v4u){0u, 0u, 0u, 0u};
            if (lane == 0) hist[1024] = 0u;
            asm volatile("s_waitcnt lgkmcnt(0)" ::: "memory");
#pragma unroll
            for (int j = 0; j < NS; ++j) if (64 * j + lane < n_adm) { int bn = (int)((f[j] - lo) * scale); bn = bn > 1023 ? 1023 : bn; __hip_atomic_fetch_add(hist + bn, 1u, __ATOMIC_RELAXED, __HIP_MEMORY_SCOPE_WAVEFRONT); }
            asm volatile("s_waitcnt lgkmcnt(0)" ::: "memory");
            unsigned c[16];
#pragma unroll
            for (int q = 0; q < 4; ++q) { const v4u t = *(const LAS v4u*)(hist + 16 * lane + 4 * q); c[4 * q] = t.x; c[4 * q + 1] = t.y; c[4 * q + 2] = t.z; c[4 * q + 3] = t.w; }
            unsigned s = 0;
#pragma unroll
            for (int q = 0; q < 16; ++q) s += c[q];
            unsigned t = s;
#pragma unroll
            for (int o = 1; o < 64; o <<= 1) { const unsigned v = (unsigned)__shfl_down((int)t, o); t += (lane + o < 64) ? v : 0u; }
            const unsigned excl = t - s;
            int B = 0; unsigned above = 0;
            { unsigned run = excl; bool found = false;
#pragma unroll
              for (int q = 15; q >= 0; --q) { const unsigned nr = run + c[q]; if (!found && nr >= 256u) { found = true; B = 16 * lane + q; above = run; } run = nr; } }
            const unsigned long long own = __ballot(excl < 256u && t >= 256u);
            const int src = (int)__ffsll((long long)own) - 1;
            B = __builtin_amdgcn_readlane(B, src); above = (unsigned)__builtin_amdgcn_readlane((int)above, src);
            const unsigned need = 256u - above;
#pragma unroll
            for (int j = 0; j < NS; ++j) if (64 * j + lane < n_adm) { int bn = (int)((f[j] - lo) * scale); bn = bn > 1023 ? 1023 : bn;
                if (bn == B) { const unsigned idx = __hip_atomic_fetch_add(hist + 1024, 1u, __ATOMIC_RELAXED, __HIP_MEMORY_SCOPE_WAVEFRONT); if (idx < 64u) hist[1025 + idx] = ordkey(f[j]); } }
            asm volatile("s_waitcnt lgkmcnt(0)" ::: "memory");
            const unsigned nc = (unsigned)__builtin_amdgcn_readfirstlane((int)hist[1024]);
            bool done = false;
            if (nc <= 64u && need <= nc) {
                const unsigned ci = lane < (int)nc ? hist[1025 + lane] : 0u; unsigned gt = 0, ge = 0;
                for (unsigned k = 0; k < nc; ++k) { const unsigned ck = (unsigned)__builtin_amdgcn_readlane((int)ci, (int)k); gt += ck > ci ? 1u : 0u; ge += ck >= ci ? 1u : 0u; }
                const unsigned long long hit = __ballot(lane < (int)nc && gt < need && need <= ge);
                if (hit != 0ull) { T = (unsigned)__builtin_amdgcn_readlane((int)ci, (int)__ffsll((long long)hit) - 1); done = true; }
            }
            if (!done) {
                T = 0u;
#pragma unroll 1
                for (int bit = 31; bit >= 0; --bit) { const unsigned cand = T | (1u << bit); int cnt = 0;
#pragma unroll
                    for (int j = 0; j < NS; ++j) cnt += __popcll(__ballot(64 * j + lane < n_adm && ordkey(f[j]) >= cand));
                    if (cnt >= 256) T = cand;
                    if (cnt == 256) break; }
            }
        }
    }
    unsigned long long mine = 0ull;
#pragma unroll
    for (int j = 0; j < NS; ++j) { const unsigned long long bm = __ballot(64 * j + lane < n_adm && ordkey(f[j]) >= T); if (lane == j) mine = bm; }
    if (lane < 34) mrow[lane] = lane < NS ? mine : 0ull;
}
DI void ph_select(const Args& a, const Ctx& C) {
    unsigned char* ws = a.ws;
    const float* SC = (const float*)(ws + WS_SC); const float* SCS = (const float*)(ws + WS_SCS); unsigned long long* MASK = (unsigned long long*)(ws + WS_MASK);
    const int gw = C.bx * NWAVES + C.wave, NGW = C.G * NWAVES;
    LAS unsigned* hist = (LAS unsigned*)(C.lds + C.wave * 5120);
    if (gw < RP) {
        float fa[32], fb[32];
        load_row<32>(SC + (size_t)gw * 2048, fa, C.lane);
        for (int row = gw; row < RP; row += 2 * NGW) {
            const int r1 = row + NGW, r2 = row + 2 * NGW;
            if (r1 < RP) load_row<32>(SC + (size_t)r1 * 2048, fb, C.lane);
            __builtin_amdgcn_sched_barrier(0);
            select_row<32>(fa, (row & 2047) + 1, MASK + (size_t)row * 34, C.lane, hist);
            if (r1 < RP) {
                if (r2 < RP) load_row<32>(SC + (size_t)r2 * 2048, fa, C.lane);
                __builtin_amdgcn_sched_barrier(0);
                select_row<32>(fb, (r1 & 2047) + 1, MASK + (size_t)r1 * 34, C.lane, hist);
            }
        }
    }
    for (int row = RP + gw; row < R; row += NGW) { float fs[33]; load_row<33>(SCS + (size_t)(row - RP) * 2112, fs, C.lane);
        select_row<33>(fs, 2049 + ((row - RP) & 7), MASK + (size_t)row * 34, C.lane, hist); }
}
constexpr float NEG_BIG = -1.0e30f;
DI bf16x8 pack_p(const f32x16& x, int sp) {
    v4u o; o.x = pk2(x[8 * sp + 0], x[8 * sp + 1]); o.y = pk2(x[8 * sp + 2], x[8 * sp + 3]); o.z = pk2(x[8 * sp + 4], x[8 * sp + 5]); o.w = pk2(x[8 * sp + 6], x[8 * sp + 7]);
    return __builtin_bit_cast(bf16x8, o);
}
DI void mask_init(f32x16& s0, f32x16& s1, unsigned long long wq) {
    const unsigned wlo = (unsigned)wq, whi = (unsigned)(wq >> 32);
    int one = 1; asm volatile("" : "+s"(one));
#pragma unroll
    for (int e = 0; e < 16; ++e) { const int sh = (e & 3) + 8 * (e >> 2);
        const int t0 = __builtin_amdgcn_sbfe((int)wlo, sh, one), t1 = __builtin_amdgcn_sbfe((int)whi, sh, one);
        s0[e] = __builtin_bit_cast(float, ~t0 & (int)0xf149f2ca); s1[e] = __builtin_bit_cast(float, ~t1 & (int)0xf149f2ca); }
}
constexpr float M_INIT = -5.0e29f;
DI void softmax_tile(f32x16& s0, f32x16& s1, float& m, float& l, f32x16 (&o)[4]) {
    float mx = fmaxf(s0[0], s1[0]);
#pragma unroll
    for (int e = 1; e < 16; ++e) mx = fmaxf(mx, fmaxf(s0[e], s1[e]));
    mx = fmaxf(mx, __shfl_xor(mx, 32));
    const float mn = fmaxf(m, mx);
    if (__ballot(mn > m) != 0ull) { const float alpha = fexp2(m - mn); l *= alpha;
#pragma unroll
        for (int db = 0; db < 4; ++db)
#pragma unroll
            for (int e = 0; e < 16; ++e) o[db][e] *= alpha; }
    m = mn;
    float ls = 0.f;
#pragma unroll
    for (int e = 0; e < 16; ++e) { s0[e] = fexp2(s0[e] - mn); s1[e] = fexp2(s1[e] - mn); ls += s0[e] + s1[e]; }
    l += ls;
}
constexpr int KT_BYTES = 64 * 272, VT_BYTES = 128 * 144;
DI void attn_prompt_unit(const Args& a, const Ctx& C, int b, int kvh, int qb) {
    unsigned char* ws = a.ws;
    const bf16* Q = (const bf16*)(ws + WS_Q); const bf16* KB = (const bf16*)(ws + WS_KB); const bf16* VB = (const bf16*)(ws + WS_VB);
    const unsigned long long* MASK = (const unsigned long long*)(ws + WS_MASK); bf16* O = (bf16*)(ws + WS_O);
    const int hg = C.wave & 3, qh = C.wave >> 2, r = C.lane & 31, hh = C.lane >> 5, head = 4 * kvh + hg;
    const int qrow = b * 2048 + qb * 64 + qh * 32 + r;
    bf16x8 qf[8];
#pragma unroll
    for (int kk = 0; kk < 8; ++kk) qf[kk] = *(const bf16x8*)(Q + (size_t)qrow * 2048 + head * 128 + kk * 16 + hh * 8);
    f32x16 o[4];
#pragma unroll
    for (int db = 0; db < 4; ++db)
#pragma unroll
        for (int e = 0; e < 16; ++e) o[db][e] = 0.f;
    float m = M_INIT, l = 0.f;
    const unsigned long long* mrow = MASK + (size_t)qrow * 34;
    LAS unsigned char* kbuf = C.lds; LAS unsigned char* vbuf = C.lds + 2 * KT_BYTES;
    const int krow0 = C.tid >> 4, kch = C.tid & 15;
    const unsigned char* kgu = (const unsigned char*)(KB + (size_t)(b * 2048) * 512 + kvh * 128); const unsigned char* vgu = (const unsigned char*)(VB + (size_t)(b * 2048) * 512 + kvh * 128);
    const unsigned klo = (unsigned)(krow0 * 1024 + kch * 16), vlo = (unsigned)(krow0 * 2048 + kch * 16);
    v4u kr[2], vr[2];
#define LOADK(kt) do { const unsigned char* kp_ = kgu + (size_t)(kt) * 65536; kr[0] = *(const v4u*)(kp_ + klo); kr[1] = *(const v4u*)(kp_ + 32768 + klo); } while (0)
#define LOADV(kt) do { const unsigned char* vp_ = vgu + (size_t)(kt) * 65536; vr[0] = *(const v4u*)(vp_ + vlo); vr[1] = *(const v4u*)(vp_ + vlo + 1024); } while (0)
#define WRITEK(buf) do { *(LAS v4u*)(kbuf + (buf) * KT_BYTES + krow0 * 272 + kch * 16) = kr[0]; *(LAS v4u*)(kbuf + (buf) * KT_BYTES + (32 + krow0) * 272 + kch * 16) = kr[1]; } while (0)
#define WRITEV(buf) do { \
        LAS unsigned char* vb_ = vbuf + (buf) * VT_BYTES + vwo; \
        const unsigned a_[4] = {vr[0].x, vr[0].y, vr[0].z, vr[0].w}, b_[4] = {vr[1].x, vr[1].y, vr[1].z, vr[1].w}; \
        _Pragma("unroll") for (int i_ = 0; i_ < 4; ++i_) { *(LAS unsigned*)(vb_ + (2 * i_) * 144) = (a_[i_] & 0xffffu) | (b_[i_] << 16); *(LAS unsigned*)(vb_ + (2 * i_ + 1) * 144) = (a_[i_] >> 16) | (b_[i_] & 0xffff0000u); } } while (0)
#define QK_TILE(buf) do { const LAS unsigned char* kb_ = kbuf + (buf) * KT_BYTES + r * 272 + hh * 16; bf16x8 ka_[4][2]; \
        _Pragma("unroll") for (int kk = 0; kk < 3; ++kk) { ka_[kk][0] = *(const LAS bf16x8*)(kb_ + kk * 32); ka_[kk][1] = *(const LAS bf16x8*)(kb_ + 32 * 272 + kk * 32); } \
        _Pragma("unroll") for (int kk = 0; kk < 8; ++kk) { \
            if (kk + 3 < 8) { ka_[(kk + 3) & 3][0] = *(const LAS bf16x8*)(kb_ + (kk + 3) * 32); ka_[(kk + 3) & 3][1] = *(const LAS bf16x8*)(kb_ + 32 * 272 + (kk + 3) * 32); } \
            s0 = MFMA32(ka_[kk & 3][0], qf[kk], s0); s1 = MFMA32(ka_[kk & 3][1], qf[kk], s1); \
            __builtin_amdgcn_sched_barrier(0); } } while (0)
#define PV_TILE(vsel) do { const LAS unsigned char* vb_ = vbuf + (vsel) * VT_BYTES + r * 144 + hh * 16; bf16x8 va_[2][4]; \
        _Pragma("unroll") for (int db = 0; db < 4; ++db) va_[0][db] = *(const LAS bf16x8*)(vb_ + db * 32 * 144 + 16 * (0 ^ (2 * db))); \
        _Pragma("unroll") for (int ps = 0; ps < 4; ++ps) { \
            if (ps < 3) { _Pragma("unroll") for (int db = 0; db < 4; ++db) va_[(ps + 1) & 1][db] = *(const LAS bf16x8*)(vb_ + db * 32 * 144 + 16 * ((2 * (ps + 1)) ^ (2 * db))); } \
            const bf16x8 pf = pack_p(ps < 2 ? s0 : s1, ps & 1); \
            _Pragma("unroll") for (int db = 0; db < 4; ++db) o[db] = MFMA32(va_[ps & 1][db], pf, o[db]); \
            __builtin_amdgcn_sched_barrier(0); } } while (0)
#define VNEXT(v) ((v) == 2 ? 0 : (v) + 1)
    const int vwo = (kch * 8) * 144 + 16 * ((2 * (krow0 >> 3) + ((krow0 >> 1) & 1)) ^ (2 * (kch >> 2))) + 8 * ((krow0 >> 2) & 1) + 4 * (krow0 & 1);
#ifndef ATT_STAGGER
#define ATT_STAGGER 1
#endif
    const bool late = ATT_STAGGER && __builtin_amdgcn_readfirstlane(C.wave) >= 4;
    LOADK(0); LOADV(0); WRITEK(0); WRITEV(0);
    unsigned long long wnext = mrow[0];
    __syncthreads();
    asm volatile("; q fragments ready" :: "v"(qf[0]), "v"(qf[1]), "v"(qf[2]), "v"(qf[3]), "v"(qf[4]), "v"(qf[5]), "v"(qf[6]), "v"(qf[7]), "v"(wnext));
    f32x16 s0, s1;
    if (!late) {
        int vsel = 0;
        for (int kt = 0; kt <= qb; ++kt) {
            const unsigned long long wq = wnext >> (4 * hh);
            const int vn = VNEXT(vsel);
            if (kt < qb) { LOADK(kt + 1); LOADV(kt + 1); wnext = mrow[kt + 1]; }
            __builtin_amdgcn_sched_barrier(0);
            mask_init(s0, s1, wq);
            QK_TILE(kt & 1);
            softmax_tile(s0, s1, m, l, o);
            PV_TILE(vsel);
            if (kt < qb) { WRITEK((kt + 1) & 1); WRITEV(vn); }
            vsel = vn;
            __syncthreads();
        }
    } else {
        { const unsigned long long wq = wnext >> (4 * hh);
          if (0 < qb) { LOADK(1); LOADV(1); wnext = mrow[1]; }
          __builtin_amdgcn_sched_barrier(0);
          mask_init(s0, s1, wq);
          QK_TILE(0);
          if (0 < qb) { WRITEK(1); WRITEV(1); }
          __syncthreads(); }
        int vsel = 0;
        for (int kt = 1; kt <= qb; ++kt) {
            const unsigned long long wq = wnext >> (4 * hh);
            const int vc = VNEXT(vsel), vn = VNEXT(vc);
            if (kt < qb) { LOADK(kt + 1); LOADV(kt + 1); wnext = mrow[kt + 1]; }
            __builtin_amdgcn_sched_barrier(0);
            softmax_tile(s0, s1, m, l, o);
            PV_TILE(vsel);
            mask_init(s0, s1, wq);
            QK_TILE(kt & 1);
            if (kt < qb) { WRITEK((kt + 1) & 1); WRITEV(vn); }
            vsel = vc;
            __syncthreads();
        }
        softmax_tile(s0, s1, m, l, o);
        PV_TILE(vsel);
    }
#undef LOADK
#undef LOADV
#undef WRITEK
#undef WRITEV
#undef QK_TILE
#undef PV_TILE
#undef VNEXT
    l += __shfl_xor(l, 32); const float inv = 1.0f / l;
#pragma unroll
    for (int db = 0; db < 4; ++db)
#pragma unroll
        for (int rg = 0; rg < 4; ++rg) { v2u w; w.x = pk2(o[db][4 * rg] * inv, o[db][4 * rg + 1] * inv); w.y = pk2(o[db][4 * rg + 2] * inv, o[db][4 * rg + 3] * inv);
            *(v2u*)(O + (size_t)qrow * 2048 + head * 128 + 32 * db + 8 * rg + 4 * hh) = w; }
}
DI bf16x8 cvt8(const f32x4& x0, const f32x4& x1) { v4u o; o.x = pk2(x0[0], x0[1]); o.y = pk2(x0[2], x0[3]); o.z = pk2(x1[0], x1[1]); o.w = pk2(x1[2], x1[3]); return __builtin_bit_cast(bf16x8, o); }
DI void attn_sample_unit(const Args& a, const Ctx& C, int b, int kvh) {
    unsigned char* ws = a.ws;
    const bf16* Q = (const bf16*)(ws + WS_Q); const bf16* KB = (const bf16*)(ws + WS_KB); const bf16* VB = (const bf16*)(ws + WS_VB);
    const unsigned long long* MASK = (const unsigned long long*)(ws + WS_MASK); bf16* O = (bf16*)(ws + WS_O);
    const float* ck = a.in[2]; const float* cv = a.in[3]; const int* pt = (const int*)a.in[6] + b * 16;
    const int r = C.lane & 31, hh = C.lane >> 5, t = r & 7, head = 4 * kvh + (r >> 3), qrow = RP + 8 * b + t;
    const bf16* qp = Q + (size_t)qrow * 2048 + head * 128 + hh * 8;
    f32x16 o[4];
#pragma unroll
    for (int db = 0; db < 4; ++db)
#pragma unroll
        for (int e = 0; e < 16; ++e) o[db][e] = 0.f;
    float m = M_INIT, l = 0.f;
    const unsigned long long* mrow = MASK + (size_t)qrow * 34;
    const unsigned kvo = (unsigned)((r * 4 + kvh) * 128 + hh * 8);
    const unsigned vvo = (unsigned)((4 * hh * 4 + kvh) * 128 + r);
    f32x4 buf[2][8];
#define SA_ROWBASE(i) ((unsigned)__builtin_amdgcn_readfirstlane(pt[(C.wave + 8 * (i)) >> 1] * 128 + ((C.wave + 8 * (i)) & 1) * 64))
#define SA_LOADK(P, rb, g, um) do { const float* k0_ = ck + (size_t)(rb) * 512 + kvo + (g) * 32; const float* k1_ = k0_ + 32 * 512; const f32x4 z_ = {0.f, 0.f, 0.f, 0.f}; \
        buf[P][0] = z_; buf[P][1] = z_; buf[P][4] = z_; buf[P][5] = z_; buf[P][2] = z_; buf[P][3] = z_; buf[P][6] = z_; buf[P][7] = z_; \
        if (((um) >> r) & 1ull) { buf[P][0] = *(const f32x4*)(k0_); buf[P][1] = *(const f32x4*)(k0_ + 4); buf[P][4] = *(const f32x4*)(k0_ + 16); buf[P][5] = *(const f32x4*)(k0_ + 20); } \
        if (((um) >> (32 + r)) & 1ull) { buf[P][2] = *(const f32x4*)(k1_); buf[P][3] = *(const f32x4*)(k1_ + 4); buf[P][6] = *(const f32x4*)(k1_ + 16); buf[P][7] = *(const f32x4*)(k1_ + 20); } \
        } while (0)
#define SA_LOADV(P, rb, g, um) do { const float* v0_ = cv + (size_t)((rb) + 16 * (g)) * 512 + vvo; const unsigned vb_ = (unsigned)((um) >> (16 * (g) + 4 * hh)); \
        _Pragma("unroll") for (int j_ = 0; j_ < 8; ++j_) { const bool on_ = (vb_ >> (8 * (j_ >> 2) + (j_ & 3))) & 1u; \
            _Pragma("unroll") for (int db_ = 0; db_ < 4; ++db_) buf[P][2 * db_ + (j_ >> 2)][j_ & 3] = on_ ? v0_[(8 * (j_ >> 2) + (j_ & 3)) * 512 + 32 * db_] : 0.f; } } while (0)
#define SA_QK(P, g) do { const bf16x8 q0_ = *(const bf16x8*)(qp + (g) * 32), q1_ = *(const bf16x8*)(qp + (g) * 32 + 16); \
        s0 = MFMA32(cvt8(buf[P][0], buf[P][1]), q0_, s0); s1 = MFMA32(cvt8(buf[P][2], buf[P][3]), q0_, s1); \
        s0 = MFMA32(cvt8(buf[P][4], buf[P][5]), q1_, s0); s1 = MFMA32(cvt8(buf[P][6], buf[P][7]), q1_, s1); } while (0)
#define SA_PV(P, pf) do { _Pragma("unroll") for (int db_ = 0; db_ < 4; ++db_) o[db_] = MFMA32(cvt8(buf[P][2 * db_], buf[P][2 * db_ + 1]), pf, o[db_]); } while (0)
#define SA_SB() __builtin_amdgcn_sched_barrier(0)
#define SA_UNION(w) ({ unsigned long long u_ = (w); u_ |= __shfl_xor(u_, 1); u_ |= __shfl_xor(u_, 2); u_ |= __shfl_xor(u_, 4); u_; })
    unsigned rb = SA_ROWBASE(0);
    unsigned long long wcur = mrow[C.wave], um = SA_UNION(wcur);
    SA_LOADK(0, rb, 0, um); SA_SB();
#pragma unroll 1
    for (int i = 0; i < 4; ++i) {
        const unsigned rbn = SA_ROWBASE(i < 3 ? i + 1 : 3);
        const unsigned long long wq = wcur >> (4 * hh), wnx = mrow[C.wave + 8 * (i < 3 ? i + 1 : 3)];
        f32x16 s0, s1; mask_init(s0, s1, wq);
        SA_LOADK(1, rb, 1, um); SA_SB(); SA_QK(0, 0); SA_SB();
        SA_LOADK(0, rb, 2, um); SA_SB(); SA_QK(1, 1); SA_SB();
        SA_LOADK(1, rb, 3, um); SA_SB(); SA_QK(0, 2); SA_SB();
        SA_LOADV(0, rb, 0, um); SA_SB(); SA_QK(1, 3); SA_SB();
        softmax_tile(s0, s1, m, l, o);
        SA_LOADV(1, rb, 1, um); SA_SB(); { const bf16x8 pf = pack_p(s0, 0); SA_PV(0, pf); } SA_SB();
        SA_LOADV(0, rb, 2, um); SA_SB(); { const bf16x8 pf = pack_p(s0, 1); SA_PV(1, pf); } SA_SB();
        SA_LOADV(1, rb, 3, um); SA_SB(); { const bf16x8 pf = pack_p(s1, 0); SA_PV(0, pf); } SA_SB();
        const unsigned long long umn = SA_UNION(wnx);
        if (i < 3) SA_LOADK(0, rbn, 0, umn); SA_SB();
        { const bf16x8 pf = pack_p(s1, 1); SA_PV(1, pf); } SA_SB();
        rb = rbn; wcur = wnx; um = umn;
    }
#undef SA_UNION
#undef SA_ROWBASE
#undef SA_LOADK
#undef SA_LOADV
#undef SA_QK
#undef SA_PV
#undef SA_SB
    if (C.wave == 0) {
        const unsigned long long wq = mrow[32] >> (4 * hh);
        f32x16 s0, s1; mask_init(s0, s1, wq);
#pragma unroll
        for (int kk = 0; kk < 8; ++kk) { v4u kv = {0u, 0u, 0u, 0u}; if (r < 8) kv = *(const v4u*)(KB + (size_t)(RP + 8 * b + r) * 512 + kvh * 128 + kk * 16 + hh * 8);
            s0 = MFMA32(__builtin_bit_cast(bf16x8, kv), *(const bf16x8*)(qp + kk * 16), s0); }
        softmax_tile(s0, s1, m, l, o);
        const bf16x8 pf = pack_p(s0, 0);
#pragma unroll
        for (int db = 0; db < 4; ++db) { const bf16* vp = VB + (size_t)(RP + 8 * b + 4 * hh) * 512 + kvh * 128 + 32 * db + r;
            v4u av; av.x = (unsigned)vp[0] | ((unsigned)vp[512] << 16); av.y = (unsigned)vp[1024] | ((unsigned)vp[1536] << 16); av.z = 0u; av.w = 0u;
            o[db] = MFMA32(__builtin_bit_cast(bf16x8, av), pf, o[db]); }
    }
    l += __shfl_xor(l, 32);
    LAS float* ml = (LAS float*)C.lds;
    LAS float* ob = (LAS float*)(C.lds + 4096);
    if (hh == 0) { ml[(C.wave * 32 + r) * 2] = m; ml[(C.wave * 32 + r) * 2 + 1] = l; }
    __syncthreads();
    float M = M_INIT;
#pragma unroll
    for (int w = 0; w < 8; ++w) M = fmaxf(M, ml[(w * 32 + r) * 2]);
    float L = 0.f;
#pragma unroll
    for (int w = 0; w < 8; ++w) L += ml[(w * 32 + r) * 2 + 1] * fexp2(ml[(w * 32 + r) * 2] - M);
    { const float sc = fexp2(m - M);
#pragma unroll
      for (int db = 0; db < 4; ++db)
#pragma unroll
          for (int e = 0; e < 16; ++e) o[db][e] *= sc; }
#define OB_WRITE(slot) do { _Pragma("unroll") for (int db = 0; db < 4; ++db) _Pragma("unroll") for (int e = 0; e < 16; ++e) ob[(((slot) * 64 + db * 16 + e) << 6) + C.lane] = o[db][e]; } while (0)
#define OB_ADD(slot) do { _Pragma("unroll") for (int db = 0; db < 4; ++db) _Pragma("unroll") for (int e = 0; e < 16; ++e) o[db][e] += ob[(((slot) * 64 + db * 16 + e) << 6) + C.lane]; } while (0)
    if (C.wave >= 4) OB_WRITE(C.wave - 4);
    __syncthreads();
    if (C.wave < 4) OB_ADD(C.wave);
    __syncthreads();
    if (C.wave == 2 || C.wave == 3) OB_WRITE(C.wave - 2);
    __syncthreads();
    if (C.wave < 2) OB_ADD(C.wave);
    __syncthreads();
    if (C.wave == 1) OB_WRITE(0);
    __syncthreads();
    if (C.wave == 0) { OB_ADD(0); const float inv = 1.0f / L;
#pragma unroll
        for (int db = 0; db < 4; ++db)
#pragma unroll
            for (int rg = 0; rg < 4; ++rg) { v2u w; w.x = pk2(o[db][4 * rg] * inv, o[db][4 * rg + 1] * inv); w.y = pk2(o[db][4 * rg + 2] * inv, o[db][4 * rg + 3] * inv);
                *(v2u*)(O + (size_t)qrow * 2048 + head * 128 + 32 * db + 8 * rg + 4 * hh) = w; } }
#undef OB_WRITE
#undef OB_ADD
}
DI void ph_attn(const Args& a, const Ctx& C) {
    volatile LAS int* slot = (volatile LAS int*)(C.lds + MISC_OFF + 64);
    { gu32* head = (gu32*)a.ws + CW_WQ + 64;
      for (;;) { const int u = wq_next(head, slot, C.tid); if (u >= 512) break; attn_sample_unit(a, C, u >> 2, u & 3); } }
#if defined(DBG_MIDSTAMP)
    if (C.bx == 0 && C.tid == 0) ((volatile LAS unsigned long long*)(C.lds + MISC_OFF + 128))[17] = wall_clock64();
#endif
    { gu32* head = (gu32*)a.ws + CW_WQ + 128;
      for (;;) { const int v = wq_next(head, slot, C.tid); if (v >= 1024) break; attn_prompt_unit(a, C, (v & 31) >> 2, v & 3, 31 - (v >> 5)); } }
}
template <int S> DI f32x4 slab_sum(const float* slab_, int row, int N, int col) { v2u v[S];
    const unsigned short* slab = (const unsigned short*)slab_;
#pragma unroll
    for (int s = 0; s < S; ++s) v[s] = *(const v2u*)(slab + ((size_t)s * 1024 + row) * N + col);
    f32x4 a = {0.f, 0.f, 0.f, 0.f};
#pragma unroll
    for (int s = 0; s < S; ++s) { a[0] += __uint_as_float(v[s].x << 16); a[1] += __uint_as_float(v[s].x & 0xffff0000u); a[2] += __uint_as_float(v[s].y << 16); a[3] += __uint_as_float(v[s].y & 0xffff0000u); }
    return a; }
DI float grp16_sum(float q) { q += __shfl_xor(q, 1); q += __shfl_xor(q, 2); q += __shfl_xor(q, 4); q += __shfl_xor(q, 8); return q; }
template <int S> DI void ph_reduce_resid(const Args& a, const Ctx& C, const float* base, float* out) {
    unsigned char* ws = a.ws; const float* slab = (const float*)(ws + WS_SLAB); bf16* XB = (bf16*)(ws + WS_XB) + (size_t)RP * 2048; float* SS = (float*)(ws + WS_SS) + (size_t)RP * 32;
    const int gw = C.bx * NWAVES + C.wave, NGW = C.G * NWAVES, lane = C.lane;
    float* RSTD = (float*)(ws + WS_RSTD);
    for (int row = gw; row < RS; row += NGW) { float tot = 0.f;
#pragma unroll
        for (int j = 0; j < 8; ++j) { const int col = 4 * lane + 256 * j; const f32x4 o = slab_sum<S>(slab, row, 2048, col) + *(const f32x4*)(base + (size_t)row * 2048 + col);
            *(f32x4*)(out + (size_t)row * 2048 + col) = o; *(v2u*)(XB + (size_t)row * 2048 + col) = (v2u){pk2(o[0], o[1]), pk2(o[2], o[3])};
            tot += (o[0] * o[0] + o[1] * o[1]) + (o[2] * o[2] + o[3] * o[3]); }
        tot = wave_sum(tot); if (lane == 0) RSTD[RP + row] = 1.0f / sqrtf(tot * (1.0f / 2048.0f) + EPS);
    }
    const float* SSP = (const float*)(ws + WS_SS);
    for (int row = C.bx * 512 + C.tid; row < RP; row += C.G * 512) RSTD[row] = rstd32(SSP + (size_t)row * 32);
}
template <int S> DI void ph_reduce_a1(const Args& a, const Ctx& C) {
    unsigned char* ws = a.ws; const float* slab = (const float*)(ws + WS_SLAB); const float* SS = (const float*)(ws + WS_SS);
    bf16* U = (bf16*)(ws + WS_U); bf16* V = (bf16*)(ws + WS_V); float* VSS = (float*)(ws + WS_VSS);
    const int gw = C.bx * NWAVES + C.wave, NGW = C.G * NWAVES, lane = C.lane;
    for (int row = gw; row < RS; row += NGW) { const float rs = ((const float*)(ws + WS_RSTD))[RP + row];
#pragma unroll
        for (int j = 0; j < 16; ++j) { const int col = 4 * lane + 256 * j; f32x4 z = slab_sum<S>(slab, row, 4096, col) * rs;
#pragma unroll
            for (int e = 0; e < 4; ++e) z[e] = pg8::gelu_tanh(z[e]);
            const v2u w = {pk2(z[0], z[1]), pk2(z[2], z[3])};
            if (j < 8) *(v2u*)(U + (size_t)(RP + row) * 2048 + col) = w;
            else { *(v2u*)(V + (size_t)(RP + row) * 2048 + col - 2048) = w; const float q = grp16_sum((z[0] * z[0] + z[1] * z[1]) + (z[2] * z[2] + z[3] * z[3])); if ((lane & 15) == 0) VSS[(size_t)(RP + row) * 32 + 4 * (j - 8) + (lane >> 4)] = q; } }
    }
}
#define SELFCHK_HOOK(a,b,c,d) do {} while (0)
#ifndef MK_ONE_LAUNCH
#define MK_ONE_LAUNCH 1
#endif
constexpr int N_PHASES = 16;
#ifndef DBG_NPH
#define DBG_NPH 16
#endif
__global__ void __launch_bounds__(NWAVES * 64, 2) fwd_kernel(Args args) {
    extern __shared__ __attribute__((aligned(16))) unsigned char lds_raw[];
    Ctx C; C.lds = (LAS unsigned char*)lds_raw; C.tid = threadIdx.x; C.lane = C.tid & 63; C.wave = __builtin_amdgcn_readfirstlane(C.tid >> 6); C.G = gridDim.x; C.bx = blockIdx.x;
    unsigned char* ws = args.ws;
    for (int u = C.tid; u < 128; u += NWAVES * 64) ((LAS unsigned*)(C.lds + MISC_OFF))[u] = 0u;
    __syncthreads();
#if MK_ONE_LAUNCH
    XcdBarrier bar = xcd_barrier_post((unsigned*)ws + CW_BAR, (volatile LAS unsigned*)(C.lds + MISC_OFF) + 8);
#define GRID_BAR() xcd_barrier(bar)
#else
#define GRID_BAR() do {} while (0)
#endif
    const int lo = args.ph_lo, hi = args.ph_hi;
#ifndef PH_MASK
#define PH_MASK 0xFFFF
#endif
#define IN(k) (((PH_MASK >> (k)) & 1) && lo <= (k) && (k) < hi)
#ifndef DBG_TPHASE
#define DBG_TPHASE -1
#define DBG_TPHASE_HI 11
#endif
#ifndef DBG_TMULT
#define DBG_TMULT 7
#endif
    volatile LAS unsigned long long* stamps = (volatile LAS unsigned long long*)(C.lds + MISC_OFF + 128);
#define STAMP(k) do { if (DBG_TPHASE >= 0 && C.bx == 0 && C.tid == 0) stamps[(k)] = wall_clock64(); } while (0)
#define SEAM(k) do { if (IN(k) && IN((k) + 1)) GRID_BAR(); STAMP((k) + 1); } while (0)
    STAMP(0);
    bf16* XB = (bf16*)(ws + WS_XB); float* SS = (float*)(ws + WS_SS); float* XA = (float*)(ws + WS_XA); float* Y = args.out + OFF_Y; float* SLAB = (float*)(ws + WS_SLAB); const float* RSTD = (const float*)(ws + WS_RSTD);
    using pg8::Gemm; using pg8::StaticOrder;
    if (IN(0)) { ph_prologue(args, C); } SEAM(0);
    if (IN(1)) { Gemm g{XB, (const bf16*)(ws + WS_WAIN), R, 4096, 2048}; pg8::SplitOrder S; S.init(4096, 2048, 4, C.G, C.bx);
        pg8::EpiA1 E{(bf16*)(ws + WS_U), (bf16*)(ws + WS_V), (float*)(ws + WS_VSS), RSTD, SLAB};
        pg8::gemm_phase<pg8::EpiA1, pg8::SplitOrder, true, true>(C.lds, g, S, E); GRID_BAR(); ph_reduce_a1<4>(args, C); } SEAM(1);
    if (IN(2)) { ph_gate(args, C); } SEAM(2);
    if (IN(3)) { Gemm g{(const bf16*)(ws + WS_GT), (const bf16*)(ws + WS_WAOUT), R, 2048, 2048}; pg8::SplitOrder S; S.init(2048, 2048, 8, C.G, C.bx);
        pg8::EpiResidT<false, false> E{nullptr, nullptr, XB, SS, SLAB};
        pg8::gemm_phase<pg8::EpiResidT<false, false>, pg8::SplitOrder, true, true>(C.lds, g, S, E); GRID_BAR(); ph_reduce_resid<8>(args, C, args.in[1], XA + (size_t)RP * 2048); } SEAM(3);
    if (IN(4)) { Gemm g{XB, (const bf16*)(ws + WS_WFIN), R, DFF2, 2048}; StaticOrder S; S.init(R, DFF2, C.G, C.bx);
        pg8::EpiFfn E{(bf16*)(ws + WS_AB), (bf16*)(ws + WS_HID), RSTD, args.out + OFF_CP, args.out + OFF_CS, args.in[20], args.in[21], (PG8_LAS float*)(C.lds + 131072)};
        pg8::gemm_phase<pg8::EpiFfn, StaticOrder, true, true>(C.lds, g, S, E); filler_pull(args, C, 0); } SEAM(4);
    if (IN(5)) { ph_conv(args, C, 0); } SEAM(5);
    if (IN(6)) { Gemm g{(const bf16*)(ws + WS_HID), (const bf16*)(ws + WS_WFOUT), R, 2048, DFF}; pg8::SplitOrder S; S.init(2048, DFF, 8, C.G, C.bx);
        pg8::EpiResidT<false, false> E{nullptr, nullptr, XB, SS, SLAB};
        pg8::gemm_phase<pg8::EpiResidT<false, false>, pg8::SplitOrder, true, true>(C.lds, g, S, E); GRID_BAR(); ph_reduce_resid<8>(args, C, XA + (size_t)RP * 2048, Y + (size_t)RP * 2048); } SEAM(6);
    if (IN(7)) { Gemm g{XB, (const bf16*)(ws + WS_WBIN), R, NBP, 2048}; StaticOrder S; S.init(R, NBP, C.G, C.bx);
        pg8::EpiScale E{(bf16*)(ws + WS_P), NBP, RSTD, nullptr, nullptr};
        pg8::gemm_phase<pg8::EpiScale, StaticOrder, true, true>(C.lds, g, S, E); filler_pull(args, C, 1); } SEAM(7);
    if (IN(8)) { ph_qkrope(args, C); } SEAM(8);
    if (IN(9)) { ph_index(args, C); } SEAM(9);
    if (IN(10)) { ph_select(args, C); } SEAM(10);
    if (IN(11)) { ph_attn(args, C); } SEAM(11);
    if (IN(12)) { Gemm g{(const bf16*)(ws + WS_O), (const bf16*)(ws + WS_WBO), R, 2048, 2048}; pg8::SplitOrder S; S.init(2048, 2048, 8, C.G, C.bx);
        pg8::EpiResidT<false, false> E{nullptr, nullptr, XB, SS, SLAB};
        pg8::gemm_phase<pg8::EpiResidT<false, false>, pg8::SplitOrder, true, true>(C.lds, g, S, E); GRID_BAR(); ph_reduce_resid<8>(args, C, Y + (size_t)RP * 2048, XA + (size_t)RP * 2048); } SEAM(12);
    if (IN(13)) { Gemm g{XB, (const bf16*)(ws + WS_WFIN) + (size_t)DFF2 * 2048, R, DFF2, 2048}; StaticOrder S; S.init(R, DFF2, C.G, C.bx);
        pg8::EpiFfn E{(bf16*)(ws + WS_AB), (bf16*)(ws + WS_HID), RSTD, args.out + OFF_CP + (size_t)8 * 2 * DFF2, args.out + OFF_CS + (size_t)128 * 2 * DFF2, args.in[20] + (size_t)3 * DFF2, args.in[21] + DFF2, (PG8_LAS float*)(C.lds + 131072)};
        pg8::gemm_phase<pg8::EpiFfn, StaticOrder, true, true>(C.lds, g, S, E); filler_pull(args, C, 2); } SEAM(13);
    if (IN(14)) { ph_conv(args, C, 1); } SEAM(14);
    if (IN(15)) { Gemm g{(const bf16*)(ws + WS_HID), (const bf16*)(ws + WS_WFOUT) + (size_t)2048 * DFF, R, 2048, DFF}; pg8::SplitOrder S; S.init(2048, DFF, 8, C.G, C.bx);
        pg8::EpiResidT<false, true> E{nullptr, Y, XB, SS, SLAB};
        pg8::gemm_phase<pg8::EpiResidT<false, true>, pg8::SplitOrder, true, true>(C.lds, g, S, E); GRID_BAR(); ph_reduce_resid<8>(args, C, XA + (size_t)RP * 2048, Y + (size_t)RP * 2048); }
    if (DBG_TPHASE >= 0) {
        STAMP(16);
        if (C.bx == 0 && C.tid == 0) { const unsigned long long d = (stamps[DBG_TPHASE_HI] - stamps[DBG_TPHASE]) * DBG_TMULT, t0 = wall_clock64();
            while (wall_clock64() - t0 < d) __builtin_amdgcn_s_sleep(16); }
    }
#undef IN
#undef SEAM
}

extern "C" void kernel_launch(void* const* d_in, const int* in_sizes, int n_in, void* d_out, int out_size, void* d_ws, size_t ws_size, hipStream_t stream) {
    static int grid = 0;
    if (grid == 0) {
        if (n_in != 23 || (size_t)out_size != OUT_TOTAL || ws_size < WS_END) { fprintf(stderr, "kernel_launch: unexpected shapes (n_in %d, out %d, ws %zu < %zu)\n", n_in, out_size, ws_size, (size_t)WS_END); grid = -1; return; }
        int dev = 0, cus = 0, per_cu = 0;
        if (hipGetDevice(&dev) != hipSuccess || hipDeviceGetAttribute(&cus, hipDeviceAttributeMultiprocessorCount, dev) != hipSuccess) { grid = -1; return; }
        if (hipFuncSetAttribute((const void*)fwd_kernel, hipFuncAttributeMaxDynamicSharedMemorySize, LDS_BYTES) != hipSuccess) { fprintf(stderr, "kernel_launch: hipFuncSetAttribute failed\n"); grid = -1; return; }
        if (hipOccupancyMaxActiveBlocksPerMultiprocessor(&per_cu, (const void*)fwd_kernel, NWAVES * 64, LDS_BYTES) != hipSuccess || per_cu < 1) { fprintf(stderr, "kernel_launch: occupancy query says %d\n", per_cu); }
        (void)hipGetLastError();
        grid = cus;
    }
    if (grid < 0) return;
    (void)hipMemsetAsync(d_ws, 0, CTL_BYTES, stream);
    Args a{};
    for (int i = 0; i < 23; ++i) a.in[i] = (const float*)d_in[i];
    a.out = (float*)d_out; a.ws = (unsigned char*)d_ws;
#if MK_ONE_LAUNCH
    a.ph_lo = 0; a.ph_hi = N_PHASES;
    hipLaunchKernelGGL(fwd_kernel, dim3(grid), dim3(NWAVES * 64), LDS_BYTES, stream, a);
#else
    for (int p = 0; p < DBG_NPH; ++p) { a.ph_lo = p; a.ph_hi = p + 1; hipLaunchKernelGGL(fwd_kernel, dim3(grid), dim3(NWAVES * 64), LDS_BYTES, stream, a); }
#endif
    SELFCHK_HOOK(d_in, d_out, d_ws, stream);
}
```

```cpp
#include <hip/hip_runtime.h>
#include <cstdio>
#include <cstdint>
namespace pg8 {
#define PG8_LAS __attribute__((address_space(3)))
typedef unsigned short bf16_t;
typedef short bf16x8 __attribute__((ext_vector_type(8)));
typedef float f32x4 __attribute__((ext_vector_type(4)));
typedef unsigned u32x4 __attribute__((ext_vector_type(4)));
constexpr int BM = 256, BK = 64, HALF = 128, HTB = HALF * BK * 2  , STAGE_BYTES = 8 * HTB, NXCD = 8, WGM = 8;

__host__ __device__ __forceinline__ int lds_byte(int r, int c) { const int st = (r >> 4) * 2 + (c >> 5), rr = r & 15, cc = c & 31, ob = rr * 64 + cc * 2; return st * 1024 + (ob ^ (((ob >> 9) & 1) << 5)); }
__host__ __device__ __forceinline__ void stage_rc(int b, int& R, int& C) { const int st = b / 1024, sb = b % 1024, swz = sb ^ (((sb >> 9) & 1) << 5); R = (st >> 1) * 16 + swz / 64; C = (st & 1) * 32 + (swz % 64) / 2; }
__host__ __device__ __forceinline__ int perm32(int rho) { const int n = rho >> 4, i = rho & 15; return 8 * (i >> 2) + 4 * n + (i & 3); }

struct Unit { int pm, pn, kb, nt, ks; };
struct Gemm { const bf16_t* A; const bf16_t* Bt; int M, N, K; };

struct StaticOrder {
    int nM, nN, nwg, G, c, nt_full;
    __host__ __device__ void init(int M, int N, int G_, int c_, int K = 2048) { nM = M / BM; nN = N / BM; nwg = nM * nN; G = G_; c = c_; nt_full = K / BK; }
    __host__ __device__ __forceinline__ bool next(int i, Unit& u) const {
        const long L = (long)i * G + c; if (L >= nwg) return false;
        int wgid = (int)L; { const int q = nwg / NXCD, r = nwg % NXCD, xcd = wgid % NXCD, off = wgid / NXCD; wgid = (xcd < r ? xcd * (q + 1) : r * (q + 1) + (xcd - r) * q) + off; }
        const int nig = WGM * nN, gid = wgid / nig, fm = gid * WGM, gsz = (nM - fm) < WGM ? (nM - fm) : WGM;
        u.pm = fm + ((wgid % nig) % gsz); u.pn = (wgid % nig) / gsz; u.kb = 0; u.nt = nt_full; u.ks = -1; return true;
    }
    __device__ __forceinline__ void a_ready(const Unit&) const {}
    __device__ __forceinline__ void done(const Unit&) const {}
};
struct SplitOrder {
    StaticOrder P; int nP, nN, S, nts, rem, G, c;
    __host__ __device__ void init(int N, int K, int S_, int G_, int c_) { P.init(16384, N, G_, c_, K); nP = 64 * (N / BM); nN = N / BM; S = S_; nts = 2 * ((K / BK) / (2 * S_)); rem = ((K / BK) - S_ * nts) / 2; G = G_; c = c_; }
    __host__ __device__ __forceinline__ bool next(int i, Unit& u) const {
        const bool flip = (nP % G == 0) && (4 * nN * S == G) && ((c & 1) != 0);
        const long L0 = (long)i * G + c, L = flip ? (long)(i - 1) * G + c : L0;
        const bool isp = flip ? (i >= 1 && L < nP) : (L0 < nP); const int s = flip ? c : (isp ? 0 : (int)(L0 - nP)); const bool iss = flip ? (i == 0) : (!isp && s < 4 * nN * S);
        int wgid = isp ? (int)L : 0; { const int q = nP / NXCD, r = nP % NXCD, xcd = wgid % NXCD, off = wgid / NXCD; wgid = (xcd < r ? xcd * (q + 1) : r * (q + 1) + (xcd - r) * q) + off; }
        const int nig = WGM * nN, gid = wgid / nig, fm = gid * WGM, gsz = (64 - fm) < WGM ? (64 - fm) : WGM;
        const int pm_p = fm + ((wgid % nig) % gsz), pn_p = (wgid % nig) / gsz;
        const int t = s / S, ks = s % S;
        u.pm = isp ? pm_p : 64 + (t & 3); u.pn = isp ? pn_p : (t >> 2); const int st = ks * nts + 2 * (ks < rem ? ks : rem), ntk = nts + (ks < rem ? 2 : 0);
        u.kb = isp ? 0 : st * BK * 2; u.nt = isp ? P.nt_full : ntk; u.ks = isp ? -1 : ks;
        return isp || iss;
    }
    __device__ __forceinline__ void a_ready(const Unit&) const {}
    __device__ __forceinline__ void done(const Unit&) const {}
};
constexpr int RPROMPT = 16384;
typedef __bf16 bf2_t __attribute__((ext_vector_type(2)));
typedef float f32x2 __attribute__((ext_vector_type(2)));
__device__ __forceinline__ unsigned cvt_pk_bf16(float lo, float hi) { f32x2 v = {lo, hi}; return __builtin_bit_cast(unsigned, __builtin_convertvector(v, bf2_t)); }
__device__ __forceinline__ u32x4 pack8(const f32x4& a, const f32x4& b) { u32x4 w; w.x = cvt_pk_bf16(a[0], a[1]); w.y = cvt_pk_bf16(a[2], a[3]); w.z = cvt_pk_bf16(b[0], b[1]); w.w = cvt_pk_bf16(b[2], b[3]); return w; }
__device__ __forceinline__ float rstd_of(const float* rstd, int row) { return rstd[row]; }
__device__ __forceinline__ float gelu_tanh(float x) {
    const float u = x * (0.7978845608f + 0.0356774081f * x * x);
    const float e = __builtin_amdgcn_exp2f(-2.885390082f * u);
    return x * __builtin_amdgcn_rcpf(1.0f + e);
}
__device__ __forceinline__ float sumsq4(const f32x4& a) { return (a[0] * a[0] + a[1] * a[1]) + (a[2] * a[2] + a[3] * a[3]); }

__device__ __forceinline__ void store_slab(const f32x4 (&acc)[2][2][4][2], const Unit& u, int wr, int wc, int fr, int fq, float* slab_, int N) {
    bf16_t* slab = (bf16_t*)slab_;
    const int col0 = u.pn * BM + wc * 32 + 8 * fq, row0 = (u.pm - 64) * BM + wr * 64 + fr;
#pragma unroll
    for (int ai = 0; ai < 2; ++ai)
#pragma unroll
        for (int m = 0; m < 4; ++m) { bf16_t* op = slab + ((size_t)u.ks * 1024 + row0 + ai * HALF + m * 16) * N + col0;
#pragma unroll
            for (int bj = 0; bj < 2; ++bj) *(u32x4*)(op + bj * HALF) = pack8(acc[ai][bj][m][0], acc[ai][bj][m][1]); }
}
struct EpiA1 {
    static constexpr bool PERM = true, AFTER_DRAIN = false;
    bf16_t* U; bf16_t* V; float* vss; const float* ss; float* slab;
    __device__ __forceinline__ void operator()(const f32x4 (&acc)[2][2][4][2], const Unit& u, int wr, int wc, int fr, int fq) const {
        if (u.ks >= 0) { store_slab(acc, u, wr, wc, fr, fq, slab, 4096); return; }
        const bool isv = u.pn >= 8; bf16_t* dst = isv ? V : U; const int pt = isv ? u.pn - 8 : u.pn;
        const int col0 = pt * BM + wc * 32 + 8 * fq, row0 = u.pm * BM + wr * 64 + fr;
        float rsv[2][4];
#pragma unroll
        for (int ai = 0; ai < 2; ++ai)
#pragma unroll
            for (int m = 0; m < 4; ++m) rsv[ai][m] = rstd_of(ss, row0 + ai * HALF + m * 16);
#pragma unroll
        for (int ai = 0; ai < 2; ++ai)
#pragma unroll
            for (int m = 0; m < 4; ++m) { const int row = row0 + ai * HALF + m * 16; const float rs = rsv[ai][m]; float q = 0.f;
#pragma unroll
                for (int bj = 0; bj < 2; ++bj) { f32x4 v0 = acc[ai][bj][m][0] * rs, v1 = acc[ai][bj][m][1] * rs;
#pragma unroll
                    for (int j = 0; j < 4; ++j) { v0[j] = gelu_tanh(v0[j]); v1[j] = gelu_tanh(v1[j]); }
                    q += sumsq4(v0) + sumsq4(v1);
                    *(u32x4*)(dst + (size_t)row * 2048 + col0 + bj * HALF) = pack8(v0, v1); }
                if (isv) { q += __shfl_xor(q, 16); q += __shfl_xor(q, 32); if (fq == 0) vss[(size_t)row * 32 + pt * 4 + wc] = q; } }
    }
};
template <bool BASE_F32, bool OUT_F32> struct EpiResidT {
    static constexpr bool PERM = true, AFTER_DRAIN = false;
    const float* base0; float* out; bf16_t* xb; float* ss; float* slab;
    __device__ __forceinline__ void operator()(const f32x4 (&acc_)[2][2][4][2], const Unit& u, int wr, int wc, int fr_, int fq_) const {
        if (u.ks >= 0) { store_slab(acc_, u, wr, wc, fr_, fq_, slab, 2048); return; }
        f32x4 (&acc)[2][2][4][2] = const_cast<f32x4 (&)[2][2][4][2]>(acc_);
        int fr = fr_, fq = fq_; asm volatile("" : "+v"(fr), "+v"(fq));
        const int col0 = u.pn * BM + wc * 32 + 8 * fq, row0 = u.pm * BM + wr * 64 + fr;
#pragma unroll
        for (int ai = 0; ai < 2; ++ai) {
            if constexpr (BASE_F32) {
                f32x4 bv[4][2][2];
#pragma unroll
                for (int m = 0; m < 4; ++m) { const int row = row0 + ai * HALF + m * 16; const float* bp = base0 + (size_t)row * 2048 + col0;
#pragma unroll
                    for (int bj = 0; bj < 2; ++bj) { bv[m][bj][0] = *(const f32x4*)(bp + bj * HALF); bv[m][bj][1] = *(const f32x4*)(bp + bj * HALF + 4); } }
#pragma unroll
                for (int m = 0; m < 4; ++m)
#pragma unroll
                    for (int bj = 0; bj < 2; ++bj) { acc[ai][bj][m][0] += bv[m][bj][0]; acc[ai][bj][m][1] += bv[m][bj][1]; }
            } else {
                u32x4 bw[4][2];
#pragma unroll
                for (int m = 0; m < 4; ++m) { const int row = row0 + ai * HALF + m * 16;
#pragma unroll
                    for (int bj = 0; bj < 2; ++bj) bw[m][bj] = *(const u32x4*)(xb + (size_t)row * 2048 + col0 + bj * HALF); }
#pragma unroll
                for (int m = 0; m < 4; ++m)
#pragma unroll
                    for (int bj = 0; bj < 2; ++bj) { const u32x4 w = bw[m][bj];
                        acc[ai][bj][m][0][0] += __uint_as_float(w.x << 16); acc[ai][bj][m][0][1] += __uint_as_float(w.x & 0xffff0000u);
                        acc[ai][bj][m][0][2] += __uint_as_float(w.y << 16); acc[ai][bj][m][0][3] += __uint_as_float(w.y & 0xffff0000u);
                        acc[ai][bj][m][1][0] += __uint_as_float(w.z << 16); acc[ai][bj][m][1][1] += __uint_as_float(w.z & 0xffff0000u);
                        acc[ai][bj][m][1][2] += __uint_as_float(w.w << 16); acc[ai][bj][m][1][3] += __uint_as_float(w.w & 0xffff0000u); }
            }
            __builtin_amdgcn_sched_barrier(0);
#pragma unroll
            for (int m = 0; m < 4; ++m) { const int row = row0 + ai * HALF + m * 16; float q = 0.f;
#pragma unroll
                for (int bj = 0; bj < 2; ++bj) { const f32x4 o0 = acc[ai][bj][m][0], o1 = acc[ai][bj][m][1];
                    q += sumsq4(o0) + sumsq4(o1);
                    if constexpr (OUT_F32) { float* op = out + (size_t)row * 2048 + col0; __builtin_nontemporal_store(o0, (f32x4*)(op + bj * HALF)); __builtin_nontemporal_store(o1, (f32x4*)(op + bj * HALF + 4)); }
                    else *(u32x4*)(xb + (size_t)row * 2048 + col0 + bj * HALF) = pack8(o0, o1); }
                q += __shfl_xor(q, 16); q += __shfl_xor(q, 32); if (fq == 0) ss[(size_t)row * 32 + u.pn * 4 + wc] = q; }
            __builtin_amdgcn_sched_barrier(0);
        }
    }
};
struct EpiScale {
    static constexpr bool PERM = true, AFTER_DRAIN = false;
    bf16_t* O; int ldc; const float* ss; float* convp; float* convs;
    __device__ __forceinline__ void operator()(const f32x4 (&acc)[2][2][4][2], const Unit& u, int wr, int wc, int fr, int fq) const {
        const int col0 = u.pn * BM + wc * 32 + 8 * fq, row0 = u.pm * BM + wr * 64 + fr;
        float rsv[2][4];
#pragma unroll
        for (int ai = 0; ai < 2; ++ai)
#pragma unroll
            for (int m = 0; m < 4; ++m) rsv[ai][m] = rstd_of(ss, row0 + ai * HALF + m * 16);
#pragma unroll
        for (int ai = 0; ai < 2; ++ai)
#pragma unroll
            for (int m = 0; m < 4; ++m) { const int row = row0 + ai * HALF + m * 16; const float rs = rsv[ai][m];
                float* cd = nullptr;
                if (convp) { if (row < RPROMPT) { const int t = row & 2047; if (t >= 2046) cd = convp + (size_t)((row >> 11) * 2 + (t - 2046)) * ldc; }
                             else { const int rr = row - RPROMPT, t = rr & 7; if (t >= 6) cd = convs + (size_t)((rr >> 3) * 2 + (t - 6)) * ldc; } }
#pragma unroll
                for (int bj = 0; bj < 2; ++bj) { const f32x4 v0 = acc[ai][bj][m][0] * rs, v1 = acc[ai][bj][m][1] * rs;
                    *(u32x4*)(O + (size_t)row * ldc + col0 + bj * HALF) = pack8(v0, v1);
                    if (cd) { *(f32x4*)(cd + col0 + bj * HALF) = v0; *(f32x4*)(cd + col0 + bj * HALF + 4) = v1; } } }
    }
};

__device__ __forceinline__ float dpp_f(float old, float src, int ctrl_sel) {
    const int o = __builtin_bit_cast(int, old), x = __builtin_bit_cast(int, src); int r;
    if (ctrl_sel == 0) r = __builtin_amdgcn_update_dpp(o, x, 0x111, 0xf, 0xf, false);
    else if (ctrl_sel == 1) r = __builtin_amdgcn_update_dpp(o, x, 0x112, 0xf, 0xf, false);
    else if (ctrl_sel == 2) r = __builtin_amdgcn_update_dpp(o, x, 0x121, 0xf, 0xf, false);
    else r = __builtin_amdgcn_update_dpp(o, x, 0x122, 0xf, 0xf, false);
    return __builtin_bit_cast(float, r);
}
struct EpiFfn {
    static constexpr bool PERM = true, AFTER_DRAIN = false;
    bf16_t* AB; bf16_t* HID; const float* ss; float* convp; float* convs; const float* cw; const float* cb; PG8_LAS float* xl;
    __device__ __forceinline__ void operator()(const f32x4 (&acc_)[2][2][4][2], const Unit& u, int wr, int wc, int fr, int fq) const {
        f32x4 (&acc)[2][2][4][2] = const_cast<f32x4 (&)[2][2][4][2]>(acc_);
        const int colg = u.pn * 128 + wc * 32 + 8 * fq, colu = 5632 + colg, row0 = u.pm * BM + wr * 64 + fr;
        const bool sample = u.pm >= 64;
        float rsv[2][4];
#pragma unroll
        for (int ai = 0; ai < 2; ++ai)
#pragma unroll
            for (int m = 0; m < 4; ++m) rsv[ai][m] = rstd_of(ss, row0 + ai * HALF + m * 16);
#pragma unroll
        for (int ai = 0; ai < 2; ++ai)
#pragma unroll
            for (int m = 0; m < 4; ++m) { const int row = row0 + ai * HALF + m * 16; const int tr = row & 255; const float rs = rsv[ai][m];
                acc[ai][0][m][0] *= rs; acc[ai][0][m][1] *= rs; acc[ai][1][m][0] *= rs; acc[ai][1][m][1] *= rs;
                float* cd = nullptr;
                if (row < RPROMPT) { const int t = row & 2047; if (t >= 2046) cd = convp + (size_t)((row >> 11) * 2 + (t - 2046)) * 11264; }
                else { const int rr = row - RPROMPT, t = rr & 7; if (t >= 6) cd = convs + (size_t)((rr >> 3) * 2 + (t - 6)) * 11264; }
                if (sample || tr < 2 || tr >= 254) { *(u32x4*)(AB + (size_t)row * 11264 + colg) = pack8(acc[ai][0][m][0], acc[ai][0][m][1]); *(u32x4*)(AB + (size_t)row * 11264 + colu) = pack8(acc[ai][1][m][0], acc[ai][1][m][1]); }
                if (cd) { *(f32x4*)(cd + colg) = acc[ai][0][m][0]; *(f32x4*)(cd + colg + 4) = acc[ai][0][m][1]; *(f32x4*)(cd + colu) = acc[ai][1][m][0]; *(f32x4*)(cd + colu + 4) = acc[ai][1][m][1]; }
                __builtin_amdgcn_sched_barrier(0); }
        const int wave = wr * 4 + wc;
        if (fr >= 14) {
#pragma unroll
            for (int ai = 0; ai < 2; ++ai) { PG8_LAS float* d = xl + ((((wave * 2 + ai) * 2 + (fr - 14)) * 4 + fq) << 4);
                *(PG8_LAS f32x4*)(d) = acc[ai][0][3][0]; *(PG8_LAS f32x4*)(d + 4) = acc[ai][0][3][1]; *(PG8_LAS f32x4*)(d + 8) = acc[ai][1][3][0]; *(PG8_LAS f32x4*)(d + 12) = acc[ai][1][3][1]; } }
        asm volatile("s_waitcnt lgkmcnt(0)" ::: "memory"); __builtin_amdgcn_s_barrier(); asm volatile("" ::: "memory");
        if (sample) return;
#pragma unroll
        for (int n = 0; n < 2; ++n) {
            const f32x4 w0g = *(const f32x4*)(cw + colg + 4 * n), w1g = *(const f32x4*)(cw + 11264 + colg + 4 * n), w2g = *(const f32x4*)(cw + 22528 + colg + 4 * n), bg = *(const f32x4*)(cb + colg + 4 * n);
            const f32x4 w0u = *(const f32x4*)(cw + colu + 4 * n), w1u = *(const f32x4*)(cw + 11264 + colu + 4 * n), w2u = *(const f32x4*)(cw + 22528 + colu + 4 * n), bu = *(const f32x4*)(cb + colu + 4 * n);
#pragma unroll
            for (int ai = 0; ai < 2; ++ai) {
                const int rb = 2 * ai + wr;
                f32x4 c1g = {0.f, 0.f, 0.f, 0.f}, c2g = c1g, c1u = c1g, c2u = c1g;
                if (rb > 0 && fr < 2) { const int pw = ((rb - 1) & 1) * 4 + wc, pai = (rb - 1) >> 1;
                    const PG8_LAS float* r1 = xl + ((((pw * 2 + pai) * 2 + 1) * 4 + fq) << 4);
                    const PG8_LAS float* r2 = xl + ((((pw * 2 + pai) * 2 + 0) * 4 + fq) << 4);
                    c1g = *(const PG8_LAS f32x4*)(r1 + 4 * n); c1u = *(const PG8_LAS f32x4*)(r1 + 8 + 4 * n);
                    const PG8_LAS float* q2 = fr == 0 ? r2 : r1; c2g = *(const PG8_LAS f32x4*)(q2 + 4 * n); c2u = *(const PG8_LAS f32x4*)(q2 + 8 + 4 * n); }
#pragma unroll
                for (int m = 0; m < 4; ++m) { const int row = row0 + ai * HALF + m * 16;
                    const f32x4 xg = acc[ai][0][m][n], xu = acc[ai][1][m][n];
                    if (m > 0) { const f32x4 pg = acc[ai][0][m - 1][n], pu = acc[ai][1][m - 1][n];
#pragma unroll
                        for (int e = 0; e < 4; ++e) { c1g[e] = dpp_f(0.f, pg[e], 2); c2g[e] = dpp_f(0.f, pg[e], 3); c1u[e] = dpp_f(0.f, pu[e], 2); c2u[e] = dpp_f(0.f, pu[e], 3); } }
                    float h[4];
#pragma unroll
                    for (int e = 0; e < 4; ++e) { const float p1g = dpp_f(c1g[e], xg[e], 0), p2g = dpp_f(c2g[e], xg[e], 1), p1u = dpp_f(c1u[e], xu[e], 0), p2u = dpp_f(c2u[e], xu[e], 1);
                        const float cg = bg[e] + w0g[e] * p2g + w1g[e] * p1g + w2g[e] * xg[e], cu = bu[e] + w0u[e] * p2u + w1u[e] * p1u + w2u[e] * xu[e];
                        h[e] = cg * __builtin_amdgcn_rcpf(1.0f + __builtin_amdgcn_exp2f(-1.4426950408889634f * cg)) * cu; }
                    if (!(rb == 0 && m == 0 && fr < 2)) { typedef unsigned u32x2 __attribute__((ext_vector_type(2)));
                        *(u32x2*)(HID + (size_t)row * 5632 + colg + 4 * n) = (u32x2){cvt_pk_bf16(h[0], h[1]), cvt_pk_bf16(h[2], h[3])}; }
                    if (m & 1) __builtin_amdgcn_sched_barrier(0);
                }
            }
        }
    }
};

template <class Epi, class Sched, bool ALIGN_EPI = false, bool SP2 = false>
__device__ __forceinline__ void gemm_phase(PG8_LAS unsigned char* lds, const Gemm g, const Sched& S, const Epi& E) {
    const int tid = threadIdx.x, wid = __builtin_amdgcn_readfirstlane(tid >> 6), lane = tid & 63, wr = wid >> 2, wc = wid & 3, fr = lane & 15, fq = lane >> 4;
    const int K = g.K; int nt;
    unsigned voffA[2], voffB[2];
#pragma unroll
    for (int i = 0; i < 2; ++i) { int R, C; stage_rc(tid * 16 + i * 8192, R, C); const int Rb = Epi::PERM ? ((R & ~31) + perm32(R & 31)) : R;
        voffA[i] = (unsigned)(R * K + C) * 2u; voffB[i] = (unsigned)(Rb * K + C) * 2u; }
    const size_t kstep = (size_t)(BK * 2);
    const size_t hstep = (size_t)HALF * K * 2;
    const size_t tstep = 2 * hstep;
    const unsigned ldsw = (unsigned)wid * 1024u;
    const int aoff = lds_byte(wr * 64 + fr, fq * 8), boff = lds_byte(wc * 32 + fr, fq * 8);
#define PG8_SA(b, h) (((b) * 2 + (h)) * HTB)
#define PG8_SB(b, h) ((4 + (b) * 2 + (h)) * HTB)
#define PG8_STAGE(bufoff, gbase, voff) do { _Pragma("unroll") for (int _i = 0; _i < 2; ++_i) \
        __builtin_amdgcn_global_load_lds((const unsigned*)((const char*)(gbase) + (voff)[_i]), (PG8_LAS unsigned*)(lds + (bufoff) + ldsw + _i * 8192), 16, 0, 0); } while (0)
#define PG8_LDA(dst, b, h) do { _Pragma("unroll") for (int m = 0; m < 4; ++m) _Pragma("unroll") for (int k = 0; k < 2; ++k) dst[m][k] = *(const PG8_LAS bf16x8*)(lds + PG8_SA(b, h) + aoff + m * 2048 + k * 1024); } while (0)
#define PG8_LDB(dst, b, h) do { _Pragma("unroll") for (int n = 0; n < 2; ++n) _Pragma("unroll") for (int k = 0; k < 2; ++k) dst[n][k] = *(const PG8_LAS bf16x8*)(lds + PG8_SB(b, h) + boff + n * 2048 + k * 1024); } while (0)
#define PG8_MMA(ai, bj, At, Bt) do { __builtin_amdgcn_s_setprio(1); _Pragma("unroll") for (int m = 0; m < 4; ++m) _Pragma("unroll") for (int n = 0; n < 2; ++n) _Pragma("unroll") for (int k = 0; k < 2; ++k) \
        acc[ai][bj][m][n] = __builtin_amdgcn_mfma_f32_16x16x32_bf16(Bt[n][k], At[m][k], acc[ai][bj][m][n], 0, 0, 0); __builtin_amdgcn_s_setprio(0); } while (0)
#define PG8_WAIT_V(n) asm volatile("s_waitcnt vmcnt(" #n ")" ::: "memory")
#define PG8_WAIT_L(n) asm volatile("s_waitcnt lgkmcnt(" #n ")" ::: "memory")
#define PG8_BAR __builtin_amdgcn_s_barrier()
#define PG8_SCHED __builtin_amdgcn_sched_barrier(0)
    Unit cur, nxt; int ui = 0;
    if (!S.next(0, cur)) return;
    f32x4 acc[2][2][4][2];
#pragma unroll
    for (int a = 0; a < 2; ++a)
#pragma unroll
        for (int b = 0; b < 2; ++b)
#pragma unroll
            for (int m = 0; m < 4; ++m)
#pragma unroll
                for (int n = 0; n < 2; ++n) acc[a][b][m][n] = (f32x4){0.f, 0.f, 0.f, 0.f};
    bf16x8 At[4][2], B0[2][2], B1[2][2];
    const char* cA = (const char*)g.A + (size_t)cur.pm * tstep + cur.kb; const char* cB = (const char*)g.Bt + (size_t)cur.pn * tstep + cur.kb; nt = cur.nt;
    S.a_ready(cur);
    if constexpr (SP2) {
        PG8_STAGE(PG8_SB(0, 0), cB, voffB); PG8_STAGE(PG8_SB(0, 1), cB + hstep, voffB); PG8_STAGE(PG8_SA(0, 0), cA, voffA); PG8_STAGE(PG8_SA(0, 1), cA + hstep, voffA);
        if (wr == 1) PG8_BAR;
        PG8_WAIT_V(2); PG8_BAR;
        PG8_STAGE(PG8_SB(1, 0), cB + kstep, voffB); PG8_STAGE(PG8_SA(1, 0), cA + kstep, voffA); PG8_STAGE(PG8_SB(1, 1), cB + hstep + kstep, voffB);
        PG8_WAIT_V(6); PG8_BAR;
    } else {
        PG8_STAGE(PG8_SB(0, 0), cB, voffB); PG8_STAGE(PG8_SA(0, 0), cA, voffA); PG8_STAGE(PG8_SB(0, 1), cB + hstep, voffB); PG8_STAGE(PG8_SA(0, 1), cA + hstep, voffA);
        if (wr == 1) PG8_BAR;
        PG8_WAIT_V(4); PG8_BAR;
        PG8_STAGE(PG8_SB(1, 0), cB + kstep, voffB); PG8_STAGE(PG8_SA(1, 0), cA + kstep, voffA); PG8_STAGE(PG8_SB(1, 1), cB + hstep + kstep, voffB);
        PG8_WAIT_V(6); PG8_BAR;
    }
    for (;;) {
        const bool has_next = S.next(ui + 1, nxt);
        const char* nA = has_next ? (const char*)g.A + (size_t)nxt.pm * tstep + nxt.kb : cA; const char* nB = has_next ? (const char*)g.Bt + (size_t)nxt.pn * tstep + nxt.kb : cB;
        for (int t = 0; t < nt; t += 2) {
            const bool last = (t == nt - 2);
            const char* a1 = cA + (size_t)(t + 1) * kstep;
            const char* a2 = last ? nA : cA + (size_t)(t + 2) * kstep; const char* b2 = last ? nB : cB + (size_t)(t + 2) * kstep;
            const char* a3 = a2 + kstep; const char* b3 = b2 + kstep;
            if (last && has_next) S.a_ready(nxt);
            if constexpr (SP2) {
            PG8_LDB(B0, 0, 0); PG8_LDB(B1, 0, 1); PG8_SCHED; PG8_LDA(At, 0, 0); PG8_STAGE(PG8_SA(1, 1), a1 + hstep, voffA);
            PG8_WAIT_V(8); PG8_WAIT_L(0); PG8_BAR; PG8_MMA(0, 0, At, B0); PG8_MMA(0, 1, At, B1); PG8_BAR; PG8_SCHED;
            PG8_LDA(At, 0, 1); PG8_STAGE(PG8_SB(0, 0), b2, voffB); PG8_STAGE(PG8_SB(0, 1), b2 + hstep, voffB); PG8_STAGE(PG8_SA(0, 0), a2, voffA);
            PG8_WAIT_V(8); PG8_WAIT_L(0); PG8_BAR; PG8_MMA(1, 0, At, B0); PG8_MMA(1, 1, At, B1); PG8_BAR; PG8_SCHED;
            PG8_LDB(B0, 1, 0); PG8_LDB(B1, 1, 1); PG8_SCHED; PG8_LDA(At, 1, 0); PG8_STAGE(PG8_SA(0, 1), a2 + hstep, voffA);
            PG8_WAIT_V(8); PG8_WAIT_L(0); PG8_BAR; PG8_MMA(0, 0, At, B0); PG8_MMA(0, 1, At, B1); PG8_BAR; PG8_SCHED;
            PG8_LDA(At, 1, 1); PG8_STAGE(PG8_SB(1, 0), b3, voffB); PG8_STAGE(PG8_SB(1, 1), b3 + hstep, voffB); PG8_STAGE(PG8_SA(1, 0), a3, voffA);
            PG8_WAIT_V(8); PG8_WAIT_L(0); PG8_BAR; PG8_MMA(1, 0, At, B0); PG8_MMA(1, 1, At, B1); PG8_BAR; PG8_SCHED;
            } else {
            PG8_LDB(B0, 0, 0); PG8_SCHED; PG8_LDA(At, 0, 0); PG8_STAGE(PG8_SA(1, 1), a1 + hstep, voffA);
            PG8_WAIT_L(8); PG8_BAR; PG8_WAIT_L(0); PG8_MMA(0, 0, At, B0); PG8_BAR; PG8_SCHED;
            PG8_LDB(B1, 0, 1); PG8_STAGE(PG8_SB(0, 0), b2, voffB);
            PG8_BAR; PG8_WAIT_L(0); PG8_MMA(0, 1, At, B1); PG8_BAR;
            PG8_LDA(At, 0, 1); PG8_STAGE(PG8_SA(0, 0), a2, voffA);
            PG8_BAR; PG8_WAIT_L(0); PG8_MMA(1, 0, At, B0); PG8_BAR; PG8_SCHED;
            PG8_STAGE(PG8_SB(0, 1), b2 + hstep, voffB);
            PG8_WAIT_V(6); PG8_BAR; PG8_MMA(1, 1, At, B1); PG8_BAR;
            PG8_LDB(B0, 1, 0); PG8_SCHED; PG8_LDA(At, 1, 0); PG8_STAGE(PG8_SA(0, 1), a2 + hstep, voffA);
            PG8_WAIT_L(8); PG8_BAR; PG8_WAIT_L(0); PG8_MMA(0, 0, At, B0); PG8_BAR; PG8_SCHED;
            PG8_LDB(B1, 1, 1); PG8_STAGE(PG8_SB(1, 0), b3, voffB);
            PG8_BAR; PG8_WAIT_L(0); PG8_MMA(0, 1, At, B1); PG8_BAR;
            PG8_LDA(At, 1, 1); PG8_STAGE(PG8_SA(1, 0), a3, voffA);
            PG8_BAR; PG8_WAIT_L(0); PG8_MMA(1, 0, At, B0); PG8_BAR; PG8_SCHED;
            PG8_STAGE(PG8_SB(1, 1), b3 + hstep, voffB);
            PG8_WAIT_V(6); PG8_BAR; PG8_MMA(1, 1, At, B1); PG8_BAR;
            }
        }
        if constexpr (ALIGN_EPI) { if (wr == 0) PG8_BAR; }
        if constexpr (!Epi::AFTER_DRAIN) { E(acc, cur, wr, wc, fr, fq); S.done(cur); }
        if (!has_next) break;
#pragma unroll
        for (int a = 0; a < 2; ++a)
#pragma unroll
            for (int b = 0; b < 2; ++b)
#pragma unroll
                for (int m = 0; m < 4; ++m)
#pragma unroll
                    for (int n = 0; n < 2; ++n) acc[a][b][m][n] = (f32x4){0.f, 0.f, 0.f, 0.f};
        cur = nxt; cA = nA; cB = nB; nt = cur.nt; ++ui;
        if constexpr (ALIGN_EPI) { if (wr == 1) PG8_BAR; }
    }
    PG8_WAIT_V(0);
    if constexpr (!ALIGN_EPI) { if (wr == 0) PG8_BAR; }
    PG8_BAR;
    if constexpr (Epi::AFTER_DRAIN) { E.fused(acc, cur, wr, wc, fr, fq, lds, wid, lane); S.done(cur); }
#undef PG8_SA
#undef PG8_SB
#undef PG8_STAGE
#undef PG8_LDA
#undef PG8_LDB
#undef PG8_MMA
#undef PG8_WAIT_V
#undef PG8_WAIT_L
#undef PG8_BAR
#undef PG8_SCHED
}
}
constexpr int NWAVES = 8;
constexpr int RP = 16384, RS = 1024, R = RP + RS;
constexpr int DM = 2048, DFF = 5632, DFF2 = 11264, BPROJ = 4176, NBP = 4352;
constexpr float EPS = 1e-6f;
constexpr float QSCALE = 0.08838834764831845f * 1.4426950408889634f;
constexpr size_t OFF_Y = 0, OFF_KP = 35651584, OFF_VP = 44040192, OFF_IKP = 52428800, OFF_KS = 53477376, OFF_VS = 54001664, OFF_IKS = 54525952,
                 OFF_CV = 54591488, OFF_CP = 56688640, OFF_CS = 57049088, OUT_TOTAL = 62816256;
constexpr size_t CTL_BYTES = 1u << 20;
constexpr size_t WS_WAIN = CTL_BYTES;
constexpr size_t WS_WAOUT = WS_WAIN + (size_t)4096 * 2048 * 2;
constexpr size_t WS_WBIN = WS_WAOUT + (size_t)2048 * 2048 * 2;
constexpr size_t WS_WBO = WS_WBIN + (size_t)NBP * 2048 * 2;
constexpr size_t WS_WFIN = WS_WBO + (size_t)2048 * 2048 * 2;
constexpr size_t WS_WFOUT = WS_WFIN + (size_t)2 * DFF2 * 2048 * 2;
constexpr size_t WS_XB = WS_WFOUT + (size_t)2 * 2048 * DFF * 2;
constexpr size_t WS_SS = WS_XB + (size_t)R * 2048 * 2;
constexpr size_t WS_XA = WS_SS + (size_t)R * 32 * 4;
constexpr size_t WS_U = WS_XA + (size_t)R * 2048 * 4;
constexpr size_t WS_V = WS_U + (size_t)R * 2048 * 2;
constexpr size_t WS_VSS = WS_V + (size_t)R * 2048 * 2;
constexpr size_t WS_GT = WS_VSS + (size_t)R * 32 * 4;
constexpr size_t WS_AB = WS_GT + (size_t)R * 2048 * 2;
constexpr size_t WS_HID = WS_AB + (size_t)R * DFF2 * 2;
constexpr size_t WS_P = WS_HID + (size_t)R * DFF * 2;
constexpr size_t WS_Q = WS_P + (size_t)R * NBP * 2;
constexpr size_t WS_KB = WS_Q + (size_t)R * 2048 * 2;
constexpr size_t WS_VB = WS_KB + (size_t)R * 512 * 2;
constexpr size_t WS_IQ = WS_VB + (size_t)R * 512 * 2;
constexpr size_t WS_IK = WS_IQ + (size_t)R * 1024 * 2;
constexpr size_t WS_IW = WS_IK + (size_t)R * 64 * 2;
constexpr size_t WS_ROPE = WS_IW + (size_t)R * 16 * 4;
constexpr size_t WS_SC = WS_ROPE + (size_t)2056 * 96 * 2 * 4;
constexpr size_t WS_SCS = WS_SC + (size_t)RP * 2048 * 4;
constexpr size_t WS_MASK = WS_SCS + (size_t)RS * 2112 * 4;
constexpr size_t WS_O = WS_MASK + (size_t)R * 34 * 8;
constexpr size_t WS_SLAB = WS_O + (size_t)R * 2048 * 2;
constexpr size_t WS_RSTD = WS_SLAB + (size_t)16384 * 1024 * 4;
constexpr size_t WS_END = WS_RSTD + (size_t)R * 4;
constexpr int CW_BAR = 4096;
constexpr int CW_WQ = 8192;
constexpr int CW_CHK = 16384;
constexpr int LDS_BYTES = 147456;
constexpr int MISC_OFF = 147456 - 512;

#define GAS __attribute__((address_space(1)))
#define LAS __attribute__((address_space(3)))
#define DI __device__ __forceinline__
typedef unsigned short bf16;
typedef unsigned v4u __attribute__((ext_vector_type(4)));
typedef unsigned v2u __attribute__((ext_vector_type(2)));
typedef float f32x4 __attribute__((ext_vector_type(4)));
typedef float f32x16 __attribute__((ext_vector_type(16)));
typedef short bf16x8 __attribute__((ext_vector_type(8)));
typedef GAS unsigned gu32;
#define RLX_AGENT __ATOMIC_RELAXED, __HIP_MEMORY_SCOPE_AGENT
#define LDS_WAIT() asm volatile("s_waitcnt lgkmcnt(0)" ::: "memory")
#define MFMA32(a, b, c) __builtin_amdgcn_mfma_f32_32x32x16_bf16((a), (b), (c), 0, 0, 0)
#define MFMA16(a, b, c) __builtin_amdgcn_mfma_f32_16x16x32_bf16((a), (b), (c), 0, 0, 0)
DI float bf2f(unsigned short h) { return __uint_as_float(((unsigned)h) << 16); }
DI float bflo(unsigned w) { return __uint_as_float(w << 16); }
DI float bfhi(unsigned w) { return __uint_as_float(w & 0xffff0000u); }
DI unsigned pk2(float lo, float hi) { return pg8::cvt_pk_bf16(lo, hi); }
DI unsigned short f2bf(float f) { return (unsigned short)(pk2(f, 0.f) & 0xffffu); }
DI float wave_sum(float v) {
#pragma unroll
    for (int o = 1; o < 64; o <<= 1) v += __shfl_xor(v, o);
    return v;
}
DI float fexp2(float x) { return __builtin_amdgcn_exp2f(x); }
#define XB_TMO      128
#define XB_XCNT(j)  (256  + 64 * (j))
#define XB_XSUB(j)  (1280 + 64 * (j))
#define XB_XGEN(j)  (2304 + 64 * (j))
#define XB_TOP      3328
#define XB_TOPGEN   3392
#define XCD_BAR_WORDS 3456
#define XB_SPIN_CAP (1u << 18)

__device__ __forceinline__ unsigned xb_ld(unsigned* p)              { return __hip_atomic_load(p, __ATOMIC_RELAXED, __HIP_MEMORY_SCOPE_AGENT); }
__device__ __forceinline__ unsigned xb_add(unsigned* p, unsigned v) { return __hip_atomic_fetch_add(p, v, __ATOMIC_RELAXED, __HIP_MEMORY_SCOPE_AGENT); }
__device__ __forceinline__ unsigned xb_xcc_id() { return (unsigned)__builtin_amdgcn_s_getreg((3 << 11) | 20) & 0xFu; }
#define XB_SPIN(cond, bar) do { unsigned _sp = 0; while (cond) { __builtin_amdgcn_s_sleep(1); \
    if ((++_sp & 255u) == 0u) { if (xb_ld(&(bar)[XB_TMO])) break; if (_sp > XB_SPIN_CAP) { atomicAdd(&(bar)[XB_TMO], 1u); break; } } } } while (0)

struct XcdBarrier {
    unsigned* bar; unsigned x;
    volatile LAS unsigned* st;
};

__device__ __forceinline__ XcdBarrier xcd_barrier_post(unsigned* bar, volatile LAS unsigned* st) {
    XcdBarrier b; b.bar = bar; b.x = xb_xcc_id(); b.st = st;
    if (threadIdx.x == 0) (void)xb_add(&bar[XB_XCNT(b.x)], 1u);
    return b;
}
__device__ __forceinline__ void xcd_barrier_complete(unsigned* bar, unsigned x, unsigned& nloc, unsigned& nx) {
    const unsigned G = gridDim.x * gridDim.y * gridDim.z;
    unsigned sum, cnt, mine, sp = 0u;
    for (;;) {
        sum = 0u; cnt = 0u; mine = 0u;
#pragma unroll
        for (unsigned j = 0; j < 16; ++j) { const unsigned c = xb_ld(&bar[XB_XCNT(j)]); sum += c; cnt += (c > 0u) ? 1u : 0u; mine = (j == x) ? c : mine; }
        if (sum == G) break;
        __builtin_amdgcn_s_sleep(1);
        if ((++sp & 255u) == 0u) { if (xb_ld(&bar[XB_TMO])) break; if (sp > XB_SPIN_CAP) { atomicAdd(&bar[XB_TMO], 1u); break; } }
    }
    nloc = mine > 0u ? mine : 1u; nx = cnt > 0u ? cnt : 1u;
}

__device__ __forceinline__ void xcd_barrier(const XcdBarrier& b) {
    asm volatile("s_waitcnt vmcnt(0)" ::: "memory");
    __syncthreads();
    if (threadIdx.x == 0) {
        unsigned* bar = b.bar;
        __builtin_amdgcn_s_waitcnt(0);
        unsigned nloc = b.st[0], nx = b.st[1];
        if (nloc == 0u) { xcd_barrier_complete(bar, b.x, nloc, nx); b.st[0] = nloc; b.st[1] = nx; }
        const unsigned old = xb_add(&bar[XB_XSUB(b.x)], 1u);
        const unsigned gen = old / nloc;
        if (old + 1u == (gen + 1u) * nloc) {
            __builtin_amdgcn_fence(__ATOMIC_RELEASE, "agent");
            asm volatile("s_waitcnt vmcnt(0)" ::: "memory");
            const unsigned og = xb_add(&bar[XB_TOP], 1u);
            const unsigned tg = og / nx;
            if (og + 1u == (tg + 1u) * nx) xb_add(&bar[XB_TOPGEN], 1u);
            else XB_SPIN(xb_ld(&bar[XB_TOPGEN]) == tg, bar);
            __builtin_amdgcn_fence(__ATOMIC_ACQUIRE, "agent");
            xb_add(&bar[XB_XGEN(b.x)], 1u);
            asm volatile("s_waitcnt vmcnt(0)" ::: "memory");
        } else {
            XB_SPIN(xb_ld(&bar[XB_XGEN(b.x)]) == gen, bar);
            __builtin_amdgcn_fence(__ATOMIC_ACQUIRE, "agent");
            asm volatile("s_waitcnt vmcnt(0)" ::: "memory");
        }
    }
    __syncthreads();
}
struct Args { const float* in[23]; float* out; unsigned char* ws; int ph_lo, ph_hi; };
struct Ctx { LAS unsigned char* lds; int tid, lane, wave, G, bx; };

DI void p0_transpose_item(const float* W, const float* gain, int K, int N, int Npad, bf16* WT, LAS float* scr, int item, int lane, bool permF = false) {
    const int nblk = Npad / 64, kb = item / nblk, nb = item % nblk, k0 = 64 * kb, n0 = 64 * nb;
    const int l15 = lane & 15, kq = lane >> 4, n = n0 + 4 * l15;
    const int nout0 = !permF ? n0 : (n0 < 5632 ? 256 * (n0 >> 7) + (n0 & 127) : 256 * ((n0 - 5632) >> 7) + 128 + ((n0 - 5632) & 127));
    f32x4 v[16];
#pragma unroll
    for (int i = 0; i < 16; ++i) { v[i] = (f32x4){0.f, 0.f, 0.f, 0.f}; if (n < N) v[i] = *(const f32x4*)(W + (size_t)(k0 + 4 * i + kq) * N + n); }
    if (gain) {
#pragma unroll
        for (int i = 0; i < 16; ++i) v[i] *= gain[k0 + 4 * i + kq]; }
#pragma unroll
    for (int i = 0; i < 16; ++i) { LAS float* d = scr + (4 * i + kq) * 65 + 4 * l15; d[0] = v[i][0]; d[1] = v[i][1]; d[2] = v[i][2]; d[3] = v[i][3]; }
    LDS_WAIT(); asm volatile("" ::: "memory");
    const int c = lane & 7;
#pragma unroll
    for (int j = 0; j < 8; ++j) { const int nn = (lane >> 3) + 8 * j; const LAS float* s = scr + (8 * c) * 65 + nn;
        v4u o; o.x = pk2(s[0 * 65], s[1 * 65]); o.y = pk2(s[2 * 65], s[3 * 65]); o.z = pk2(s[4 * 65], s[5 * 65]); o.w = pk2(s[6 * 65], s[7 * 65]);
        *(GAS v4u*)(WT + (size_t)(nout0 + nn) * K + k0 + 8 * c) = o; }
    LDS_WAIT(); asm volatile("" ::: "memory");
}
DI void sincos_small(double r, double& s, double& c) {
    const double r2 = r * r;
    double ts = 1.0 / 51090942171709440000.0;
    ts = ts * r2 * (-1.0) + 1.0 / 121645100408832000.0;
    ts = ts * (-r2) + 1.0 / 355687428096000.0;
    ts = ts * (-r2) + 1.0 / 1307674368000.0;
    ts = ts * (-r2) + 1.0 / 6227020800.0;
    ts = ts * (-r2) + 1.0 / 39916800.0;
    ts = ts * (-r2) + 1.0 / 362880.0;
    ts = ts * (-r2) + 1.0 / 5040.0;
    ts = ts * (-r2) + 1.0 / 120.0;
    ts = ts * (-r2) + 1.0 / 6.0;
    ts = ts * (-r2) + 1.0;
    s = ts * r;
    double tc = 1.0 / 2432902008176640000.0;
    tc = tc * (-r2) + 1.0 / 6402373705728000.0;
    tc = tc * (-r2) + 1.0 / 20922789888000.0;
    tc = tc * (-r2) + 1.0 / 87178291200.0;
    tc = tc * (-r2) + 1.0 / 479001600.0;
    tc = tc * (-r2) + 1.0 / 3628800.0;
    tc = tc * (-r2) + 1.0 / 40320.0;
    tc = tc * (-r2) + 1.0 / 720.0;
    tc = tc * (-r2) + 1.0 / 24.0;
    tc = tc * (-r2) + 1.0 / 2.0;
    tc = tc * (-r2) + 1.0;
    c = tc;
}
DI void ph_prologue(const Args& a, const Ctx& C) {
    unsigned char* ws = a.ws;
    LAS float* scr = (LAS float*)(C.lds + C.wave * 16640);
    const int gw = C.bx * NWAVES + C.wave, NGW = C.G * NWAVES;
    constexpr int I_AIN = 32 * 64, I_AOUT = 32 * 32, I_FIN = 32 * (DFF2 / 64), I_BIN = 32 * (NBP / 64), I_FIN1B = I_FIN / 2;
    constexpr int NITEMS = I_AIN + I_AOUT + I_FIN + I_BIN + I_FIN1B;
    for (int it = gw; it < NITEMS; it += NGW) {
        int r = it;
        if (r < I_AIN) { p0_transpose_item(a.in[8], a.in[7], 2048, 4096, 4096, (bf16*)(ws + WS_WAIN), scr, r, C.lane); continue; } r -= I_AIN;
        if (r < I_AOUT) { p0_transpose_item(a.in[12], nullptr, 2048, 2048, 2048, (bf16*)(ws + WS_WAOUT), scr, r, C.lane); continue; } r -= I_AOUT;
        if (r < I_FIN) { p0_transpose_item(a.in[19], a.in[18], 2048, DFF2, DFF2, (bf16*)(ws + WS_WFIN), scr, r, C.lane, true); continue; } r -= I_FIN;
        if (r < I_BIN) { p0_transpose_item(a.in[14], a.in[13], 2048, BPROJ, NBP, (bf16*)(ws + WS_WBIN), scr, r, C.lane); continue; } r -= I_BIN;
        p0_transpose_item(a.in[19] + (size_t)2048 * DFF2, a.in[18] + 2048, 2048, DFF2, DFF2, (bf16*)(ws + WS_WFIN) + (size_t)DFF2 * 2048, scr, I_FIN1B + r, C.lane, true);
    }
    bf16* XB = (bf16*)(ws + WS_XB); float* SS = (float*)(ws + WS_SS);
    for (int row = gw; row < R; row += NGW) {
        const float* src = row < RP ? a.in[0] + (size_t)row * 2048 : a.in[1] + (size_t)(row - RP) * 2048;
        const GAS f32x4* xr = (const GAS f32x4*)src + C.lane; float s = 0.f;
        GAS v2u* o8 = (GAS v2u*)(XB + (size_t)row * 2048) + C.lane;
#pragma unroll
        for (int j = 0; j < 8; ++j) { const f32x4 v = xr[64 * j]; s += (v[0] * v[0] + v[1] * v[1]) + (v[2] * v[2] + v[3] * v[3]); v2u w; w.x = pk2(v[0], v[1]); w.y = pk2(v[2], v[3]); o8[64 * j] = w; }
        s = wave_sum(s);
        if (C.lane < 32) SS[(size_t)row * 32 + C.lane] = C.lane == 0 ? s : 0.f;
        if (C.lane == 0) ((float*)(ws + WS_RSTD))[row] = 1.0f / sqrtf(s * (1.0f / 2048.0f) + EPS);
    }
    float* rope = (float*)(ws + WS_ROPE);
    for (int idx = C.bx * 512 + C.tid; idx < 2056 * 96; idx += C.G * 512) {
        const int pos = idx / 96, i = idx % 96;
        const float ex = i < 64 ? (float)i * (2.0f / 128.0f) : (float)(i - 64) * (2.0f / 64.0f);
        const float inv = exp2f(-ex * 13.287712379549449f);
        const double ang = (double)pos * (double)inv;
        const double k = __builtin_rint(ang * 0.15915494309189535);
        const double rr = ang - k * 6.283185307179586;
        double sn, cs; sincos_small(rr, sn, cs);
        rope[2 * idx] = (float)cs; rope[2 * idx + 1] = (float)sn;
    }
}

constexpr int FQ_FOUT = (DFF / 64) * 32, FQ_BO = 32 * 32, FQ_FIN1A = 32 * (DFF2 / 64) / 2;
DI void filler_pull(const Args& a, const Ctx& C, int q) {
    unsigned char* ws = a.ws; gu32* head = (gu32*)ws + CW_WQ + 64 * (8 + q);
    LAS float* scr = (LAS float*)(C.lds + C.wave * 16640);
    const int n = q == 1 ? FQ_BO + FQ_FIN1A : FQ_FOUT;
    for (;;) {
        int it = 0; if (C.lane == 0) it = (int)__hip_atomic_fetch_add(head, 1u, RLX_AGENT);
        it = __builtin_amdgcn_readfirstlane(it);
        if (it >= n) break;
        if (q == 0) p0_transpose_item(a.in[22], nullptr, DFF, 2048, 2048, (bf16*)(ws + WS_WFOUT), scr, it, C.lane);
        else if (q == 2) p0_transpose_item(a.in[22] + (size_t)DFF * 2048, nullptr, DFF, 2048, 2048, (bf16*)(ws + WS_WFOUT) + (size_t)2048 * DFF, scr, it, C.lane);
        else { if (it < FQ_BO) p0_transpose_item(a.in[17], nullptr, 2048, 2048, 2048, (bf16*)(ws + WS_WBO), scr, it, C.lane);
               else p0_transpose_item(a.in[19] + (size_t)2048 * DFF2, a.in[18] + 2048, 2048, DFF2, DFF2, (bf16*)(ws + WS_WFIN) + (size_t)DFF2 * 2048, scr, it - FQ_BO, C.lane, true); }
    }
}
DI float rstd32(const float* p) { const f32x4* q = (const f32x4*)p; f32x4 a = q[0];
#pragma unroll
    for (int i = 1; i < 8; ++i) a += q[i];
    return 1.0f / sqrtf(((a[0] + a[1]) + (a[2] + a[3])) * (1.0f / 2048.0f) + EPS); }
DI void ph_gate(const Args& a, const Ctx& C) {
    unsigned char* ws = a.ws;
    const bf16* V = (const bf16*)(ws + WS_V); const bf16* U = (const bf16*)(ws + WS_U); bf16* GT = (bf16*)(ws + WS_GT); const float* vss = (const float*)(ws + WS_VSS);
    const float* vgain = a.in[9]; const float* Ws = a.in[10]; const float* bs = a.in[11];
    LAS unsigned char* vt = C.lds;
    LAS float* rsv = (LAS float*)(C.lds + 36864);
    const int l15 = C.lane & 15, kq = C.lane >> 4;
    int gcur = -1; bf16x8 wf[4];
#pragma unroll
    for (int kk = 0; kk < 4; ++kk) wf[kk] = (bf16x8){0, 0, 0, 0, 0, 0, 0, 0};
    v4u vraw[4]; v2u ureg[8]; f32x4 ssr[8];
#define G_LOAD(u_) do { const int g_ = (u_) & 15, r0_ = ((u_) >> 4) * 128; \
        _Pragma("unroll") for (int it = 0; it < 2; ++it) { const int ix_ = C.wave + 8 * it, p_ = 16 * (ix_ & 3) + l15, c_ = 4 * (ix_ >> 2) + kq; \
            vraw[2 * it] = *(const v4u*)(V + (size_t)(r0_ + 2 * p_) * 2048 + g_ * 128 + c_ * 8); vraw[2 * it + 1] = *(const v4u*)(V + (size_t)(r0_ + 2 * p_ + 1) * 2048 + g_ * 128 + c_ * 8); } \
        if (C.tid < 128) { _Pragma("unroll") for (int q = 0; q < 8; ++q) ssr[q] = *(const f32x4*)(vss + (size_t)(r0_ + C.tid) * 32 + 4 * q); } \
        _Pragma("unroll") for (int db = 0; db < 8; ++db) ureg[db] = *(const v2u*)(U + (size_t)(r0_ + 16 * C.wave + l15) * 2048 + g_ * 128 + db * 16 + 4 * kq); } while (0)
    if (C.bx < 2048) G_LOAD(C.bx);
    for (int u = C.bx; u < 2048; u += C.G) {
        const int g = u & 15, chunk = u >> 4, r0 = chunk * 128;
        if (g != gcur) { gcur = g; const int t = 16 * C.wave + l15;
#pragma unroll
            for (int kk = 0; kk < 4; ++kk) { const int s0 = 32 * kk + 8 * kq; const float* wp = Ws + ((size_t)g * 128 + t) * 128 + s0;
                const f32x4 w0 = *(const f32x4*)wp, w1 = *(const f32x4*)(wp + 4); v4u o;
                o.x = pk2(s0 + 0 <= t ? w0[0] : 0.f, s0 + 1 <= t ? w0[1] : 0.f); o.y = pk2(s0 + 2 <= t ? w0[2] : 0.f, s0 + 3 <= t ? w0[3] : 0.f);
                o.z = pk2(s0 + 4 <= t ? w1[0] : 0.f, s0 + 5 <= t ? w1[1] : 0.f); o.w = pk2(s0 + 6 <= t ? w1[2] : 0.f, s0 + 7 <= t ? w1[3] : 0.f);
                wf[kk] = __builtin_bit_cast(bf16x8, o); } }
        if (C.tid < 128) { f32x4 a4 = ssr[0];
#pragma unroll
            for (int q = 1; q < 8; ++q) a4 += ssr[q];
            rsv[C.tid] = 1.0f / sqrtf(((a4[0] + a4[1]) + (a4[2] + a4[3])) * (1.0f / 2048.0f) + EPS); }
        __syncthreads();
#pragma unroll
        for (int it = 0; it < 2; ++it) { const int ix = C.wave + 8 * it, p = 16 * (ix & 3) + l15, c = 4 * (ix >> 2) + kq;
            const v4u ra = vraw[2 * it], rb = vraw[2 * it + 1]; const float rsa = rsv[2 * p], rsb = rsv[2 * p + 1];
            const f32x4 g0 = *(const f32x4*)(vgain + g * 128 + c * 8), g1 = *(const f32x4*)(vgain + g * 128 + c * 8 + 4);
            const float xa[8] = {bflo(ra.x) * g0[0], bfhi(ra.x) * g0[1], bflo(ra.y) * g0[2], bfhi(ra.y) * g0[3], bflo(ra.z) * g1[0], bfhi(ra.z) * g1[1], bflo(ra.w) * g1[2], bfhi(ra.w) * g1[3]};
            const float xb_[8] = {bflo(rb.x) * g0[0], bfhi(rb.x) * g0[1], bflo(rb.y) * g0[2], bfhi(rb.y) * g0[3], bflo(rb.z) * g1[0], bfhi(rb.z) * g1[1], bflo(rb.w) * g1[2], bfhi(rb.w) * g1[3]};
#pragma unroll
            for (int i = 0; i < 8; ++i) *(LAS unsigned*)(vt + (c * 8 + i) * 272 + p * 4) = pk2(xa[i] * rsa, xb_[i] * rsb); }
        v2u ucur[8];
#pragma unroll
        for (int db = 0; db < 8; ++db) ucur[db] = ureg[db];
        __syncthreads();
        if (u + C.G < 2048) G_LOAD(u + C.G);
        __builtin_amdgcn_sched_barrier(0);
        const int t = 16 * C.wave + l15, row = r0 + t; const float bias = bs[g * 128 + t];
#pragma unroll
        for (int db = 0; db < 8; ++db) { f32x4 acc = {0.f, 0.f, 0.f, 0.f};
#pragma unroll
            for (int kk = 0; kk < 4; ++kk) if (kk <= (C.wave >> 1)) { const bf16x8 av = *(const LAS bf16x8*)(vt + (db * 16 + l15) * 272 + (kk * 32 + kq * 8) * 2); acc = MFMA16(av, wf[kk], acc); }
            const size_t off = (size_t)row * 2048 + g * 128 + db * 16 + 4 * kq;
            const v2u uu = ucur[db]; v2u o;
            o.x = pk2(bflo(uu.x) * (acc[0] + bias), bfhi(uu.x) * (acc[1] + bias)); o.y = pk2(bflo(uu.y) * (acc[2] + bias), bfhi(uu.y) * (acc[3] + bias));
            *(v2u*)(GT + off) = o; }
        __syncthreads();
    }
#undef G_LOAD
    float* cvout = a.out + OFF_CV;
    for (int us = C.bx; us < 32; us += C.G) {
        const int r0 = RP + 32 * us;
        if (C.tid < 32) rsv[C.tid] = rstd32(vss + (size_t)(r0 + C.tid) * 32);
        __syncthreads();
#pragma unroll 1
        for (int it = 0; it < 2; ++it) { const int id = C.tid + 512 * it, bl = id >> 8, c = id & 255, col = c * 8, g = col >> 7;
            const f32x4 g0 = *(const f32x4*)(vgain + col), g1 = *(const f32x4*)(vgain + col + 4);
            float vn[8][8];
#pragma unroll
            for (int t = 0; t < 8; ++t) { const size_t off = (size_t)(r0 + 8 * bl + t) * 2048 + col; const v4u raw = *(const v4u*)(V + off); const float rs = rsv[8 * bl + t];
                vn[t][0] = bflo(raw.x) * rs * g0[0]; vn[t][1] = bfhi(raw.x) * rs * g0[1]; vn[t][2] = bflo(raw.y) * rs * g0[2]; vn[t][3] = bfhi(raw.y) * rs * g0[3];
                vn[t][4] = bflo(raw.z) * rs * g1[0]; vn[t][5] = bfhi(raw.z) * rs * g1[1]; vn[t][6] = bflo(raw.w) * rs * g1[2]; vn[t][7] = bfhi(raw.w) * rs * g1[3];
                float* co = cvout + (size_t)(32 * us + 8 * bl + t) * 2048 + col;
                *(f32x4*)co = (f32x4){vn[t][0], vn[t][1], vn[t][2], vn[t][3]}; *(f32x4*)(co + 4) = (f32x4){vn[t][4], vn[t][5], vn[t][6], vn[t][7]}; }
#pragma unroll
            for (int t = 0; t < 8; ++t) { float s[8]; const float bias = bs[g * 128 + t];
#pragma unroll
                for (int i = 0; i < 8; ++i) s[i] = bias;
#pragma unroll
                for (int sp = 0; sp <= t; ++sp) { const float wv = Ws[((size_t)g * 128 + t) * 128 + sp];
#pragma unroll
                    for (int i = 0; i < 8; ++i) s[i] += wv * vn[sp][i]; }
                const size_t off = (size_t)(r0 + 8 * bl + t) * 2048 + col; const v4u uu = *(const v4u*)(U + off); v4u o;
                o.x = pk2(bflo(uu.x) * s[0], bfhi(uu.x) * s[1]); o.y = pk2(bflo(uu.y) * s[2], bfhi(uu.y) * s[3]); o.z = pk2(bflo(uu.z) * s[4], bfhi(uu.z) * s[5]); o.w = pk2(bflo(uu.w) * s[6], bfhi(uu.w) * s[7]);
                *(v4u*)(GT + off) = o; } }
        __syncthreads();
    }
}
DI void up8(const v4u& r, float (&x)[8]) { x[0] = bflo(r.x); x[1] = bfhi(r.x); x[2] = bflo(r.y); x[3] = bfhi(r.y); x[4] = bflo(r.z); x[5] = bfhi(r.z); x[6] = bflo(r.w); x[7] = bfhi(r.w); }
DI void ld8(const float* p, float (&x)[8]) { const f32x4 a = *(const f32x4*)p, b = *(const f32x4*)(p + 4); x[0] = a[0]; x[1] = a[1]; x[2] = a[2]; x[3] = a[3]; x[4] = b[0]; x[5] = b[1]; x[6] = b[2]; x[7] = b[3]; }
DI void ph_conv(const Args& a, const Ctx& C, int layer) {
    unsigned char* ws = a.ws;
    const bf16* AB = (const bf16*)(ws + WS_AB); bf16* HID = (bf16*)(ws + WS_HID);
    const float* cw = a.in[20] + (size_t)layer * 3 * DFF2; const float* cb = a.in[21] + (size_t)layer * DFF2; const float* st = a.in[5] + (size_t)layer * 128 * 2 * DFF2;
    constexpr int NCC = DFF / 8, NBLK = 128 + 64;
    for (int item = C.bx * 512 + C.tid; item < NBLK * NCC; item += C.G * 512) {
        const int blk = item / NCC, cc = item % NCC, col = cc * 8;
        const int r0 = blk < 128 ? RP + 8 * blk : 256 * (blk - 128), nrows = blk < 128 ? 8 : 2;
        float w0g[8], w1g[8], w2g[8], bg[8], w0u[8], w1u[8], w2u[8], bu[8];
        ld8(cw + col, w0g); ld8(cw + DFF2 + col, w1g); ld8(cw + 2 * DFF2 + col, w2g); ld8(cb + col, bg);
        ld8(cw + DFF + col, w0u); ld8(cw + DFF2 + DFF + col, w1u); ld8(cw + 2 * DFF2 + DFF + col, w2u); ld8(cb + DFF + col, bu);
        float g1[8], g2[8], u1[8], u2[8];
#pragma unroll
        for (int i = 0; i < 8; ++i) { g1[i] = 0.f; g2[i] = 0.f; u1[i] = 0.f; u2[i] = 0.f; }
        if (r0 < RP && (r0 & 2047) != 0) {
            up8(*(const v4u*)(AB + (size_t)(r0 - 1) * DFF2 + col), g1); up8(*(const v4u*)(AB + (size_t)(r0 - 2) * DFF2 + col), g2);
            up8(*(const v4u*)(AB + (size_t)(r0 - 1) * DFF2 + DFF + col), u1); up8(*(const v4u*)(AB + (size_t)(r0 - 2) * DFF2 + DFF + col), u2); }
#pragma unroll 1
        for (int r4 = 0; r4 < nrows; r4 += 4) {
            v4u ga[4], ua[4];
#pragma unroll
            for (int q = 0; q < 4; ++q) { const int rq = r0 + (r4 + q < nrows ? r4 + q : nrows - 1); ga[q] = *(const v4u*)(AB + (size_t)rq * DFF2 + col); ua[q] = *(const v4u*)(AB + (size_t)rq * DFF2 + DFF + col); }
            if (r0 >= RP && (r4 & 7) == 0) { const int b = (r0 + r4 - RP) >> 3;
                ld8(st + (size_t)(b * 2 + 0) * DFF2 + col, g2); ld8(st + (size_t)(b * 2 + 1) * DFF2 + col, g1);
                ld8(st + (size_t)(b * 2 + 0) * DFF2 + DFF + col, u2); ld8(st + (size_t)(b * 2 + 1) * DFF2 + DFF + col, u1); }
#pragma unroll
            for (int q = 0; q < 4; ++q) { const int row = r0 + r4 + q;
                float g0[8], u0[8]; up8(ga[q], g0); up8(ua[q], u0);
                float h[8];
#pragma unroll
                for (int i = 0; i < 8; ++i) { const float cg = bg[i] + w0g[i] * g2[i] + w1g[i] * g1[i] + w2g[i] * g0[i], cu = bu[i] + w0u[i] * u2[i] + w1u[i] * u1[i] + w2u[i] * u0[i];
                    h[i] = cg * __builtin_amdgcn_rcpf(1.0f + fexp2(-1.4426950408889634f * cg)) * cu; g2[i] = g1[i]; g1[i] = g0[i]; u2[i] = u1[i]; u1[i] = u0[i]; }
                v4u o; o.x = pk2(h[0], h[1]); o.y = pk2(h[2], h[3]); o.z = pk2(h[4], h[5]); o.w = pk2(h[6], h[7]);
                if (r4 + q < nrows) *(v4u*)(HID + (size_t)row * DFF + col) = o; }
        }
    }
}
DI void ph_qkrope(const Args& a, const Ctx& C) {
    unsigned char* ws = a.ws;
    const bf16* P = (const bf16*)(ws + WS_P); const float* rope = (const float*)(ws + WS_ROPE);
    bf16* Q = (bf16*)(ws + WS_Q); bf16* KB = (bf16*)(ws + WS_KB); bf16* VB = (bf16*)(ws + WS_VB); bf16* IQ = (bf16*)(ws + WS_IQ); bf16* IK = (bf16*)(ws + WS_IK); float* IW = (float*)(ws + WS_IW);
    const int gw = C.bx * NWAVES + C.wave, NGW = C.G * NWAVES, lane = C.lane;
    const int sub = lane & 15, hsel = lane >> 4, sub8 = lane & 7, hsel8 = lane >> 3;
    const f32x4 qga = *(const f32x4*)(a.in[15] + 4 * sub), qgb = *(const f32x4*)(a.in[15] + 64 + 4 * sub), kga = *(const f32x4*)(a.in[16] + 4 * sub), kgb = *(const f32x4*)(a.in[16] + 64 + 4 * sub);
    struct QkRow { v2u qa[4], qb[4], ia[2], ib[2], ka, kb, ka2, kb2; v4u vraw; float wv; f32x4 t0, t1, u0, u1; };
    auto load_row = [&](int row, QkRow& L) __attribute__((always_inline)) {
        const bf16* p = P + (size_t)row * NBP;
        const int pos = row < RP ? (row & 2047) : 2048 + ((row - RP) & 7);
        const float* rt = rope + (size_t)pos * 192;
#pragma unroll
        for (int it = 0; it < 4; ++it) { L.qa[it] = *(const v2u*)(p + (4 * it + hsel) * 128 + 4 * sub); L.qb[it] = *(const v2u*)(p + (4 * it + hsel) * 128 + 64 + 4 * sub); }
        L.ka = *(const v2u*)(p + 2048 + hsel * 128 + 4 * sub); L.kb = *(const v2u*)(p + 2048 + hsel * 128 + 64 + 4 * sub);
        L.vraw = *(const v4u*)(p + 2560 + lane * 8);
#pragma unroll
        for (int it = 0; it < 2; ++it) { L.ia[it] = *(const v2u*)(p + 3072 + (8 * it + hsel8) * 64 + 4 * sub8); L.ib[it] = *(const v2u*)(p + 3072 + (8 * it + hsel8) * 64 + 32 + 4 * sub8); }
        L.ka2 = (v2u){0u, 0u}; L.kb2 = (v2u){0u, 0u}; if (lane < 8) { L.ka2 = *(const v2u*)(p + 4096 + 4 * sub8); L.kb2 = *(const v2u*)(p + 4096 + 32 + 4 * sub8); }
        L.wv = 0.f; if (lane < 16) L.wv = bf2f(p[4160 + lane]);
        L.t0 = *(const f32x4*)(rt + 8 * sub); L.t1 = *(const f32x4*)(rt + 8 * sub + 4);
        L.u0 = *(const f32x4*)(rt + 128 + 8 * sub8); L.u1 = *(const f32x4*)(rt + 128 + 8 * sub8 + 4);
    };
    auto finish_row = [&](int row, const QkRow& L) __attribute__((always_inline)) {
        float* kout = row < RP ? a.out + OFF_KP + (size_t)row * 512 : a.out + OFF_KS + (size_t)(row - RP) * 512;
        float* vout = row < RP ? a.out + OFF_VP + (size_t)row * 512 : a.out + OFF_VS + (size_t)(row - RP) * 512;
        float* ikout = row < RP ? a.out + OFF_IKP + (size_t)row * 64 : a.out + OFF_IKS + (size_t)(row - RP) * 64;
        const v2u (&qa)[4] = L.qa; const v2u (&qb)[4] = L.qb; const v2u (&ia)[2] = L.ia; const v2u (&ib)[2] = L.ib;
        const v2u ka = L.ka, kb = L.kb, ka2 = L.ka2, kb2 = L.kb2; const v4u vraw = L.vraw; const float wv = L.wv; const f32x4 t0 = L.t0, t1 = L.t1, u0 = L.u0, u1 = L.u1;
        const float cs[4] = {t0[0], t0[2], t1[0], t1[2]}, sn[4] = {t0[1], t0[3], t1[1], t1[3]};
        const float cs8[4] = {u0[0], u0[2], u1[0], u1[2]}, sn8[4] = {u0[1], u0[3], u1[1], u1[3]};
#pragma unroll
        for (int it = 0; it < 4; ++it) {
            const float x1[4] = {bflo(qa[it].x), bfhi(qa[it].x), bflo(qa[it].y), bfhi(qa[it].y)}, x2[4] = {bflo(qb[it].x), bfhi(qb[it].x), bflo(qb[it].y), bfhi(qb[it].y)};
            float ss = 0.f;
#pragma unroll
            for (int e = 0; e < 4; ++e) ss += x1[e] * x1[e] + x2[e] * x2[e];
            ss += __shfl_xor(ss, 1); ss += __shfl_xor(ss, 2); ss += __shfl_xor(ss, 4); ss += __shfl_xor(ss, 8);
            const float rs = QSCALE / sqrtf(ss * (1.0f / 128.0f) + EPS);
            float o1[4], o2[4];
#pragma unroll
            for (int e = 0; e < 4; ++e) { const float y1 = x1[e] * rs * qga[e], y2 = x2[e] * rs * qgb[e]; o1[e] = y1 * cs[e] - y2 * sn[e]; o2[e] = y2 * cs[e] + y1 * sn[e]; }
            bf16* qd = Q + (size_t)row * 2048 + (4 * it + hsel) * 128 + 4 * sub;
            *(v2u*)qd = (v2u){pk2(o1[0], o1[1]), pk2(o1[2], o1[3])}; *(v2u*)(qd + 64) = (v2u){pk2(o2[0], o2[1]), pk2(o2[2], o2[3])};
        }
        { const float x1[4] = {bflo(ka.x), bfhi(ka.x), bflo(ka.y), bfhi(ka.y)}, x2[4] = {bflo(kb.x), bfhi(kb.x), bflo(kb.y), bfhi(kb.y)};
          float ss = 0.f;
#pragma unroll
          for (int e = 0; e < 4; ++e) ss += x1[e] * x1[e] + x2[e] * x2[e];
          ss += __shfl_xor(ss, 1); ss += __shfl_xor(ss, 2); ss += __shfl_xor(ss, 4); ss += __shfl_xor(ss, 8);
          const float rs = 1.0f / sqrtf(ss * (1.0f / 128.0f) + EPS);
          f32x4 o1, o2;
#pragma unroll
          for (int e = 0; e < 4; ++e) { const float y1 = x1[e] * rs * kga[e], y2 = x2[e] * rs * kgb[e]; o1[e] = y1 * cs[e] - y2 * sn[e]; o2[e] = y2 * cs[e] + y1 * sn[e]; }
          bf16* kd = KB + (size_t)row * 512 + hsel * 128 + 4 * sub;
          *(v2u*)kd = (v2u){pk2(o1[0], o1[1]), pk2(o1[2], o1[3])}; *(v2u*)(kd + 64) = (v2u){pk2(o2[0], o2[1]), pk2(o2[2], o2[3])};
          __builtin_nontemporal_store(o1, (f32x4*)(kout + hsel * 128 + 4 * sub)); __builtin_nontemporal_store(o2, (f32x4*)(kout + hsel * 128 + 64 + 4 * sub)); }
        { *(v4u*)(VB + (size_t)row * 512 + lane * 8) = vraw; float x[8]; up8(vraw, x);
          __builtin_nontemporal_store((f32x4){x[0], x[1], x[2], x[3]}, (f32x4*)(vout + lane * 8)); __builtin_nontemporal_store((f32x4){x[4], x[5], x[6], x[7]}, (f32x4*)(vout + lane * 8 + 4)); }
#pragma unroll
        for (int it = 0; it < 2; ++it) {
            const float x1[4] = {bflo(ia[it].x), bfhi(ia[it].x), bflo(ia[it].y), bfhi(ia[it].y)}, x2[4] = {bflo(ib[it].x), bfhi(ib[it].x), bflo(ib[it].y), bfhi(ib[it].y)};
            float o1[4], o2[4];
#pragma unroll
            for (int e = 0; e < 4; ++e) { o1[e] = x1[e] * cs8[e] - x2[e] * sn8[e]; o2[e] = x2[e] * cs8[e] + x1[e] * sn8[e]; }
            bf16* qd = IQ + (size_t)row * 1024 + (8 * it + hsel8) * 64 + 4 * sub8;
            *(v2u*)qd = (v2u){pk2(o1[0], o1[1]), pk2(o1[2], o1[3])}; *(v2u*)(qd + 32) = (v2u){pk2(o2[0], o2[1]), pk2(o2[2], o2[3])};
        }
        if (lane < 8) {
            const float x1[4] = {bflo(ka2.x), bfhi(ka2.x), bflo(ka2.y), bfhi(ka2.y)}, x2[4] = {bflo(kb2.x), bfhi(kb2.x), bflo(kb2.y), bfhi(kb2.y)};
            f32x4 o1, o2;
#pragma unroll
            for (int e = 0; e < 4; ++e) { o1[e] = x1[e] * cs8[e] - x2[e] * sn8[e]; o2[e] = x2[e] * cs8[e] + x1[e] * sn8[e]; }
            bf16* kd = IK + (size_t)row * 64 + 4 * sub8;
            *(v2u*)kd = (v2u){pk2(o1[0], o1[1]), pk2(o1[2], o1[3])}; *(v2u*)(kd + 32) = (v2u){pk2(o2[0], o2[1]), pk2(o2[2], o2[3])};
            *(f32x4*)(ikout + 4 * sub8) = o1; *(f32x4*)(ikout + 32 + 4 * sub8) = o2;
        }
        if (lane < 16) IW[(size_t)row * 16 + lane] = wv * 0.03125f;
    };
    { QkRow A, B;
      if (gw < R) load_row(gw, A);
      for (int row = gw; row < R; row += 2 * NGW) { const int r1 = row + NGW, r2 = row + 2 * NGW;
          if (r1 < R) load_row(r1, B);
          __builtin_amdgcn_sched_barrier(0);
          finish_row(row, A);
          if (r1 < R) { if (r2 < R) load_row(r2, A);
              __builtin_amdgcn_sched_barrier(0);
              finish_row(r1, B); } } }
}
DI int wq_next(gu32* head, volatile LAS int* slot, int tid) {
    __syncthreads();
    if (tid == 0) *slot = (int)__hip_atomic_fetch_add(head, 1u, RLX_AGENT);
    __syncthreads();
    return __builtin_amdgcn_readfirstlane(*slot);
}
DI void idx_prompt_unit(const Args& a, const Ctx& C, int b, int qb, int st_lo, int st_hi) {
    unsigned char* ws = a.ws;
    const bf16* IQ = (const bf16*)(ws + WS_IQ); const bf16* IK = (const bf16*)(ws + WS_IK); const float* IW = (const float*)(ws + WS_IW); float* SC = (float*)(ws + WS_SC);
    LAS unsigned char* iql = C.lds;
    { const bf16* src = IQ + (size_t)(b * 2048 + qb * 64) * 1024;
#pragma unroll 4
      for (int i = 0; i < 16; ++i) { const int id = C.tid + 512 * i, row = id >> 7, ch = id & 127; *(LAS v4u*)(iql + row * 2064 + ch * 16) = *(const v4u*)(src + (size_t)row * 1024 + ch * 8); } }
    __syncthreads();
    const int qg = C.wave & 1, kg = C.wave >> 1, r = C.lane & 31, hh = C.lane >> 5;
    const int qrow = b * 2048 + qb * 64 + qg * 32 + r;
    const float* wrow = IW + (size_t)qrow * 16;
    for (int st = st_lo; st < st_hi; ++st) {
        const int s0 = st * 256 + kg * 64;
        if (s0 <= qb * 64 + 63) {
            bf16x8 ka[2][4];
#pragma unroll
            for (int sb = 0; sb < 2; ++sb)
#pragma unroll
                for (int kk = 0; kk < 4; ++kk) ka[sb][kk] = *(const bf16x8*)(IK + (size_t)(b * 2048 + s0 + sb * 32 + r) * 64 + kk * 16 + hh * 8);
            f32x16 acc0, acc1;
#pragma unroll
            for (int e = 0; e < 16; ++e) { acc0[e] = 0.f; acc1[e] = 0.f; }
#pragma unroll 1
            for (int h = 0; h < 16; h += 2) {
                const float wh0 = wrow[h], wh1 = wrow[h + 1];
                bf16x8 qf0[4], qf1[4];
#pragma unroll
                for (int kk = 0; kk < 4; ++kk) { qf0[kk] = *(const LAS bf16x8*)(iql + (qg * 32 + r) * 2064 + h * 128 + kk * 32 + hh * 16); qf1[kk] = *(const LAS bf16x8*)(iql + (qg * 32 + r) * 2064 + (h + 1) * 128 + kk * 32 + hh * 16); }
                f32x16 c0, c1, d0, d1;
#pragma unroll
                for (int e = 0; e < 16; ++e) { c0[e] = 0.f; c1[e] = 0.f; d0[e] = 0.f; d1[e] = 0.f; }
#pragma unroll
                for (int kk = 0; kk < 4; ++kk) { c0 = MFMA32(ka[0][kk], qf0[kk], c0); c1 = MFMA32(ka[1][kk], qf0[kk], c1); }
#pragma unroll
                for (int kk = 0; kk < 4; ++kk) { d0 = MFMA32(ka[0][kk], qf1[kk], d0); d1 = MFMA32(ka[1][kk], qf1[kk], d1); }
#pragma unroll
                for (int e = 0; e < 16; ++e) { acc0[e] += wh0 * fmaxf(c0[e], 0.f); acc1[e] += wh0 * fmaxf(c1[e], 0.f); }
#pragma unroll
                for (int e = 0; e < 16; ++e) { acc0[e] += wh1 * fmaxf(d0[e], 0.f); acc1[e] += wh1 * fmaxf(d1[e], 0.f); }
            }
            float* dst = SC + (size_t)qrow * 2048 + s0 + 4 * hh;
#pragma unroll
            for (int rg = 0; rg < 4; ++rg) { *(f32x4*)(dst + 8 * rg) = (f32x4){acc0[4 * rg], acc0[4 * rg + 1], acc0[4 * rg + 2], acc0[4 * rg + 3]};
                                             *(f32x4*)(dst + 32 + 8 * rg) = (f32x4){acc1[4 * rg], acc1[4 * rg + 1], acc1[4 * rg + 2], acc1[4 * rg + 3]}; }
        }
    }
}
DI void idx_sample_unit(const Args& a, const Ctx& C, int b) {
    unsigned char* ws = a.ws;
    const bf16* IQ = (const bf16*)(ws + WS_IQ); const bf16* IK = (const bf16*)(ws + WS_IK); const float* IW = (const float*)(ws + WS_IW); float* SCS = (float*)(ws + WS_SCS);
    const float* cik = a.in[4]; const int* pt = (const int*)a.in[6] + b * 16;
    const int r = C.lane & 31, hh = C.lane >> 5;
    bf16x8 qa[4][4];
#pragma unroll
    for (int blk = 0; blk < 4; ++blk)
#pragma unroll
        for (int kk = 0; kk < 4; ++kk) qa[blk][kk] = *(const bf16x8*)(IQ + (size_t)(RP + 8 * b + 2 * blk + (r >> 4)) * 1024 + (r & 15) * 64 + kk * 16 + hh * 8);
    for (int kb = C.wave; kb < 65; kb += 8) {
        bf16x8 kf[4];
        if (kb < 64) { const int s = 32 * kb + r; const float* kp = cik + ((size_t)pt[s >> 7] * 128 + (s & 127)) * 64 + hh * 8;
#pragma unroll
            for (int kk = 0; kk < 4; ++kk) { const f32x4 x0 = *(const f32x4*)(kp + kk * 16), x1 = *(const f32x4*)(kp + kk * 16 + 4); v4u o; o.x = pk2(x0[0], x0[1]); o.y = pk2(x0[2], x0[3]); o.z = pk2(x1[0], x1[1]); o.w = pk2(x1[2], x1[3]); kf[kk] = __builtin_bit_cast(bf16x8, o); } }
        else {
#pragma unroll
            for (int kk = 0; kk < 4; ++kk) { v4u o = {0u, 0u, 0u, 0u}; if (r < 8) o = *(const v4u*)(IK + (size_t)(RP + 8 * b + r) * 64 + kk * 16 + hh * 8); kf[kk] = __builtin_bit_cast(bf16x8, o); } }
#pragma unroll
        for (int blk = 0; blk < 4; ++blk) {
            f32x16 c;
#pragma unroll
            for (int e = 0; e < 16; ++e) c[e] = 0.f;
#pragma unroll
            for (int kk = 0; kk < 4; ++kk) c = MFMA32(qa[blk][kk], kf[kk], c);
            float p0 = 0.f, p1 = 0.f;
            const float* w0p = IW + (size_t)(RP + 8 * b + 2 * blk) * 16 + 4 * hh; const float* w1p = w0p + 16;
            const f32x4 w00 = *(const f32x4*)w0p, w01 = *(const f32x4*)(w0p + 8), w10 = *(const f32x4*)w1p, w11 = *(const f32x4*)(w1p + 8);
#pragma unroll
            for (int j = 0; j < 4; ++j) { p0 += w00[j] * fmaxf(c[j], 0.f) + w01[j] * fmaxf(c[4 + j], 0.f); p1 += w10[j] * fmaxf(c[8 + j], 0.f) + w11[j] * fmaxf(c[12 + j], 0.f); }
            p0 += __shfl_xor(p0, 32); p1 += __shfl_xor(p1, 32);
            SCS[(size_t)(8 * b + 2 * blk + hh) * 2112 + 32 * kb + r] = hh ? p1 : p0;
        }
    }
}
DI void ph_index(const Args& a, const Ctx& C) {
    gu32* head = (gu32*)a.ws + CW_WQ; volatile LAS int* slot = (volatile LAS int*)(C.lds + MISC_OFF + 64);
    for (;;) {
        const int u = wq_next(head, slot, C.tid);
        if (u >= 128 + 640) break;
        if (u < 128) idx_sample_unit(a, C, u);
        else {
            const int v = u - 128, b = v & 7, k = v >> 3; int qb, c;
            if (k < 32) { qb = 31 - (k >> 2); c = k & 3; } else if (k < 56) { const int k2 = k - 32; qb = 23 - k2 / 3; c = k2 % 3; }
            else if (k < 72) { const int k3 = k - 56; qb = 15 - (k3 >> 1); c = k3 & 1; } else { qb = 79 - k; c = 0; }
            const int nsteps = (qb * 64 + 64 + 255) >> 8, lo = 2 * c, hi = lo + 2 < nsteps ? lo + 2 : nsteps;
            idx_prompt_unit(a, C, b, qb, lo, hi); }
    }
}
DI unsigned ordkey(float f) { const unsigned b = __float_as_uint(f); return (b & 0x80000000u) ? ~b : (b | 0x80000000u); }
template <int NS> DI void load_row(const float* sc, float (&f)[NS], int lane) {
#pragma unroll
    for (int j = 0; j < NS; ++j) f[j] = sc[64 * j + lane];
}
template <int NS> DI void select_row(const float (&f)[NS], int n_adm, unsigned long long* mrow, int lane, LAS unsigned* hist) {
    unsigned T = 1u;
    if (n_adm > 256) {
        float lo = 3.0e38f, hi = -3.0e38f;
#pragma unroll
        for (int j = 0; j < NS; ++j) { const bool v = 64 * j + lane < n_adm; lo = v ? fminf(lo, f[j]) : lo; hi = v ? fmaxf(hi, f[j]) : hi; }
#pragma unroll
        for (int o = 1; o < 64; o <<= 1) { lo = fminf(lo, __shfl_xor(lo, o)); hi = fmaxf(hi, __shfl_xor(hi, o)); }
        if (hi > lo) {
            const float scale = 1023.5f / (hi - lo);
#pragma unroll
            for (int q = 0; q < 4; ++q) *(LAS v4u*)(hist + 16 * lane + 4 * q) = (v4u){0u, 0u, 0u, 0u};
            if (lane == 0) hist[1024] = 0u;
            asm volatile("s_waitcnt lgkmcnt(0)" ::: "memory");
#pragma unroll
            for (int j = 0; j < NS; ++j) if (64 * j + lane < n_adm) { int bn = (int)((f[j] - lo) * scale); bn = bn > 1023 ? 1023 : bn; __hip_atomic_fetch_add(hist + bn, 1u, __ATOMIC_RELAXED, __HIP_MEMORY_SCOPE_WAVEFRONT); }
            asm volatile("s_waitcnt lgkmcnt(0)" ::: "memory");
            unsigned c[16];
#pragma unroll
            for (int q = 0; q < 4; ++q) { const v4u t = *(const LAS v4u*)(hist + 16 * lane + 4 * q); c[4 * q] = t.x; c[4 * q + 1] = t.y; c[4 * q + 2] = t.z; c[4 * q + 3] = t.w; }
            unsigned s = 0;
#pragma unroll
            for (int q = 0; q < 16; ++q) s += c[q];
            unsigned t = s;
#pragma unroll
            for (int o = 1; o < 64; o <<= 1) { const unsigned v = (unsigned)__shfl_down((int)t, o); t += (lane + o < 64) ? v : 0u; }
            const unsigned excl = t - s;
            int B = 0; unsigned above = 0;
            { unsigned run = excl; bool found = false;
#pragma unroll
              for (int q = 15; q >= 0; --q) { const unsigned nr = run + c[q]; if (!found && nr >= 256u) { found = true; B = 16 * lane + q; above = run; } run = nr; } }
            const unsigned long long own = __ballot(excl < 256u && t >= 256u);
            const int src = (int)__ffsll((long long)own) - 1;
            B = __builtin_amdgcn_readlane(B, src); above = (unsigned)__builtin_amdgcn_readlane((int)above, src);
            const unsigned need = 256u - above;
#pragma unroll
            for (int j = 0; j < NS; ++j) if (64 * j + lane < n_adm) { int bn = (int)((f[j] - lo) * scale); bn = bn > 1023 ? 1023 : bn;
                if (bn == B) { const unsigned idx = __hip_atomic_fetch_add(hist + 1024, 1u, __ATOMIC_RELAXED, __HIP_MEMORY_SCOPE_WAVEFRONT); if (idx < 64u) hist[1025 + idx] = ordkey(f[j]); } }
            asm volatile("s_waitcnt lgkmcnt(0)" ::: "memory");
            const unsigned nc = (unsigned)__builtin_amdgcn_readfirstlane((int)hist[1024]);
            bool done = false;
            if (nc <= 64u && need <= nc) {
                const unsigned ci = lane < (int)nc ? hist[1025 + lane] : 0u; unsigned gt = 0, ge = 0;
                for (unsigned k = 0; k < nc; ++k) { const unsigned ck = (unsigned)__builtin_amdgcn_readlane((int)ci, (int)k); gt += ck > ci ? 1u : 0u; ge += ck >= ci ? 1u : 0u; }
                const unsigned long long hit = __ballot(lane < (int)nc && gt < need && need <= ge);
                if (hit != 0ull) { T = (unsigned)__builtin_amdgcn_readlane((int)ci, (int)__ffsll((long long)hit) - 1); done = true; }
            }
            if (!done) {
                T = 0u;
#pragma unroll 1
                for (int bit = 31; bit >= 0; --bit) { const unsigned cand = T | (1u << bit); int cnt = 0;
#pragma unroll
                    for (int j = 0; j < NS; ++j) cnt += __popcll(__ballot(64 * j + lane < n_adm && ordkey(f[j]) >= cand));
                    if (cnt >= 256) T = cand;
                    if (cnt == 256) break; }
            }
        }
    }
    unsigned long long mine = 0ull;
#pragma unroll
    for (int j = 0; j < NS; ++j) { const unsigned long long bm = __ballot(64 * j + lane < n_adm && ordkey(f[j]) >= T); if (lane == j) mine = bm; }
    if (lane < 34) mrow[lane] = lane < NS ? mine : 0ull;
}
DI void ph_select(const Args& a, const Ctx& C) {
    unsigned char* ws = a.ws;
    const float* SC = (const float*)(ws + WS_SC); const float* SCS = (const float*)(ws + WS_SCS); unsigned long long* MASK = (unsigned long long*)(ws + WS_MASK);
    const int gw = C.bx * NWAVES + C.wave, NGW = C.G * NWAVES;
    LAS unsigned* hist = (LAS unsigned*)(C.lds + C.wave * 5120);
    if (gw < RP) {
        float fa[32], fb[32];
        load_row<32>(SC + (size_t)gw * 2048, fa, C.lane);
        for (int row = gw; row < RP; row += 2 * NGW) {
            const int r1 = row + NGW, r2 = row + 2 * NGW;
            if (r1 < RP) load_row<32>(SC + (size_t)r1 * 2048, fb, C.lane);
            __builtin_amdgcn_sched_barrier(0);
            select_row<32>(fa, (row & 2047) + 1, MASK + (size_t)row * 34, C.lane, hist);
            if (r1 < RP) {
                if (r2 < RP) load_row<32>(SC + (size_t)r2 * 2048, fa, C.lane);
                __builtin_amdgcn_sched_barrier(0);
                select_row<32>(fb, (r1 & 2047) + 1, MASK + (size_t)r1 * 34, C.lane, hist);
            }
        }
    }
    for (int row = RP + gw; row < R; row += NGW) { float fs[33]; load_row<33>(SCS + (size_t)(row - RP) * 2112, fs, C.lane);
        select_row<33>(fs, 2049 + ((row - RP) & 7), MASK + (size_t)row * 34, C.lane, hist); }
}
constexpr float NEG_BIG = -1.0e30f;
DI bf16x8 pack_p(const f32x16& x, int sp) {
    v4u o; o.x = pk2(x[8 * sp + 0], x[8 * sp + 1]); o.y = pk2(x[8 * sp + 2], x[8 * sp + 3]); o.z = pk2(x[8 * sp + 4], x[8 * sp + 5]); o.w = pk2(x[8 * sp + 6], x[8 * sp + 7]);
    return __builtin_bit_cast(bf16x8, o);
}
DI void mask_init(f32x16& s0, f32x16& s1, unsigned long long wq) {
    const unsigned wlo = (unsigned)wq, whi = (unsigned)(wq >> 32);
    int one = 1; asm volatile("" : "+s"(one));
#pragma unroll
    for (int e = 0; e < 16; ++e) { const int sh = (e & 3) + 8 * (e >> 2);
        const int t0 = __builtin_amdgcn_sbfe((int)wlo, sh, one), t1 = __builtin_amdgcn_sbfe((int)whi, sh, one);
        s0[e] = __builtin_bit_cast(float, ~t0 & (int)0xf149f2ca); s1[e] = __builtin_bit_cast(float, ~t1 & (int)0xf149f2ca); }
}
constexpr float M_INIT = -5.0e29f;
DI void softmax_tile(f32x16& s0, f32x16& s1, float& m, float& l, f32x16 (&o)[4]) {
    float mx = fmaxf(s0[0], s1[0]);
#pragma unroll
    for (int e = 1; e < 16; ++e) mx = fmaxf(mx, fmaxf(s0[e], s1[e]));
    mx = fmaxf(mx, __shfl_xor(mx, 32));
    const float mn = fmaxf(m, mx);
    if (__ballot(mn > m) != 0ull) { const float alpha = fexp2(m - mn); l *= alpha;
#pragma unroll
        for (int db = 0; db < 4; ++db)
#pragma unroll
            for (int e = 0; e < 16; ++e) o[db][e] *= alpha; }
    m = mn;
    float ls = 0.f;
#pragma unroll
    for (int e = 0; e < 16; ++e) { s0[e] = fexp2(s0[e] - mn); s1[e] = fexp2(s1[e] - mn); ls += s0[e] + s1[e]; }
    l += ls;
}
constexpr int KT_BYTES = 64 * 272, VT_BYTES = 128 * 144;
DI void attn_prompt_unit(const Args& a, const Ctx& C, int b, int kvh, int qb) {
    unsigned char* ws = a.ws;
    const bf16* Q = (const bf16*)(ws + WS_Q); const bf16* KB = (const bf16*)(ws + WS_KB); const bf16* VB = (const bf16*)(ws + WS_VB);
    const unsigned long long* MASK = (const unsigned long long*)(ws + WS_MASK); bf16* O = (bf16*)(ws + WS_O);
    const int hg = C.wave & 3, qh = C.wave >> 2, r = C.lane & 31, hh = C.lane >> 5, head = 4 * kvh + hg;
    const int qrow = b * 2048 + qb * 64 + qh * 32 + r;
    bf16x8 qf[8];
#pragma unroll
    for (int kk = 0; kk < 8; ++kk) qf[kk] = *(const bf16x8*)(Q + (size_t)qrow * 2048 + head * 128 + kk * 16 + hh * 8);
    f32x16 o[4];
#pragma unroll
    for (int db = 0; db < 4; ++db)
#pragma unroll
        for (int e = 0; e < 16; ++e) o[db][e] = 0.f;
    float m = M_INIT, l = 0.f;
    const unsigned long long* mrow = MASK + (size_t)qrow * 34;
    LAS unsigned char* kbuf = C.lds; LAS unsigned char* vbuf = C.lds + 2 * KT_BYTES;
    const int krow0 = C.tid >> 4, kch = C.tid & 15;
    const unsigned char* kgu = (const unsigned char*)(KB + (size_t)(b * 2048) * 512 + kvh * 128); const unsigned char* vgu = (const unsigned char*)(VB + (size_t)(b * 2048) * 512 + kvh * 128);
    const unsigned klo = (unsigned)(krow0 * 1024 + kch * 16), vlo = (unsigned)(krow0 * 2048 + kch * 16);
    v4u kr[2], vr[2];
#define LOADK(kt) do { const unsigned char* kp_ = kgu + (size_t)(kt) * 65536; kr[0] = *(const v4u*)(kp_ + klo); kr[1] = *(const v4u*)(kp_ + 32768 + klo); } while (0)
#define LOADV(kt) do { const unsigned char* vp_ = vgu + (size_t)(kt) * 65536; vr[0] = *(const v4u*)(vp_ + vlo); vr[1] = *(const v4u*)(vp_ + vlo + 1024); } while (0)
#define WRITEK(buf) do { *(LAS v4u*)(kbuf + (buf) * KT_BYTES + krow0 * 272 + kch * 16) = kr[0]; *(LAS v4u*)(kbuf + (buf) * KT_BYTES + (32 + krow0) * 272 + kch * 16) = kr[1]; } while (0)
#define WRITEV(buf) do { \
        LAS unsigned char* vb_ = vbuf + (buf) * VT_BYTES + vwo; \
        const unsigned a_[4] = {vr[0].x, vr[0].y, vr[0].z, vr[0].w}, b_[4] = {vr[1].x, vr[1].y, vr[1].z, vr[1].w}; \
        _Pragma("unroll") for (int i_ = 0; i_ < 4; ++i_) { *(LAS unsigned*)(vb_ + (2 * i_) * 144) = (a_[i_] & 0xffffu) | (b_[i_] << 16); *(LAS unsigned*)(vb_ + (2 * i_ + 1) * 144) = (a_[i_] >> 16) | (b_[i_] & 0xffff0000u); } } while (0)
#define QK_TILE(buf) do { const LAS unsigned char* kb_ = kbuf + (buf) * KT_BYTES + r * 272 + hh * 16; bf16x8 ka_[4][2]; \
        _Pragma("unroll") for (int kk = 0; kk < 3; ++kk) { ka_[kk][0] = *(const LAS bf16x8*)(kb_ + kk * 32); ka_[kk][1] = *(const LAS bf16x8*)(kb_ + 32 * 272 + kk * 32); } \
        _Pragma("unroll") for (int kk = 0; kk < 8; ++kk) { \
            if (kk + 3 < 8) { ka_[(kk + 3) & 3][0] = *(const LAS bf16x8*)(kb_ + (kk + 3) * 32); ka_[(kk + 3) & 3][1] = *(const LAS bf16x8*)(kb_ + 32 * 272 + (kk + 3) * 32); } \
            s0 = MFMA32(ka_[kk & 3][0], qf[kk], s0); s1 = MFMA32(ka_[kk & 3][1], qf[kk], s1); \
            __builtin_amdgcn_sched_barrier(0); } } while (0)
#define PV_TILE(vsel) do { const LAS unsigned char* vb_ = vbuf + (vsel) * VT_BYTES + r * 144 + hh * 16; bf16x8 va_[2][4]; \
        _Pragma("unroll") for (int db = 0; db < 4; ++db) va_[0][db] = *(const LAS bf16x8*)(vb_ + db * 32 * 144 + 16 * (0 ^ (2 * db))); \
        _Pragma("unroll") for (int ps = 0; ps < 4; ++ps) { \
            if (ps < 3) { _Pragma("unroll") for (int db = 0; db < 4; ++db) va_[(ps + 1) & 1][db] = *(const LAS bf16x8*)(vb_ + db * 32 * 144 + 16 * ((2 * (ps + 1)) ^ (2 * db))); } \
            const bf16x8 pf = pack_p(ps < 2 ? s0 : s1, ps & 1); \
            _Pragma("unroll") for (int db = 0; db < 4; ++db) o[db] = MFMA32(va_[ps & 1][db], pf, o[db]); \
            __builtin_amdgcn_sched_barrier(0); } } while (0)
#define VNEXT(v) ((v) == 2 ? 0 : (v) + 1)
    const int vwo = (kch * 8) * 144 + 16 * ((2 * (krow0 >> 3) + ((krow0 >> 1) & 1)) ^ (2 * (kch >> 2))) + 8 * ((krow0 >> 2) & 1) + 4 * (krow0 & 1);
#ifndef ATT_STAGGER
#define ATT_STAGGER 1
#endif
    const bool late = ATT_STAGGER && __builtin_amdgcn_readfirstlane(C.wave) >= 4;
    LOADK(0); LOADV(0); WRITEK(0); WRITEV(0);
    unsigned long long wnext = mrow[0];
    __syncthreads();
    asm volatile("; q fragments ready" :: "v"(qf[0]), "v"(qf[1]), "v"(qf[2]), "v"(qf[3]), "v"(qf[4]), "v"(qf[5]), "v"(qf[6]), "v"(qf[7]), "v"(wnext));
    f32x16 s0, s1;
    if (!late) {
        int vsel = 0;
        for (int kt = 0; kt <= qb; ++kt) {
            const unsigned long long wq = wnext >> (4 * hh);
            const int vn = VNEXT(vsel);
            if (kt < qb) { LOADK(kt + 1); LOADV(kt + 1); wnext = mrow[kt + 1]; }
            __builtin_amdgcn_sched_barrier(0);
            mask_init(s0, s1, wq);
            QK_TILE(kt & 1);
            softmax_tile(s0, s1, m, l, o);
            PV_TILE(vsel);
            if (kt < qb) { WRITEK((kt + 1) & 1); WRITEV(vn); }
            vsel = vn;
            __syncthreads();
        }
    } else {
        { const unsigned long long wq = wnext >> (4 * hh);
          if (0 < qb) { LOADK(1); LOADV(1); wnext = mrow[1]; }
          __builtin_amdgcn_sched_barrier(0);
          mask_init(s0, s1, wq);
          QK_TILE(0);
          if (0 < qb) { WRITEK(1); WRITEV(1); }
          __syncthreads(); }
        int vsel = 0;
        for (int kt = 1; kt <= qb; ++kt) {
            const unsigned long long wq = wnext >> (4 * hh);
            const int vc = VNEXT(vsel), vn = VNEXT(vc);
            if (kt < qb) { LOADK(kt + 1); LOADV(kt + 1); wnext = mrow[kt + 1]; }
            __builtin_amdgcn_sched_barrier(0);
            softmax_tile(s0, s1, m, l, o);
            PV_TILE(vsel);
            mask_init(s0, s1, wq);
            QK_TILE(kt & 1);
            if (kt < qb) { WRITEK((kt + 1) & 1); WRITEV(vn); }
            vsel = vc;
            __syncthreads();
        }
        softmax_tile(s0, s1, m, l, o);
        PV_TILE(vsel);
    }
#undef LOADK
#undef LOADV
#undef WRITEK
#undef WRITEV
#undef QK_TILE
#undef PV_TILE
#undef VNEXT
    l += __shfl_xor(l, 32); const float inv = 1.0f / l;
#pragma unroll
    for (int db = 0; db < 4; ++db)
#pragma unroll
        for (int rg = 0; rg < 4; ++rg) { v2u w; w.x = pk2(o[db][4 * rg] * inv, o[db][4 * rg + 1] * inv); w.y = pk2(o[db][4 * rg + 2] * inv, o[db][4 * rg + 3] * inv);
            *(v2u*)(O + (size_t)qrow * 2048 + head * 128 + 32 * db + 8 * rg + 4 * hh) = w; }
}
DI bf16x8 cvt8(const f32x4& x0, const f32x4& x1) { v4u o; o.x = pk2(x0[0], x0[1]); o.y = pk2(x0[2], x0[3]); o.z = pk2(x1[0], x1[1]); o.w = pk2(x1[2], x1[3]); return __builtin_bit_cast(bf16x8, o); }
DI void attn_sample_unit(const Args& a, const Ctx& C, int b, int kvh) {
    unsigned char* ws = a.ws;
    const bf16* Q = (const bf16*)(ws + WS_Q); const bf16* KB = (const bf16*)(ws + WS_KB); const bf16* VB = (const bf16*)(ws + WS_VB);
    const unsigned long long* MASK = (const unsigned long long*)(ws + WS_MASK); bf16* O = (bf16*)(ws + WS_O);
    const float* ck = a.in[2]; const float* cv = a.in[3]; const int* pt = (const int*)a.in[6] + b * 16;
    const int r = C.lane & 31, hh = C.lane >> 5, t = r & 7, head = 4 * kvh + (r >> 3), qrow = RP + 8 * b + t;
    const bf16* qp = Q + (size_t)qrow * 2048 + head * 128 + hh * 8;
    f32x16 o[4];
#pragma unroll
    for (int db = 0; db < 4; ++db)
#pragma unroll
        for (int e = 0; e < 16; ++e) o[db][e] = 0.f;
    float m = M_INIT, l = 0.f;
    const unsigned long long* mrow = MASK + (size_t)qrow * 34;
    const unsigned kvo = (unsigned)((r * 4 + kvh) * 128 + hh * 8);
    const unsigned vvo = (unsigned)((4 * hh * 4 + kvh) * 128 + r);
    f32x4 buf[2][8];
#define SA_ROWBASE(i) ((unsigned)__builtin_amdgcn_readfirstlane(pt[(C.wave + 8 * (i)) >> 1] * 128 + ((C.wave + 8 * (i)) & 1) * 64))
#define SA_LOADK(P, rb, g, um) do { const float* k0_ = ck + (size_t)(rb) * 512 + kvo + (g) * 32; const float* k1_ = k0_ + 32 * 512; const f32x4 z_ = {0.f, 0.f, 0.f, 0.f}; \
        buf[P][0] = z_; buf[P][1] = z_; buf[P][4] = z_; buf[P][5] = z_; buf[P][2] = z_; buf[P][3] = z_; buf[P][6] = z_; buf[P][7] = z_; \
        if (((um) >> r) & 1ull) { buf[P][0] = *(const f32x4*)(k0_); buf[P][1] = *(const f32x4*)(k0_ + 4); buf[P][4] = *(const f32x4*)(k0_ + 16); buf[P][5] = *(const f32x4*)(k0_ + 20); } \
        if (((um) >> (32 + r)) & 1ull) { buf[P][2] = *(const f32x4*)(k1_); buf[P][3] = *(const f32x4*)(k1_ + 4); buf[P][6] = *(const f32x4*)(k1_ + 16); buf[P][7] = *(const f32x4*)(k1_ + 20); } \
        } while (0)
#define SA_LOADV(P, rb, g, um) do { const float* v0_ = cv + (size_t)((rb) + 16 * (g)) * 512 + vvo; const unsigned vb_ = (unsigned)((um) >> (16 * (g) + 4 * hh)); \
        _Pragma("unroll") for (int j_ = 0; j_ < 8; ++j_) { const bool on_ = (vb_ >> (8 * (j_ >> 2) + (j_ & 3))) & 1u; \
            _Pragma("unroll") for (int db_ = 0; db_ < 4; ++db_) buf[P][2 * db_ + (j_ >> 2)][j_ & 3] = on_ ? v0_[(8 * (j_ >> 2) + (j_ & 3)) * 512 + 32 * db_] : 0.f; } } while (0)
#define SA_QK(P, g) do { const bf16x8 q0_ = *(const bf16x8*)(qp + (g) * 32), q1_ = *(const bf16x8*)(qp + (g) * 32 + 16); \
        s0 = MFMA32(cvt8(buf[P][0], buf[P][1]), q0_, s0); s1 = MFMA32(cvt8(buf[P][2], buf[P][3]), q0_, s1); \
        s0 = MFMA32(cvt8(buf[P][4], buf[P][5]), q1_, s0); s1 = MFMA32(cvt8(buf[P][6], buf[P][7]), q1_, s1); } while (0)
#define SA_PV(P, pf) do { _Pragma("unroll") for (int db_ = 0; db_ < 4; ++db_) o[db_] = MFMA32(cvt8(buf[P][2 * db_], buf[P][2 * db_ + 1]), pf, o[db_]); } while (0)
#define SA_SB() __builtin_amdgcn_sched_barrier(0)
#define SA_UNION(w) ({ unsigned long long u_ = (w); u_ |= __shfl_xor(u_, 1); u_ |= __shfl_xor(u_, 2); u_ |= __shfl_xor(u_, 4); u_; })
    unsigned rb = SA_ROWBASE(0);
    unsigned long long wcur = mrow[C.wave], um = SA_UNION(wcur);
    SA_LOADK(0, rb, 0, um); SA_SB();
#pragma unroll 1
    for (int i = 0; i < 4; ++i) {
        const unsigned rbn = SA_ROWBASE(i < 3 ? i + 1 : 3);
        const unsigned long long wq = wcur >> (4 * hh), wnx = mrow[C.wave + 8 * (i < 3 ? i + 1 : 3)];
        f32x16 s0, s1; mask_init(s0, s1, wq);
        SA_LOADK(1, rb, 1, um); SA_SB(); SA_QK(0, 0); SA_SB();
        SA_LOADK(0, rb, 2, um); SA_SB(); SA_QK(1, 1); SA_SB();
        SA_LOADK(1, rb, 3, um); SA_SB(); SA_QK(0, 2); SA_SB();
        SA_LOADV(0, rb, 0, um); SA_SB(); SA_QK(1, 3); SA_SB();
        softmax_tile(s0, s1, m, l, o);
        SA_LOADV(1, rb, 1, um); SA_SB(); { const bf16x8 pf = pack_p(s0, 0); SA_PV(0, pf); } SA_SB();
        SA_LOADV(0, rb, 2, um); SA_SB(); { const bf16x8 pf = pack_p(s0, 1); SA_PV(1, pf); } SA_SB();
        SA_LOADV(1, rb, 3, um); SA_SB(); { const bf16x8 pf = pack_p(s1, 0); SA_PV(0, pf); } SA_SB();
        const unsigned long long umn = SA_UNION(wnx);
        if (i < 3) SA_LOADK(0, rbn, 0, umn); SA_SB();
        { const bf16x8 pf = pack_p(s1, 1); SA_PV(1, pf); } SA_SB();
        rb = rbn; wcur = wnx; um = umn;
    }
#undef SA_UNION
#undef SA_ROWBASE
#undef SA_LOADK
#undef SA_LOADV
#undef SA_QK
#undef SA_PV
#undef SA_SB
    if (C.wave == 0) {
        const unsigned long long wq = mrow[32] >> (4 * hh);
        f32x16 s0, s1; mask_init(s0, s1, wq);
#pragma unroll
        for (int kk = 0; kk < 8; ++kk) { v4u kv = {0u, 0u, 0u, 0u}; if (r < 8) kv = *(const v4u*)(KB + (size_t)(RP + 8 * b + r) * 512 + kvh * 128 + kk * 16 + hh * 8);
            s0 = MFMA32(__builtin_bit_cast(bf16x8, kv), *(const bf16x8*)(qp + kk * 16), s0); }
        softmax_tile(s0, s1, m, l, o);
        const bf16x8 pf = pack_p(s0, 0);
#pragma unroll
        for (int db = 0; db < 4; ++db) { const bf16* vp = VB + (size_t)(RP + 8 * b + 4 * hh) * 512 + kvh * 128 + 32 * db + r;
            v4u av; av.x = (unsigned)vp[0] | ((unsigned)vp[512] << 16); av.y = (unsigned)vp[1024] | ((unsigned)vp[1536] << 16); av.z = 0u; av.w = 0u;
            o[db] = MFMA32(__builtin_bit_cast(bf16x8, av), pf, o[db]); }
    }
    l += __shfl_xor(l, 32);
    LAS float* ml = (LAS float*)C.lds;
    LAS float* ob = (LAS float*)(C.lds + 4096);
    if (hh == 0) { ml[(C.wave * 32 + r) * 2] = m; ml[(C.wave * 32 + r) * 2 + 1] = l; }
    __syncthreads();
    float M = M_INIT;
#pragma unroll
    for (int w = 0; w < 8; ++w) M = fmaxf(M, ml[(w * 32 + r) * 2]);
    float L = 0.f;
#pragma unroll
    for (int w = 0; w < 8; ++w) L += ml[(w * 32 + r) * 2 + 1] * fexp2(ml[(w * 32 + r) * 2] - M);
    { const float sc = fexp2(m - M);
#pragma unroll
      for (int db = 0; db < 4; ++db)
#pragma unroll
          for (int e = 0; e < 16; ++e) o[db][e] *= sc; }
#define OB_WRITE(slot) do { _Pragma("unroll") for (int db = 0; db < 4; ++db) _Pragma("unroll") for (int e = 0; e < 16; ++e) ob[(((slot) * 64 + db * 16 + e) << 6) + C.lane] = o[db][e]; } while (0)
#define OB_ADD(slot) do { _Pragma("unroll") for (int db = 0; db < 4; ++db) _Pragma("unroll") for (int e = 0; e < 16; ++e) o[db][e] += ob[(((slot) * 64 + db * 16 + e) << 6) + C.lane]; } while (0)
    if (C.wave >= 4) OB_WRITE(C.wave - 4);
    __syncthreads();
    if (C.wave < 4) OB_ADD(C.wave);
    __syncthreads();
    if (C.wave == 2 || C.wave == 3) OB_WRITE(C.wave - 2);
    __syncthreads();
    if (C.wave < 2) OB_ADD(C.wave);
    __syncthreads();
    if (C.wave == 1) OB_WRITE(0);
    __syncthreads();
    if (C.wave == 0) { OB_ADD(0); const float inv = 1.0f / L;
#pragma unroll
        for (int db = 0; db < 4; ++db)
#pragma unroll
            for (int rg = 0; rg < 4; ++rg) { v2u w; w.x = pk2(o[db][4 * rg] * inv, o[db][4 * rg + 1] * inv); w.y = pk2(o[db][4 * rg + 2] * inv, o[db][4 * rg + 3] * inv);
                *(v2u*)(O + (size_t)qrow * 2048 + head * 128 + 32 * db + 8 * rg + 4 * hh) = w; } }
#undef OB_WRITE
#undef OB_ADD
}
DI void ph_attn(const Args& a, const Ctx& C) {
    volatile LAS int* slot = (volatile LAS int*)(C.lds + MISC_OFF + 64);
    { gu32* head = (gu32*)a.ws + CW_WQ + 64;
      for (;;) { const int u = wq_next(head, slot, C.tid); if (u >= 512) break; attn_sample_unit(a, C, u >> 2, u & 3); } }
#if defined(DBG_MIDSTAMP)
    if (C.bx == 0 && C.tid == 0) ((volatile LAS unsigned long long*)(C.lds + MISC_OFF + 128))[17] = wall_clock64();
#endif
    { gu32* head = (gu32*)a.ws + CW_WQ + 128;
      for (;;) { const int v = wq_next(head, slot, C.tid); if (v >= 1024) break; attn_prompt_unit(a, C, (v & 31) >> 2, v & 3, 31 - (v >> 5)); } }
}
template <int S> DI f32x4 slab_sum(const float* slab_, int row, int N, int col) { v2u v[S];
    const unsigned short* slab = (const unsigned short*)slab_;
#pragma unroll
    for (int s = 0; s < S; ++s) v[s] = *(const v2u*)(slab + ((size_t)s * 1024 + row) * N + col);
    f32x4 a = {0.f, 0.f, 0.f, 0.f};
#pragma unroll
    for (int s = 0; s < S; ++s) { a[0] += __uint_as_float(v[s].x << 16); a[1] += __uint_as_float(v[s].x & 0xffff0000u); a[2] += __uint_as_float(v[s].y << 16); a[3] += __uint_as_float(v[s].y & 0xffff0000u); }
    return a; }
DI float grp16_sum(float q) { q += __shfl_xor(q, 1); q += __shfl_xor(q, 2); q += __shfl_xor(q, 4); q += __shfl_xor(q, 8); return q; }
template <int S> DI void ph_reduce_resid(const Args& a, const Ctx& C, const float* base, float* out) {
    unsigned char* ws = a.ws; const float* slab = (const float*)(ws + WS_SLAB); bf16* XB = (bf16*)(ws + WS_XB) + (size_t)RP * 2048; float* SS = (float*)(ws + WS_SS) + (size_t)RP * 32;
    const int gw = C.bx * NWAVES + C.wave, NGW = C.G * NWAVES, lane = C.lane;
    float* RSTD = (float*)(ws + WS_RSTD);
    for (int row = gw; row < RS; row += NGW) { float tot = 0.f;
#pragma unroll
        for (int j = 0; j < 8; ++j) { const int col = 4 * lane + 256 * j; const f32x4 o = slab_sum<S>(slab, row, 2048, col) + *(const f32x4*)(base + (size_t)row * 2048 + col);
            *(f32x4*)(out + (size_t)row * 2048 + col) = o; *(v2u*)(XB + (size_t)row * 2048 + col) = (v2u){pk2(o[0], o[1]), pk2(o[2], o[3])};
            tot += (o[0] * o[0] + o[1] * o[1]) + (o[2] * o[2] + o[3] * o[3]); }
        tot = wave_sum(tot); if (lane == 0) RSTD[RP + row] = 1.0f / sqrtf(tot * (1.0f / 2048.0f) + EPS);
    }
    const float* SSP = (const float*)(ws + WS_SS);
    for (int row = C.bx * 512 + C.tid; row < RP; row += C.G * 512) RSTD[row] = rstd32(SSP + (size_t)row * 32);
}
template <int S> DI void ph_reduce_a1(const Args& a, const Ctx& C) {
    unsigned char* ws = a.ws; const float* slab = (const float*)(ws + WS_SLAB); const float* SS = (const float*)(ws + WS_SS);
    bf16* U = (bf16*)(ws + WS_U); bf16* V = (bf16*)(ws + WS_V); float* VSS = (float*)(ws + WS_VSS);
    const int gw = C.bx * NWAVES + C.wave, NGW = C.G * NWAVES, lane = C.lane;
    for (int row = gw; row < RS; row += NGW) { const float rs = ((const float*)(ws + WS_RSTD))[RP + row];
#pragma unroll
        for (int j = 0; j < 16; ++j) { const int col = 4 * lane + 256 * j; f32x4 z = slab_sum<S>(slab, row, 4096, col) * rs;
#pragma unroll
            for (int e = 0; e < 4; ++e) z[e] = pg8::gelu_tanh(z[e]);
            const v2u w = {pk2(z[0], z[1]), pk2(z[2], z[3])};
            if (j < 8) *(v2u*)(U + (size_t)(RP + row) * 2048 + col) = w;
            else { *(v2u*)(V + (size_t)(RP + row) * 2048 + col - 2048) = w; const float q = grp16_sum((z[0] * z[0] + z[1] * z[1]) + (z[2] * z[2] + z[3] * z[3])); if ((lane & 15) == 0) VSS[(size_t)(RP + row) * 32 + 4 * (j - 8) + (lane >> 4)] = q; } }
    }
}
#define SELFCHK_HOOK(a,b,c,d) do {} while (0)
#ifndef MK_ONE_LAUNCH
#define MK_ONE_LAUNCH 1
#endif
constexpr int N_PHASES = 16;
#ifndef DBG_NPH
#define DBG_NPH 16
#endif
__global__ void __launch_bounds__(NWAVES * 64, 2) fwd_kernel(Args args) {
    extern __shared__ __attribute__((aligned(16))) unsigned char lds_raw[];
    Ctx C; C.lds = (LAS unsigned char*)lds_raw; C.tid = threadIdx.x; C.lane = C.tid & 63; C.wave = __builtin_amdgcn_readfirstlane(C.tid >> 6); C.G = gridDim.x; C.bx = blockIdx.x;
    unsigned char* ws = args.ws;
    for (int u = C.tid; u < 128; u += NWAVES * 64) ((LAS unsigned*)(C.lds + MISC_OFF))[u] = 0u;
    __syncthreads();
#if MK_ONE_LAUNCH
    XcdBarrier bar = xcd_barrier_post((unsigned*)ws + CW_BAR, (volatile LAS unsigned*)(C.lds + MISC_OFF) + 8);
#define GRID_BAR() xcd_barrier(bar)
#else
#define GRID_BAR() do {} while (0)
#endif
    const int lo = args.ph_lo, hi = args.ph_hi;
#ifndef PH_MASK
#define PH_MASK 0xFFFF
#endif
#define IN(k) (((PH_MASK >> (k)) & 1) && lo <= (k) && (k) < hi)
#ifndef DBG_TPHASE
#define DBG_TPHASE -1
#define DBG_TPHASE_HI 11
#endif
#ifndef DBG_TMULT
#define DBG_TMULT 7
#endif
    volatile LAS unsigned long long* stamps = (volatile LAS unsigned long long*)(C.lds + MISC_OFF + 128);
#define STAMP(k) do { if (DBG_TPHASE >= 0 && C.bx == 0 && C.tid == 0) stamps[(k)] = wall_clock64(); } while (0)
#define SEAM(k) do { if (IN(k) && IN((k) + 1)) GRID_BAR(); STAMP((k) + 1); } while (0)
    STAMP(0);
    bf16* XB = (bf16*)(ws + WS_XB); float* SS = (float*)(ws + WS_SS); float* XA = (float*)(ws + WS_XA); float* Y = args.out + OFF_Y; float* SLAB = (float*)(ws + WS_SLAB); const float* RSTD = (const float*)(ws + WS_RSTD);
    using pg8::Gemm; using pg8::StaticOrder;
    if (IN(0)) { ph_prologue(args, C); } SEAM(0);
    if (IN(1)) { Gemm g{XB, (const bf16*)(ws + WS_WAIN), R, 4096, 2048}; pg8::SplitOrder S; S.init(4096, 2048, 4, C.G, C.bx);
        pg8::EpiA1 E{(bf16*)(ws + WS_U), (bf16*)(ws + WS_V), (float*)(ws + WS_VSS), RSTD, SLAB};
        pg8::gemm_phase<pg8::EpiA1, pg8::SplitOrder, true, true>(C.lds, g, S, E); GRID_BAR(); ph_reduce_a1<4>(args, C); } SEAM(1);
    if (IN(2)) { ph_gate(args, C); } SEAM(2);
    if (IN(3)) { Gemm g{(const bf16*)(ws + WS_GT), (const bf16*)(ws + WS_WAOUT), R, 2048, 2048}; pg8::SplitOrder S; S.init(2048, 2048, 8, C.G, C.bx);
        pg8::EpiResidT<false, false> E{nullptr, nullptr, XB, SS, SLAB};
        pg8::gemm_phase<pg8::EpiResidT<false, false>, pg8::SplitOrder, true, true>(C.lds, g, S, E); GRID_BAR(); ph_reduce_resid<8>(args, C, args.in[1], XA + (size_t)RP * 2048); } SEAM(3);
    if (IN(4)) { Gemm g{XB, (const bf16*)(ws + WS_WFIN), R, DFF2, 2048}; StaticOrder S; S.init(R, DFF2, C.G, C.bx);
        pg8::EpiFfn E{(bf16*)(ws + WS_AB), (bf16*)(ws + WS_HID), RSTD, args.out + OFF_CP, args.out + OFF_CS, args.in[20], args.in[21], (PG8_LAS float*)(C.lds + 131072)};
        pg8::gemm_phase<pg8::EpiFfn, StaticOrder, true, true>(C.lds, g, S, E); filler_pull(args, C, 0); } SEAM(4);
    if (IN(5)) { ph_conv(args, C, 0); } SEAM(5);
    if (IN(6)) { Gemm g{(const bf16*)(ws + WS_HID), (const bf16*)(ws + WS_WFOUT), R, 2048, DFF}; pg8::SplitOrder S; S.init(2048, DFF, 8, C.G, C.bx);
        pg8::EpiResidT<false, false> E{nullptr, nullptr, XB, SS, SLAB};
        pg8::gemm_phase<pg8::EpiResidT<false, false>, pg8::SplitOrder, true, true>(C.lds, g, S, E); GRID_BAR(); ph_reduce_resid<8>(args, C, XA + (size_t)RP * 2048, Y + (size_t)RP * 2048); } SEAM(6);
    if (IN(7)) { Gemm g{XB, (const bf16*)(ws + WS_WBIN), R, NBP, 2048}; StaticOrder S; S.init(R, NBP, C.G, C.bx);
        pg8::EpiScale E{(bf16*)(ws + WS_P), NBP, RSTD, nullptr, nullptr};
        pg8::gemm_phase<pg8::EpiScale, StaticOrder, true, true>(C.lds, g, S, E); filler_pull(args, C, 1); } SEAM(7);
    if (IN(8)) { ph_qkrope(args, C); } SEAM(8);
    if (IN(9)) { ph_index(args, C); } SEAM(9);
    if (IN(10)) { ph_select(args, C); } SEAM(10);
    if (IN(11)) { ph_attn(args, C); } SEAM(11);
    if (IN(12)) { Gemm g{(const bf16*)(ws + WS_O), (const bf16*)(ws + WS_WBO), R, 2048, 2048}; pg8::SplitOrder S; S.init(2048, 2048, 8, C.G, C.bx);
        pg8::EpiResidT<false, false> E{nullptr, nullptr, XB, SS, SLAB};
        pg8::gemm_phase<pg8::EpiResidT<false, false>, pg8::SplitOrder, true, true>(C.lds, g, S, E); GRID_BAR(); ph_reduce_resid<8>(args, C, Y + (size_t)RP * 2048, XA + (size_t)RP * 2048); } SEAM(12);
    if (IN(13)) { Gemm g{XB, (const bf16*)(ws + WS_WFIN) + (size_t)DFF2 * 2048, R, DFF2, 2048}; StaticOrder S; S.init(R, DFF2, C.G, C.bx);
        pg8::EpiFfn E{(bf16*)(ws + WS_AB), (bf16*)(ws + WS_HID), RSTD, args.out + OFF_CP + (size_t)8 * 2 * DFF2, args.out + OFF_CS + (size_t)128 * 2 * DFF2, args.in[20] + (size_t)3 * DFF2, args.in[21] + DFF2, (PG8_LAS float*)(C.lds + 131072)};
        pg8::gemm_phase<pg8::EpiFfn, StaticOrder, true, true>(C.lds, g, S, E); filler_pull(args, C, 2); } SEAM(13);
    if (IN(14)) { ph_conv(args, C, 1); } SEAM(14);
    if (IN(15)) { Gemm g{(const bf16*)(ws + WS_HID), (const bf16*)(ws + WS_WFOUT) + (size_t)2048 * DFF, R, 2048, DFF}; pg8::SplitOrder S; S.init(2048, DFF, 8, C.G, C.bx);
        pg8::EpiResidT<false, true> E{nullptr, Y, XB, SS, SLAB};
        pg8::gemm_phase<pg8::EpiResidT<false, true>, pg8::SplitOrder, true, true>(C.lds, g, S, E); GRID_BAR(); ph_reduce_resid<8>(args, C, XA + (size_t)RP * 2048, Y + (size_t)RP * 2048); }
    if (DBG_TPHASE >= 0) {
        STAMP(16);
        if (C.bx == 0 && C.tid == 0) { const unsigned long long d = (stamps[DBG_TPHASE_HI] - stamps[DBG_TPHASE]) * DBG_TMULT, t0 = wall_clock64();
            while (wall_clock64() - t0 < d) __builtin_amdgcn_s_sleep(16); }
    }
#undef IN
#undef SEAM
}

extern "C" void kernel_launch(void* const* d_in, const int* in_sizes, int n_in, void* d_out, int out_size, void* d_ws, size_t ws_size, hipStream_t stream) {
    static int grid = 0;
    if (grid == 0) {
        if (n_in != 23 || (size_t)out_size != OUT_TOTAL || ws_size < WS_END) { fprintf(stderr, "kernel_launch: unexpected shapes (n_in %d, out %d, ws %zu < %zu)\n", n_in, out_size, ws_size, (size_t)WS_END); grid = -1; return; }
        int dev = 0, cus = 0, per_cu = 0;
        if (hipGetDevice(&dev) != hipSuccess || hipDeviceGetAttribute(&cus, hipDeviceAttributeMultiprocessorCount, dev) != hipSuccess) { grid = -1; return; }
        if (hipFuncSetAttribute((const void*)fwd_kernel, hipFuncAttributeMaxDynamicSharedMemorySize, LDS_BYTES) != hipSuccess) { fprintf(stderr, "kernel_launch: hipFuncSetAttribute failed\n"); grid = -1; return; }
        if (hipOccupancyMaxActiveBlocksPerMultiprocessor(&per_cu, (const void*)fwd_kernel, NWAVES * 64, LDS_BYTES) != hipSuccess || per_cu < 1) { fprintf(stderr, "kernel_launch: occupancy query says %d\n", per_cu); }
        (void)hipGetLastError();
        grid = cus;
    }
    if (grid < 0) return;
    (void)hipMemsetAsync(d_ws, 0, CTL_BYTES, stream);
    Args a{};
    for (int i = 0; i < 23; ++i) a.in[i] = (const float*)d_in[i];
    a.out = (float*)d_out; a.ws = (unsigned char*)d_ws;
#if MK_ONE_LAUNCH
    a.ph_lo = 0; a.ph_hi = N_PHASES;
    hipLaunchKernelGGL(fwd_kernel, dim3(grid), dim3(NWAVES * 64), LDS_BYTES, stream, a);
#else
    for (int p = 0; p < DBG_NPH; ++p) { a.ph_lo = p; a.ph_hi = p + 1; hipLaunchKernelGGL(fwd_kernel, dim3(grid), dim3(NWAVES * 64), LDS_BYTES, stream, a); }
#endif
    SELFCHK_HOOK(d_in, d_out, d_ws, stream);
}
```
